# Optimizing an MI355X kernel written in HIP

```python
import math
import jax, jax.numpy as jnp
from jax import lax
import numpy as np

D_MODEL = 1024
BATCH = 8
SEQ = 4096
DEPTH = 1

ATTN_HEADS = 4
ATTN_HEAD_DIM = 64
ATTN_V_DIM = 2 * ATTN_HEAD_DIM
ATTN_WIDTH = ATTN_HEADS * ATTN_V_DIM
QK_WIDTH = ATTN_HEADS * 2 * ATTN_HEAD_DIM
ROPE_THETA = 500000.0
ROPE_DIM = ATTN_HEAD_DIM // 4
Q_BLOCK = 128
LRU_WIDTH = D_MODEL - ATTN_WIDTH
LRU_BLOCKS = 8
LRU_BLOCK_DIM = LRU_WIDTH // LRU_BLOCKS
CONV_WIDTH = 4
LRU_C = 8.0
N_DIRS = 2
IN_WIDTH = 2 * QK_WIDTH + ATTN_WIDTH + 2 * LRU_WIDTH
N_GROUPS = 4
EXPERTS_PER_GROUP = 8
N_EXPERTS = N_GROUPS * EXPERTS_PER_GROUP
TOP_K = 2
D_EXPERT = 256
EPS = 1e-6

kernel_name = 'hybrid_diffattn_rglru_hmoe_encoder'


def rmsnorm(x, g):
    xf = x.astype(jnp.float32)
    y = xf * lax.rsqrt(jnp.mean(xf * xf, axis=-1, keepdims=True) + EPS)
    return (y * g.astype(jnp.float32)).astype(x.dtype)


def rope_tables(seq_len):
    pos = jnp.arange(seq_len, dtype=jnp.float32)
    inv_freq = ROPE_THETA ** (-jnp.arange(0, ROPE_DIM, 2, dtype=jnp.float32) / ROPE_DIM)
    ang = pos[:, None] * inv_freq[None, :]
    return jnp.cos(ang), jnp.sin(ang)


def partial_rope(t, cos, sin):
    c = cos[None, :, None, None, :].astype(t.dtype)
    s = sin[None, :, None, None, :].astype(t.dtype)
    half = ROPE_DIM // 2
    t1, t2, rest = t[..., :half], t[..., half:ROPE_DIM], t[..., ROPE_DIM:]
    return jnp.concatenate([t1 * c - t2 * s, t2 * c + t1 * s, rest], axis=-1)


def diff_attention(q, k, v, lam, lambda_init, subln_g):
    B, S = q.shape[0], q.shape[1]
    n_blk = S // Q_BLOCK
    q = q * (ATTN_HEAD_DIM ** -0.5)
    qb = q.reshape(B, n_blk, Q_BLOCK, ATTN_HEADS, 2, ATTN_HEAD_DIM).transpose(1, 0, 2, 3, 4, 5)

    def one_block(q_blk):
        s = jnp.einsum('bqhmd,bkhmd->bhmqk', q_blk, k).astype(jnp.float32)
        p = jax.nn.softmax(s, axis=-1)
        a = p[:, :, 0] - lam * p[:, :, 1]
        return jnp.einsum('bhqk,bkhe->bqhe', a.astype(v.dtype), v)

    o = lax.map(one_block, qb)
    o = o.transpose(1, 0, 2, 3, 4).reshape(B, S, ATTN_HEADS, ATTN_V_DIM)
    o = rmsnorm(o, subln_g) * (1.0 - lambda_init)
    return o.reshape(B, S, ATTN_WIDTH)


def centred_depthwise_conv(x, w, b):
    C = x.shape[-1]
    left = CONV_WIDTH // 2
    y = lax.conv_general_dilated(
        x, w[:, None, :].astype(x.dtype), window_strides=(1,),
        padding=[(left, CONV_WIDTH - 1 - left)],
        dimension_numbers=('NWC', 'WIO', 'NWC'), feature_group_count=C)
    return y + b.astype(x.dtype)


def _linear_recurrence(c1, c2):
    a1, b1 = c1
    a2, b2 = c2
    return a1 * a2, a2 * b1 + b2


def rg_lru(x, w_r, b_r, w_i, b_i, lam_param, reverse):
    B, S, C = x.shape
    xf = x.astype(jnp.float32)
    xb = xf.reshape(B, S, LRU_BLOCKS, LRU_BLOCK_DIM)
    r = jax.nn.sigmoid(jnp.einsum('bshi,hij->bshj', xb, w_r.astype(jnp.float32)).reshape(B, S, C) + b_r)
    i = jax.nn.sigmoid(jnp.einsum('bshi,hij->bshj', xb, w_i.astype(jnp.float32)).reshape(B, S, C) + b_i)
    log_a = -LRU_C * jax.nn.softplus(-lam_param.astype(jnp.float32)) * r
    a = jnp.exp(log_a)
    u = jnp.sqrt(-jnp.expm1(2.0 * log_a)) * (i * xf)
    _, h = lax.associative_scan(_linear_recurrence, (a, u), axis=1, reverse=reverse)
    return h


def hierarchical_moe(h, w_grp, w_exp, w_gate, w_up, w_down):
    B, S, D = h.shape
    t = h.reshape(B * S, D)
    g_prob = jax.nn.softmax((t @ w_grp).astype(jnp.float32), axis=-1)
    g_top_p, g_idx = lax.top_k(g_prob, 1)
    e_logits = (t @ w_exp).astype(jnp.float32).reshape(B * S, N_GROUPS, EXPERTS_PER_GROUP)
    e_in_grp = jnp.take_along_axis(e_logits, g_idx[:, :, None], axis=1)[:, 0]
    e_top_logit, e_idx = lax.top_k(e_in_grp, TOP_K)
    e_w = jax.nn.softmax(e_top_logit, axis=-1) * g_top_p
    global_idx = g_idx * EXPERTS_PER_GROUP + e_idx
    comb = jnp.sum(jax.nn.one_hot(global_idx, N_EXPERTS, dtype=jnp.float32) * e_w[..., None], axis=1)
    comb = comb.astype(t.dtype)
    out = jnp.zeros_like(t)
    for e in range(N_EXPERTS):
        hid = jax.nn.silu(t @ w_gate[e]) * (t @ w_up[e])
        out = out + comb[:, e:e + 1] * (hid @ w_down[e])
    return out.reshape(B, S, D)


def setup_inputs(seed: int = 0) -> dict:
    key = jax.random.key(seed)
    ks = jax.random.split(key, 24)
    f32 = jnp.float32
    nrm = lambda k, shape, scale: jax.random.normal(k, shape, f32) * scale
    a_c = jax.random.uniform(ks[15], (DEPTH, N_DIRS, LRU_WIDTH), f32, 0.9, 0.999)
    a0 = a_c ** (1.0 / LRU_C)
    lru_lambda = jnp.log(a0) - jnp.log1p(-a0)
    return {
        'x': jax.random.normal(ks[0], (BATCH, SEQ, D_MODEL), f32),
        'norm1_g': 1.0 + nrm(ks[1], (DEPTH, D_MODEL), 0.02),
        'w_in': nrm(ks[2], (DEPTH, D_MODEL, IN_WIDTH), D_MODEL ** -0.5),
        'lambda_q1': nrm(ks[3], (DEPTH, ATTN_HEAD_DIM), 0.1),
        'lambda_k1': nrm(ks[4], (DEPTH, ATTN_HEAD_DIM), 0.1),
        'lambda_q2': nrm(ks[5], (DEPTH, ATTN_HEAD_DIM), 0.1),
        'lambda_k2': nrm(ks[6], (DEPTH, ATTN_HEAD_DIM), 0.1),
        'subln_g': 1.0 + nrm(ks[7], (DEPTH, ATTN_V_DIM), 0.02),
        'conv_w': nrm(ks[8], (DEPTH, CONV_WIDTH, LRU_WIDTH), CONV_WIDTH ** -0.5),
        'conv_b': nrm(ks[9], (DEPTH, LRU_WIDTH), 0.01),
        'lru_w_r': nrm(ks[10], (DEPTH, N_DIRS, LRU_BLOCKS, LRU_BLOCK_DIM, LRU_BLOCK_DIM), LRU_BLOCK_DIM ** -0.5),
        'lru_b_r': nrm(ks[11], (DEPTH, N_DIRS, LRU_WIDTH), 0.01),
        'lru_w_i': nrm(ks[12], (DEPTH, N_DIRS, LRU_BLOCKS, LRU_BLOCK_DIM, LRU_BLOCK_DIM), LRU_BLOCK_DIM ** -0.5),
        'lru_b_i': nrm(ks[13], (DEPTH, N_DIRS, LRU_WIDTH), 0.01),
        'lru_lambda': lru_lambda,
        'w_out': nrm(ks[14], (DEPTH, D_MODEL, D_MODEL), D_MODEL ** -0.5),
        'norm2_g': 1.0 + nrm(ks[16], (DEPTH, D_MODEL), 0.02),
        'w_grp': nrm(ks[17], (DEPTH, D_MODEL, N_GROUPS), D_MODEL ** -0.5),
        'w_exp': nrm(ks[18], (DEPTH, D_MODEL, N_EXPERTS), D_MODEL ** -0.5),
        'w_gate': nrm(ks[19], (DEPTH, N_EXPERTS, D_MODEL, D_EXPERT), D_MODEL ** -0.5),
        'w_up': nrm(ks[20], (DEPTH, N_EXPERTS, D_MODEL, D_EXPERT), D_MODEL ** -0.5),
        'w_down': nrm(ks[21], (DEPTH, N_EXPERTS, D_EXPERT, D_MODEL), D_EXPERT ** -0.5),
        'final_g': 1.0 + nrm(ks[22], (D_MODEL,), 0.02),
    }


def reference(x, norm1_g, w_in, lambda_q1, lambda_k1, lambda_q2, lambda_k2, subln_g,
              conv_w, conv_b, lru_w_r, lru_b_r, lru_w_i, lru_b_i, lru_lambda, w_out,
              norm2_g, w_grp, w_exp, w_gate, w_up, w_down, final_g):
    B, S, _ = x.shape
    cos, sin = rope_tables(S)
    for l in range(DEPTH):
        lambda_init = 0.8 - 0.6 * math.exp(-0.3 * l)
        h = rmsnorm(x, norm1_g[l])
        proj = h @ w_in[l]
        q, k, v, xr, gate = jnp.split(
            proj, [QK_WIDTH, 2 * QK_WIDTH, 2 * QK_WIDTH + ATTN_WIDTH,
                   2 * QK_WIDTH + ATTN_WIDTH + LRU_WIDTH], axis=-1)
        q = partial_rope(q.reshape(B, S, ATTN_HEADS, 2, ATTN_HEAD_DIM), cos, sin)
        k = partial_rope(k.reshape(B, S, ATTN_HEADS, 2, ATTN_HEAD_DIM), cos, sin)
        v = v.reshape(B, S, ATTN_HEADS, ATTN_V_DIM)
        lam = (jnp.exp(jnp.sum(lambda_q1[l].astype(jnp.float32) * lambda_k1[l].astype(jnp.float32)))
               - jnp.exp(jnp.sum(lambda_q2[l].astype(jnp.float32) * lambda_k2[l].astype(jnp.float32)))
               + lambda_init)
        attn_out = diff_attention(q, k, v, lam, lambda_init, subln_g[l])
        xc = centred_depthwise_conv(xr, conv_w[l], conv_b[l])
        h_fwd = rg_lru(xc, lru_w_r[l, 0], lru_b_r[l, 0], lru_w_i[l, 0], lru_b_i[l, 0], lru_lambda[l, 0], False)
        h_bwd = rg_lru(xc, lru_w_r[l, 1], lru_b_r[l, 1], lru_w_i[l, 1], lru_b_i[l, 1], lru_lambda[l, 1], True)
        rnn_out = (h_fwd + h_bwd).astype(x.dtype) * jax.nn.gelu(gate)
        mix = jnp.concatenate([attn_out, rnn_out], axis=-1) @ w_out[l]
        x = x + mix
        h = rmsnorm(x, norm2_g[l])
        x = x + hierarchical_moe(h, w_grp[l], w_exp[l], w_gate[l], w_up[l], w_down[l])
    return rmsnorm(x, final_g)
```

```cpp
#include <hip/hip_runtime.h>
#include <hip/hip_cooperative_groups.h>
#include <hip/hip_bf16.h>
#include <cstdint>
#include <cstdio>
namespace cg = cooperative_groups;

#ifndef MK_N_LAUNCHES
#define MK_N_LAUNCHES 0
#endif

#define LAS __attribute__((address_space(3)))
typedef unsigned short bf16_t;
typedef __hip_bfloat16 bf16;
typedef short bf16x8 __attribute__((ext_vector_type(8)));
typedef short s16x4 __attribute__((ext_vector_type(4)));
typedef float f32x4 __attribute__((ext_vector_type(4)));
typedef float f32x16 __attribute__((ext_vector_type(16)));
typedef unsigned u32x4 __attribute__((ext_vector_type(4)));
typedef unsigned u32x2 __attribute__((ext_vector_type(2)));

constexpr int NBATCH = 8, SEQ = 4096, DM = 1024, MTOK = NBATCH * SEQ;
constexpr int NIN = 2560;
constexpr int NEXP = 32, DEXP = 256;
constexpr float EPS = 1e-6f;
constexpr int NWAVES = 8, NTHREADS = 512;
constexpr int NPHASES = 9;

constexpr size_t MiB = 1u << 20;
constexpr size_t WS_CTL = 0;
constexpr size_t WS_RT = 1 * MiB;
constexpr size_t WS_WRT = 1 * MiB + 512 * 1024;
constexpr size_t WS_WIN = 2 * MiB;
constexpr size_t WS_WOUT = 7 * MiB;
constexpr size_t WS_WGU = 9 * MiB;
constexpr size_t WS_WD = 41 * MiB;
constexpr size_t WS_EW = 58 * MiB;
constexpr size_t WS_LIST = 59 * MiB;
constexpr size_t WS_XN = 64 * MiB;
constexpr size_t WS_Q = 128 * MiB, WS_K = 160 * MiB, WS_V = 192 * MiB, WS_XR = 224 * MiB, WS_GG = 256 * MiB;
constexpr size_t WS_Y = 128 * MiB;
constexpr size_t WS_O0 = 288 * MiB;
constexpr size_t WS_HID = 288 * MiB;
constexpr size_t WS_HF = 352 * MiB;
constexpr size_t WS_MIX = 416 * MiB;
constexpr size_t WS_END = 480 * MiB;

constexpr int LDS_BYTES = 100 * 1024;

struct Args { const float* in[23]; float* out; unsigned char* ws; int ph_lo, ph_hi; };

#define LDS_WAIT() asm volatile("s_waitcnt lgkmcnt(0)" ::: "memory")
__device__ __forceinline__ unsigned f2bf(float f) { unsigned u = __builtin_bit_cast(unsigned, f); return (u + 0x7fffu + ((u >> 16) & 1u)) >> 16; }
__device__ __forceinline__ unsigned pk2(float lo, float hi) { return f2bf(lo) | (f2bf(hi) << 16); }
__device__ __forceinline__ float bf2f(bf16_t b) { return __builtin_bit_cast(float, (unsigned)b << 16); }
__device__ __forceinline__ float wave_sum(float v) {
#pragma unroll
    for (int o = 1; o < 64; o <<= 1) v += __shfl_xor(v, o);
    return v;
}
__device__ __forceinline__ float gelu_tanh(float x) {
    const float y = 0.7978845608028654f * (x + 0.044715f * x * x * x);
    const float t = 1.0f - 2.0f / (1.0f + __expf(2.0f * y));
    return 0.5f * x * (1.0f + t);
}
__device__ __forceinline__ float sigmoidf_(float x) { return 1.0f / (1.0f + __expf(-x)); }

__device__ __forceinline__ void tr_item(const float* W, int N, int k0, int n0, bf16_t* WT, int ldt, int dst_row0, LAS float* scr, int lane) {
#pragma unroll 8
    for (int i = 0; i < 32; ++i) { const int kk = 2 * i + (lane >> 5); scr[kk * 33 + (lane & 31)] = W[(size_t)(k0 + kk) * N + n0 + (lane & 31)]; }
    LDS_WAIT(); asm volatile("" ::: "memory");
    const int c = lane & 7;
#pragma unroll
    for (int j = 0; j < 4; ++j) { const int n = (lane >> 3) + 8 * j; const LAS float* s = scr + (8 * c) * 33 + n;
        u32x4 o; o.x = pk2(s[0 * 33], s[1 * 33]); o.y = pk2(s[2 * 33], s[3 * 33]); o.z = pk2(s[4 * 33], s[5 * 33]); o.w = pk2(s[6 * 33], s[7 * 33]);
        *(u32x4*)(WT + (size_t)(dst_row0 + n) * ldt + k0 + 8 * c) = o; }
    LDS_WAIT(); asm volatile("" ::: "memory");
}
__device__ __forceinline__ int gu_row(int c, int is_up) { return 64 * (c >> 5) + 32 * is_up + (c & 31); }

__device__ __forceinline__ void rms_row_bf16(const float* xrow, const float* g, bf16_t* orow, int lane) {
    const f32x4* xr = (const f32x4*)xrow + lane; const f32x4* gr = (const f32x4*)g + lane;
    f32x4 v[4]; float s = 0.f;
#pragma unroll
    for (int j = 0; j < 4; ++j) { v[j] = xr[64 * j]; s += (v[j].x * v[j].x + v[j].y * v[j].y) + (v[j].z * v[j].z + v[j].w * v[j].w); }
    s = wave_sum(s);
    const float rstd = 1.0f / sqrtf(s * (1.0f / DM) + EPS);
    u32x2* o8 = (u32x2*)orow + lane;
#pragma unroll
    for (int j = 0; j < 4; ++j) { const f32x4 gv = gr[64 * j]; u32x2 w; w.x = pk2(v[j].x * rstd * gv.x, v[j].y * rstd * gv.y); w.y = pk2(v[j].z * rstd * gv.z, v[j].w * rstd * gv.w); o8[64 * j] = w; }
}

__device__ __forceinline__ void phase0(const Args& a, LAS unsigned char* lds, int tid, int wave, int lane, int gw, int NGW) {
    unsigned char* ws = a.ws;
    LAS float* scr = (LAS float*)(lds + wave * 8704);
    bf16_t* WinT = (bf16_t*)(ws + WS_WIN); bf16_t* WoutT = (bf16_t*)(ws + WS_WOUT); bf16_t* WguT = (bf16_t*)(ws + WS_WGU); bf16_t* WdT = (bf16_t*)(ws + WS_WD);
    constexpr int I_IN = 16 * 80, I_OUT = 16 * 32, I_G = 32 * 128, I_U = 32 * 128, I_D = 32 * 128, NITEMS = I_IN + I_OUT + I_G + I_U + I_D;
    for (int it = gw; it < NITEMS; it += NGW) {
        int r = it;
        if (r < I_IN) { const int kb = r / 80, nb = r % 80; tr_item(a.in[2], NIN, 64 * kb, 32 * nb, WinT, DM, 32 * nb, scr, lane); continue; } r -= I_IN;
        if (r < I_OUT) { const int kb = r / 32, nb = r % 32; tr_item(a.in[15], DM, 64 * kb, 32 * nb, WoutT, DM, 32 * nb, scr, lane); continue; } r -= I_OUT;
        if (r < I_G) { const int e = r / 128, rr = r % 128, kb = rr / 8, nb = rr % 8; tr_item(a.in[19] + (size_t)e * DM * DEXP, DEXP, 64 * kb, 32 * nb, WguT + (size_t)e * 512 * DM, DM, gu_row(32 * nb, 0), scr, lane); continue; } r -= I_G;
        if (r < I_U) { const int e = r / 128, rr = r % 128, kb = rr / 8, nb = rr % 8; tr_item(a.in[20] + (size_t)e * DM * DEXP, DEXP, 64 * kb, 32 * nb, WguT + (size_t)e * 512 * DM, DM, gu_row(32 * nb, 1), scr, lane); continue; } r -= I_U;
        { const int e = r / 128, rr = r % 128, kb = rr / 32, nb = rr % 32; tr_item(a.in[21] + (size_t)e * DEXP * DM, DM, 64 * kb, 32 * nb, WdT + (size_t)e * DM * DEXP, DEXP, 32 * nb, scr, lane); }
    }
    { float* WRT = (float*)(ws + WS_WRT); const int gt = gw * 64 + lane, NGT = NGW * 64;
      for (int idx = gt; idx < 36 * DM; idx += NGT) { const int j = idx / DM, k = idx % DM; WRT[idx] = (j < 4) ? a.in[17][k * 4 + j] : a.in[18][k * 32 + (j - 4)]; }
      float2* RT = (float2*)(ws + WS_RT);
      for (int idx = gt; idx < SEQ * 8; idx += NGT) { const int pos = idx >> 3, i = idx & 7;
          const float invf = __builtin_amdgcn_exp2f(-(float)i * (18.931568569324174f / 8.0f));
          const float ang = (float)pos * invf;
          const double rev = (double)ang * 0.15915494309189535; const double fr = rev - __builtin_rint(rev);
          const float frf = (float)fr;
          RT[idx] = make_float2(__builtin_amdgcn_cosf(frf), __builtin_amdgcn_sinf(frf)); }
      int* cnt = (int*)(ws + WS_CTL);
      if (gt < 64) cnt[gt] = 0;
    }
    { bf16_t* XN = (bf16_t*)(ws + WS_XN);
      for (int m = gw; m < MTOK; m += NGW) rms_row_bf16(a.in[0] + (size_t)m * DM, a.in[1], XN + (size_t)m * DM, lane); }
}

template <class ARow>
__device__ __forceinline__ void wave_gemm_64x64(f32x4 (&acc)[4][4], const ARow& arow, const bf16_t* __restrict__ Bt, int ldb, int K, int m0, int n0, int lane) {
    const int fr = lane & 15, fq = lane >> 4;
#pragma unroll
    for (int mi = 0; mi < 4; ++mi)
#pragma unroll
        for (int ni = 0; ni < 4; ++ni) acc[mi][ni] = (f32x4){0.f, 0.f, 0.f, 0.f};
    const bf16_t* ap[4];
#pragma unroll
    for (int mi = 0; mi < 4; ++mi) ap[mi] = arow(m0 + 16 * mi + fr) + 8 * fq;
    const bf16_t* bp = Bt + (size_t)(n0 + fr) * ldb + 8 * fq;
    for (int k0 = 0; k0 < K; k0 += 32) {
        bf16x8 av[4], bv[4];
#pragma unroll
        for (int mi = 0; mi < 4; ++mi) av[mi] = *(const bf16x8*)(ap[mi] + k0);
#pragma unroll
        for (int ni = 0; ni < 4; ++ni) bv[ni] = *(const bf16x8*)(bp + (size_t)(16 * ni) * ldb + k0);
#pragma unroll
        for (int mi = 0; mi < 4; ++mi)
#pragma unroll
            for (int ni = 0; ni < 4; ++ni) acc[mi][ni] = __builtin_amdgcn_mfma_f32_16x16x32_bf16(bv[ni], av[mi], acc[mi][ni], 0, 0, 0);
    }
}
struct RowsContig { const bf16_t* base; int ld; __device__ __forceinline__ const bf16_t* operator()(int r) const { return base + (size_t)r * ld; } };

__device__ __forceinline__ void store_bf16x4(bf16_t* p, f32x4 v) { u32x2 w; w.x = pk2(v.x, v.y); w.y = pk2(v.z, v.w); *(u32x2*)p = w; }

__device__ __forceinline__ void phase1(const Args& a, int lane, int gw, int NGW) {
    unsigned char* ws = a.ws;
    const bf16_t* XN = (const bf16_t*)(ws + WS_XN); const bf16_t* WinT = (const bf16_t*)(ws + WS_WIN);
    const float2* RT = (const float2*)(ws + WS_RT);
    const int fr = lane & 15, fq = lane >> 4;
    constexpr int NT_N = NIN / 64, NT = (MTOK / 64) * NT_N;
    for (int t = gw; t < NT; t += NGW) {
        const int m0 = (t / NT_N) * 64, n0 = (t % NT_N) * 64;
        f32x4 acc[4][4];
        wave_gemm_64x64(acc, RowsContig{XN, DM}, WinT, DM, DM, m0, n0, lane);
        const int seg = n0 >> 9, cbase = n0 & 511;
        bf16_t* dst = (bf16_t*)(ws + (seg == 0 ? WS_Q : seg == 1 ? WS_K : seg == 2 ? WS_V : seg == 3 ? WS_XR : WS_GG));
#pragma unroll
        for (int mi = 0; mi < 4; ++mi) { const int row = m0 + 16 * mi + fr, pos = row & (SEQ - 1);
#pragma unroll
            for (int ni = 0; ni < 4; ++ni) { f32x4 v = acc[mi][ni];
                if (seg <= 1) {
                    if (((cbase + 16 * ni) & 63) == 0) {
                        f32x4 p; p.x = __shfl_xor(v.x, 32); p.y = __shfl_xor(v.y, 32); p.z = __shfl_xor(v.z, 32); p.w = __shfl_xor(v.w, 32);
                        const float2* cs = RT + pos * 8 + 4 * (fq & 1);
                        const float2 c0 = cs[0], c1 = cs[1], c2 = cs[2], c3 = cs[3];
                        if (fq < 2) { v.x = v.x * c0.x - p.x * c0.y; v.y = v.y * c1.x - p.y * c1.y; v.z = v.z * c2.x - p.z * c2.y; v.w = v.w * c3.x - p.w * c3.y; }
                        else        { v.x = v.x * c0.x + p.x * c0.y; v.y = v.y * c1.x + p.y * c1.y; v.z = v.z * c2.x + p.z * c2.y; v.w = v.w * c3.x + p.w * c3.y; }
                    }
                } else if (seg == 4) { v.x = gelu_tanh(v.x); v.y = gelu_tanh(v.y); v.z = gelu_tanh(v.z); v.w = gelu_tanh(v.w); }
                store_bf16x4(dst + (size_t)row * 512 + cbase + 16 * ni + 4 * fq, v); } }
    }
}

namespace att {
constexpr int DQK = 64, DV = 128, QBLK = 32, KVBLK = 64, LD = 512;
constexpr float SCALE = 0.125f, THR = 8.f;
constexpr int SHM_V = KVBLK * DV * 2, SHM_K = KVBLK * DQK * 2, SHM_ATTN = 2 * SHM_V + 2 * SHM_K + NWAVES * 64 * 4;
#define KSWZ(row, colB) ((row) * 128 + ((colB) ^ (((row) & 7) << 4)))
#define SBAR() __builtin_amdgcn_sched_barrier(0)
__device__ __forceinline__ int crow(int r, int hi) { return (r & 3) + 8 * (r >> 2) + 4 * hi; }
__device__ __forceinline__ unsigned cvtpk(float lo, float hi) { unsigned r; asm volatile("v_cvt_pk_bf16_f32 %0, %1, %2" : "=v"(r) : "v"(lo), "v"(hi)); return r; }

__device__ __forceinline__ void partialSM(f32x16& p0, f32x16& p1, float& m_reg, float& mn, float& alpha) {
    constexpr float C = SCALE * 1.4426950408889634f;
    float pmax = p0[0];
#pragma unroll
    for (int r = 1; r < 16; ++r) pmax = fmaxf(pmax, p0[r]);
#pragma unroll
    for (int r = 0; r < 16; ++r) pmax = fmaxf(pmax, p1[r]);
    { auto rr = __builtin_amdgcn_permlane32_swap(__float_as_uint(pmax), __float_as_uint(pmax), false, false);
      pmax = fmaxf(__uint_as_float(rr[0]), __uint_as_float(rr[1])); }
    if (__builtin_expect(__all(pmax - m_reg <= THR / SCALE), 1)) { mn = m_reg; alpha = 1.f; }
    else { mn = fmaxf(m_reg, pmax); alpha = __builtin_amdgcn_exp2f((m_reg - mn) * C); m_reg = mn; }
    const float mnC = -mn * C;
#pragma unroll
    for (int r = 0; r < 16; ++r) p0[r] = fmaf(p0[r], C, mnC);
#pragma unroll
    for (int r = 0; r < 16; ++r) p1[r] = fmaf(p1[r], C, mnC);
#pragma unroll
    for (int r = 0; r < 16; ++r) p0[r] = __builtin_amdgcn_exp2f(p0[r]);
}
__device__ __forceinline__ void finishSM(f32x16& p0, f32x16& p1, float alpha, float& l_reg, bf16x8& pa0, bf16x8& pa1, bf16x8& pa2, bf16x8& pa3) {
#pragma unroll
    for (int r = 0; r < 16; ++r) p1[r] = __builtin_amdgcn_exp2f(p1[r]);
    float ps = 0;
#pragma unroll
    for (int r = 0; r < 16; ++r) ps += p0[r];
#pragma unroll
    for (int r = 0; r < 16; ++r) ps += p1[r];
    { auto rr = __builtin_amdgcn_permlane32_swap(__float_as_uint(ps), __float_as_uint(ps), false, false);
      ps = __uint_as_float(rr[0]) + __uint_as_float(rr[1]); }
    l_reg = l_reg * alpha + ps;
#define PK4(P, BASE, OUT) do { unsigned a0 = cvtpk(P[BASE + 0], P[BASE + 1]), a1 = cvtpk(P[BASE + 2], P[BASE + 3]);   \
    unsigned b0 = cvtpk(P[BASE + 4], P[BASE + 5]), b1 = cvtpk(P[BASE + 6], P[BASE + 7]);                              \
    auto r0 = __builtin_amdgcn_permlane32_swap(a0, b0, false, false); auto r1 = __builtin_amdgcn_permlane32_swap(a1, b1, false, false); \
    u32x4 w = {r0[0], r1[0], r0[1], r1[1]}; OUT = *reinterpret_cast<bf16x8*>(&w); } while (0)
    PK4(p0, 0, pa0); PK4(p0, 8, pa1); PK4(p1, 0, pa2); PK4(p1, 8, pa3);
#undef PK4
}
__device__ __forceinline__ void qkt(f32x16& p0, f32x16& p1, const char* Ks, const bf16x8* qr, int r32, int hi) {
    p0 = f32x16{}; p1 = f32x16{};
#pragma unroll
    for (int d0 = 0; d0 < 4; ++d0) { const int cb = (d0 * 16 + hi * 8) * 2;
        const bf16x8 b0 = *reinterpret_cast<const bf16x8*>(Ks + KSWZ(r32, cb));
        const bf16x8 b1 = *reinterpret_cast<const bf16x8*>(Ks + KSWZ(32 + r32, cb));
        p0 = __builtin_amdgcn_mfma_f32_32x32x16_bf16(b0, qr[d0], p0, 0, 0, 0);
        p1 = __builtin_amdgcn_mfma_f32_32x32x16_bf16(b1, qr[d0], p1, 0, 0, 0); }
}
__device__ __forceinline__ int v_st(int k, int c) { const int kk = (k & ~0xC) | ((k & 4) << 1) | ((k & 8) >> 1); return ((kk >> 3) * 4 + (c >> 5)) * 512 + ((kk & 7) * 32 + (c & 31)) * 2; }
__device__ __forceinline__ int v_rd_base(int lane) { return ((lane & 3) << 3) | (((lane >> 2) & 3) << 6) | (((lane >> 4) & 1) << 5) | (((lane >> 5) & 1) << 8); }
constexpr int v_rd_off(int d0, int ks, int half) { return d0 * 512 + ks * 4096 + half * 2048; }
template <int OFF> __device__ __forceinline__ s16x4 tr_read(int vb) {
    s16x4 r; asm volatile("ds_read_b64_tr_b16 %0, %1 offset:%2" : "=&v"(r) : "v"(vb), "i"(OFF) : "memory"); return r;
}
template <int D0> __device__ __forceinline__ void pv_one(f32x16& od, int vb, bf16x8 pa0, bf16x8 pa1, bf16x8 pa2, bf16x8 pa3) {
    const s16x4 l0 = tr_read<v_rd_off(D0, 0, 0)>(vb), h0 = tr_read<v_rd_off(D0, 0, 1)>(vb), l1 = tr_read<v_rd_off(D0, 1, 0)>(vb), h1 = tr_read<v_rd_off(D0, 1, 1)>(vb);
    const s16x4 l2 = tr_read<v_rd_off(D0, 2, 0)>(vb), h2 = tr_read<v_rd_off(D0, 2, 1)>(vb), l3 = tr_read<v_rd_off(D0, 3, 0)>(vb), h3 = tr_read<v_rd_off(D0, 3, 1)>(vb);
    asm volatile("s_waitcnt lgkmcnt(0)" ::: "memory"); SBAR();
#define PK(L, H) (bf16x8){L[0], L[1], L[2], L[3], H[0], H[1], H[2], H[3]}
    od = __builtin_amdgcn_mfma_f32_32x32x16_bf16(pa0, PK(l0, h0), od, 0, 0, 0);
    od = __builtin_amdgcn_mfma_f32_32x32x16_bf16(pa1, PK(l1, h1), od, 0, 0, 0);
    od = __builtin_amdgcn_mfma_f32_32x32x16_bf16(pa2, PK(l2, h2), od, 0, 0, 0);
    od = __builtin_amdgcn_mfma_f32_32x32x16_bf16(pa3, PK(l3, h3), od, 0, 0, 0);
#undef PK
}
__device__ __forceinline__ void pv_d0(f32x16* o, int vb, bf16x8 pa0, bf16x8 pa1, bf16x8 pa2, bf16x8 pa3) {
    pv_one<0>(o[0], vb, pa0, pa1, pa2, pa3); pv_one<1>(o[1], vb, pa0, pa1, pa2, pa3); pv_one<2>(o[2], vb, pa0, pa1, pa2, pa3); pv_one<3>(o[3], vb, pa0, pa1, pa2, pa3);
}

__device__ __forceinline__ void attn_pass(const bf16_t* __restrict__ Qb, const bf16_t* __restrict__ Kh, const bf16_t* __restrict__ Vh, int seq, char* lds,
                                          f32x16 (&o)[4], float (&rli)[16]) {
    int tid_ = threadIdx.x; asm volatile("" : "+v"(tid_));
    const int tid = tid_, wid = tid >> 6, lane = tid & 63, r32 = lane & 31, hi = lane >> 5;
    char* V_lds = lds; char* K_lds = lds + 2 * SHM_V;
    float* wsf = (float*)(lds + 2 * SHM_V + 2 * SHM_K) + wid * 64; float* li_l = wsf; float* al_l = wsf + 32;
    float m_reg = -1e30f, l_reg = 0;
#pragma unroll
    for (int d = 0; d < 4; ++d) o[d] = f32x16{};
    bf16x8 qr[4];
    const bf16_t* Qw = Qb + (long)(wid * QBLK + r32) * LD + hi * 8;
#pragma unroll
    for (int d0 = 0; d0 < 4; ++d0) qr[d0] = *reinterpret_cast<const bf16x8*>(Qw + d0 * 16);
    const int sr = tid >> 4, sc = (tid & 15) * 8, vst0 = v_st(sr, sc), vst1 = v_st(32 + sr, sc);
    const int kr = tid >> 3, kc = (tid & 7) * 8, kst = KSWZ(kr, kc * 2);
    const int vb0 = (int)(uintptr_t)V_lds + v_rd_base(lane);
    struct { bf16x8 vs0, vs1, ks0; } sr_[2];
#define SLOAD(i, k0) do { sr_[i].vs0 = *reinterpret_cast<const bf16x8*>(&Vh[(long)((k0) + sr) * LD + sc]); sr_[i].vs1 = *reinterpret_cast<const bf16x8*>(&Vh[(long)((k0) + 32 + sr) * LD + sc]); \
    sr_[i].ks0 = *reinterpret_cast<const bf16x8*>(&Kh[(long)((k0) + kr) * LD + kc]); } while (0)
#define SWRITE(b, i) do { *(bf16x8*)(V_lds + (b) * SHM_V + vst0) = sr_[i].vs0; *(bf16x8*)(V_lds + (b) * SHM_V + vst1) = sr_[i].vs1; \
    *(bf16x8*)(K_lds + (b) * SHM_K + kst) = sr_[i].ks0; } while (0)
#define SWAIT() asm volatile("s_waitcnt vmcnt(3)" ::: "memory")
#define RESC(al) do { if (__any((al) < 1.f)) { if (hi == 0) al_l[r32] = (al); asm volatile("s_waitcnt lgkmcnt(0)" ::: "memory"); \
    _Pragma("unroll") for (int d = 0; d < 4; ++d) _Pragma("unroll") for (int r = 0; r < 16; ++r) o[d][r] *= al_l[crow(r, hi)]; } } while (0)
    f32x16 pA0, pA1, pB0, pB1; float mnA, mnB, alA, alB; bf16x8 pa0, pa1, pa2, pa3; const int NT = seq / KVBLK;
    constexpr int SE = 0, SO = 1;
    __syncthreads();
    SLOAD(SE, 0); asm volatile("s_waitcnt vmcnt(0)" ::: "memory"); SWRITE(0, SE); __syncthreads();
    qkt(pA0, pA1, K_lds, qr, r32, hi); partialSM(pA0, pA1, m_reg, mnA, alA);
    SLOAD(SO, KVBLK); if (2 < NT) SLOAD(SE, 2 * KVBLK);
    SWAIT(); SWRITE(1, SO); __syncthreads();
    for (int j = 1; j + 1 < NT; j += 2) {
        SBAR(); qkt(pB0, pB1, K_lds + SHM_K, qr, r32, hi);
        finishSM(pA0, pA1, alA, l_reg, pa0, pa1, pa2, pa3); SBAR();
        SLOAD(SO, (j + 2) * KVBLK); SBAR();
        pv_d0(o, vb0, pa0, pa1, pa2, pa3); partialSM(pB0, pB1, m_reg, mnB, alB);
        __syncthreads(); SWAIT(); SWRITE(0, SE);
        RESC(alB); __syncthreads();
        SBAR(); qkt(pA0, pA1, K_lds, qr, r32, hi);
        finishSM(pB0, pB1, alB, l_reg, pa0, pa1, pa2, pa3); SBAR();
        if (j + 3 < NT) SLOAD(SE, (j + 3) * KVBLK); SBAR();
        pv_d0(o, vb0 + SHM_V, pa0, pa1, pa2, pa3); partialSM(pA0, pA1, m_reg, mnA, alA);
        __syncthreads(); SWAIT(); SWRITE(1, SO);
        RESC(alA); __syncthreads();
    }
    SBAR(); qkt(pB0, pB1, K_lds + SHM_K, qr, r32, hi);
    finishSM(pA0, pA1, alA, l_reg, pa0, pa1, pa2, pa3); SBAR();
    pv_d0(o, vb0, pa0, pa1, pa2, pa3); partialSM(pB0, pB1, m_reg, mnB, alB);
    __syncthreads(); RESC(alB);
    finishSM(pB0, pB1, alB, l_reg, pa0, pa1, pa2, pa3); SBAR();
    pv_d0(o, vb0 + SHM_V, pa0, pa1, pa2, pa3);
    if (hi == 0) li_l[r32] = l_reg; asm volatile("s_waitcnt lgkmcnt(0)" ::: "memory");
#pragma unroll
    for (int r = 0; r < 16; ++r) rli[r] = __builtin_amdgcn_rcpf(li_l[crow(r, hi)]);
#undef SLOAD
#undef SWRITE
#undef SWAIT
#undef RESC
}
#undef KSWZ
#undef SBAR
}

__device__ __forceinline__ void phase2_attn(const Args& a, char* lds, int nblk, int blk) {
    unsigned char* ws = a.ws;
    const bf16_t* Qb = (const bf16_t*)(ws + WS_Q); const bf16_t* Kb = (const bf16_t*)(ws + WS_K); const bf16_t* Vb = (const bf16_t*)(ws + WS_V);
    float* OS = (float*)(ws + WS_O0) + (size_t)blk * 65536;
    bf16_t* MIX = (bf16_t*)(ws + WS_MIX);
    const float lambda_init = 0.2f;
    float lam;
    { const int l0 = threadIdx.x & 63; const float d1 = wave_sum(a.in[3][l0] * a.in[4][l0]), d2 = wave_sum(a.in[5][l0] * a.in[6][l0]); lam = expf(d1) - expf(d2) + lambda_init; }
    for (int u = blk; u < NBATCH * 4 * 16; u += nblk) {
        const int b = u >> 6, h = (u >> 4) & 3, qb = u & 15;
        const long row0 = (long)b * SEQ + qb * 256;
        for (int m = 0; m < 2; ++m) {
            f32x16 o[4]; float rli[16];
            att::attn_pass(Qb + row0 * 512 + (h * 2 + m) * 64, Kb + (long)b * SEQ * 512 + (h * 2 + m) * 64, Vb + (long)b * SEQ * 512 + h * 128, SEQ, lds, o, rli);
            int tid_ = threadIdx.x; asm volatile("" : "+v"(tid_));
            const int wid = tid_ >> 6, r32 = tid_ & 31, hi = (tid_ >> 5) & 1;
            float* od = OS + m * 32768 + (wid * 32) * 128 + r32;
#pragma unroll
            for (int r = 0; r < 16; ++r) { const int orow = att::crow(r, hi);
#pragma unroll
                for (int d0 = 0; d0 < 4; ++d0) od[orow * 128 + d0 * 32] = o[d0][r] * rli[r]; }
        }
        __syncthreads();
        { int tid_ = threadIdx.x; asm volatile("" : "+v"(tid_));
          const int row = tid_ >> 1, hf = tid_ & 1;
          const f32x4* p0 = (const f32x4*)(OS + row * 128 + hf * 64); const f32x4* p1 = (const f32x4*)(OS + 32768 + row * 128 + hf * 64);
          f32x4 av[16]; float ss = 0.f;
#pragma unroll
          for (int j = 0; j < 16; ++j) { const f32x4 x0 = p0[j], x1 = p1[j]; av[j] = x0 - lam * x1; ss += (av[j].x * av[j].x + av[j].y * av[j].y) + (av[j].z * av[j].z + av[j].w * av[j].w); }
          ss += __shfl_xor(ss, 1);
          const float rstd = (1.0f - lambda_init) / sqrtf(ss * (1.0f / 128.f) + EPS);
          const f32x4* gp = (const f32x4*)(a.in[7] + hf * 64);
          bf16_t* dst = MIX + (size_t)(row0 + row) * 1024 + h * 128 + hf * 64;
#pragma unroll
          for (int j = 0; j < 16; ++j) { const f32x4 g = gp[j]; store_bf16x4(dst + 4 * j, av[j] * rstd * g); }
        }
    }
}

__device__ __forceinline__ void phase2_lru(const Args& a, LAS unsigned char* lds, int nblk, int blk) {
    unsigned char* ws = a.ws;
    const bf16_t* XR = (const bf16_t*)(ws + WS_XR); const bf16_t* GG = (const bf16_t*)(ws + WS_GG);
    float* HF = (float*)(ws + WS_HF); bf16_t* MIX = (bf16_t*)(ws + WS_MIX);
    LAS float* wr = (LAS float*)lds;
    LAS float* wi = wr + 4096;
    LAS float* xs = wi + 4096;
    LAS float* as = xs + 4096;
    LAS float* us = as + 4096;
    LAS float* hs = us + 4096;
    const int tid = threadIdx.x, c = tid & 63, tg = tid >> 6;
    for (int u = blk; u < NBATCH * 8; u += nblk) {
        const int b = u >> 3, kb = u & 7, ch = kb * 64 + c;
        const float cw0 = a.in[8][0 * 512 + ch], cw1 = a.in[8][1 * 512 + ch], cw2 = a.in[8][2 * 512 + ch], cw3 = a.in[8][3 * 512 + ch], cb = a.in[9][ch];
        for (int dir = 0; dir < 2; ++dir) {
            __syncthreads();
            for (int i = tid; i < 4096; i += NTHREADS) { wr[i] = a.in[10][(size_t)(dir * 8 + kb) * 4096 + i]; wi[i] = a.in[12][(size_t)(dir * 8 + kb) * 4096 + i]; }
            const float br = a.in[11][dir * 512 + ch], bi = a.in[13][dir * 512 + ch];
            const float nl = -a.in[14][dir * 512 + ch];
            const float sp = (nl > 15.f) ? nl : log1pf(expf(nl));
            const float kA = -8.0f * sp;
            float hcar = 0.f;
            for (int ci = 0; ci < SEQ / 64; ++ci) {
                const int t0 = (dir == 0) ? ci * 64 : (SEQ - 64 - ci * 64);
                float xcv[8];
#pragma unroll
                for (int k = 0; k < 8; ++k) { const int t = t0 + tg * 8 + k; const size_t rb = (size_t)b * SEQ;
                    const float x0 = (t - 2 >= 0) ? bf2f(XR[(rb + t - 2) * 512 + ch]) : 0.f;
                    const float x1 = (t - 1 >= 0) ? bf2f(XR[(rb + t - 1) * 512 + ch]) : 0.f;
                    const float x2 = bf2f(XR[(rb + t) * 512 + ch]);
                    const float x3 = (t + 1 < SEQ) ? bf2f(XR[(rb + t + 1) * 512 + ch]) : 0.f;
                    xcv[k] = cb + cw0 * x0 + cw1 * x1 + cw2 * x2 + cw3 * x3;
                    xs[(tg * 8 + k) * 64 + c] = xcv[k]; }
                __syncthreads();
                float ra[8], ia[8];
#pragma unroll
                for (int k = 0; k < 8; ++k) { ra[k] = 0.f; ia[k] = 0.f; }
                for (int i = 0; i < 64; ++i) { const float w1 = wr[i * 64 + c], w2 = wi[i * 64 + c];
#pragma unroll
                    for (int k = 0; k < 8; ++k) { const float xv = xs[(tg * 8 + k) * 64 + i]; ra[k] = fmaf(xv, w1, ra[k]); ia[k] = fmaf(xv, w2, ia[k]); } }
#pragma unroll
                for (int k = 0; k < 8; ++k) { const float r = sigmoidf_(ra[k] + br), ig = sigmoidf_(ia[k] + bi);
                    const float log_a = kA * r; const float av = expf(log_a); const float uv = sqrtf(-expm1f(2.0f * log_a)) * (ig * xcv[k]);
                    as[(tg * 8 + k) * 64 + c] = av; us[(tg * 8 + k) * 64 + c] = uv; }
                __syncthreads();
                if (tg == 0) {
                    if (dir == 0) { for (int tt = 0; tt < 64; ++tt) { hcar = fmaf(as[tt * 64 + c], hcar, us[tt * 64 + c]); hs[tt * 64 + c] = hcar; } }
                    else          { for (int tt = 63; tt >= 0; --tt) { hcar = fmaf(as[tt * 64 + c], hcar, us[tt * 64 + c]); hs[tt * 64 + c] = hcar; } }
                }
                __syncthreads();
#pragma unroll
                for (int k = 0; k < 8; ++k) { const size_t row = (size_t)b * SEQ + t0 + tg * 8 + k; const float hv = hs[(tg * 8 + k) * 64 + c];
                    if (dir == 0) HF[row * 512 + ch] = hv;
                    else MIX[row * 1024 + 512 + ch] = (bf16_t)f2bf((HF[row * 512 + ch] + hv) * bf2f(GG[row * 512 + ch])); }
            }
        }
    }
}

__device__ __forceinline__ void phase3(const Args& a, int lane, int gw, int NGW) {
    unsigned char* ws = a.ws;
    const bf16_t* MIX = (const bf16_t*)(ws + WS_MIX); const bf16_t* WoutT = (const bf16_t*)(ws + WS_WOUT);
    const float* x = a.in[0]; float* X1 = a.out;
    const int fr = lane & 15, fq = lane >> 4;
    constexpr int NT_N = DM / 64, NT = (MTOK / 64) * NT_N;
    for (int t = gw; t < NT; t += NGW) {
        const int m0 = (t / NT_N) * 64, n0 = (t % NT_N) * 64;
        f32x4 acc[4][4];
        wave_gemm_64x64(acc, RowsContig{MIX, DM}, WoutT, DM, DM, m0, n0, lane);
#pragma unroll
        for (int mi = 0; mi < 4; ++mi) { const size_t row = m0 + 16 * mi + fr;
#pragma unroll
            for (int ni = 0; ni < 4; ++ni) { const size_t off = row * DM + n0 + 16 * ni + 4 * fq; *(f32x4*)(X1 + off) = *(const f32x4*)(x + off) + acc[mi][ni]; } }
    }
}

__device__ __forceinline__ void phase4(const Args& a, int lane, int gw, int NGW) {
    unsigned char* ws = a.ws;
    const float* X1 = a.out; const float* g2 = a.in[16]; bf16_t* H2 = (bf16_t*)(ws + WS_XN);
    const float* WRT = (const float*)(ws + WS_WRT);
    int* cnt = (int*)(ws + WS_CTL); int* LIST = (int*)(ws + WS_LIST); float* EW = (float*)(ws + WS_EW);
    for (int r0 = gw * 4; r0 < MTOK; r0 += NGW * 4) {
        f32x4 hv[4][4];
#pragma unroll
        for (int r = 0; r < 4; ++r) {
            const f32x4* xr = (const f32x4*)(X1 + (size_t)(r0 + r) * DM) + lane; float s = 0.f;
#pragma unroll
            for (int j = 0; j < 4; ++j) { hv[r][j] = xr[64 * j]; s += (hv[r][j].x * hv[r][j].x + hv[r][j].y * hv[r][j].y) + (hv[r][j].z * hv[r][j].z + hv[r][j].w * hv[r][j].w); }
            s = wave_sum(s);
            const float rstd = 1.0f / sqrtf(s * (1.0f / DM) + EPS);
            u32x2* o8 = (u32x2*)(H2 + (size_t)(r0 + r) * DM) + lane;
#pragma unroll
            for (int j = 0; j < 4; ++j) { const f32x4 gv = ((const f32x4*)g2)[lane + 64 * j]; hv[r][j] = hv[r][j] * rstd * gv;
                u32x2 w; w.x = pk2(hv[r][j].x, hv[r][j].y); w.y = pk2(hv[r][j].z, hv[r][j].w); o8[64 * j] = w; }
        }
        float mylog[4] = {0.f, 0.f, 0.f, 0.f};
        for (int j = 0; j < 36; ++j) {
            f32x4 w[4];
#pragma unroll
            for (int jj = 0; jj < 4; ++jj) w[jj] = ((const f32x4*)(WRT + (size_t)j * DM))[lane + 64 * jj];
#pragma unroll
            for (int r = 0; r < 4; ++r) { float p = 0.f;
#pragma unroll
                for (int jj = 0; jj < 4; ++jj) p += (hv[r][jj].x * w[jj].x + hv[r][jj].y * w[jj].y) + (hv[r][jj].z * w[jj].z + hv[r][jj].w * w[jj].w);
                p = wave_sum(p);
                if (lane == j) mylog[r] = p; }
        }
#pragma unroll
        for (int r = 0; r < 4; ++r) {
            const float g0 = __shfl(mylog[r], 0), g1 = __shfl(mylog[r], 1), g2l = __shfl(mylog[r], 2), g3 = __shfl(mylog[r], 3);
            int gi = 0; float gm = g0;
            if (g1 > gm) { gm = g1; gi = 1; } if (g2l > gm) { gm = g2l; gi = 2; } if (g3 > gm) { gm = g3; gi = 3; }
            const float gp = 1.0f / (expf(g0 - gm) + expf(g1 - gm) + expf(g2l - gm) + expf(g3 - gm));
            float ev[8];
#pragma unroll
            for (int j = 0; j < 8; ++j) ev[j] = __shfl(mylog[r], 4 + gi * 8 + j);
            int i1 = 0; float l1 = ev[0];
#pragma unroll
            for (int j = 1; j < 8; ++j) if (ev[j] > l1) { l1 = ev[j]; i1 = j; }
            int i2 = -1; float l2 = -3.0e38f;
#pragma unroll
            for (int j = 0; j < 8; ++j) if (j != i1 && ev[j] > l2) { l2 = ev[j]; i2 = j; }
            const float e2 = expf(l2 - l1); const float w1 = gp / (1.0f + e2), w2 = gp * e2 / (1.0f + e2);
            if (lane == 0) { const int row = r0 + r; const int ea = gi * 8 + i1, eb = gi * 8 + i2;
                const int sa = atomicAdd(&cnt[ea], 1); LIST[(size_t)ea * MTOK + sa] = row * 2 + 0; EW[row * 2 + 0] = w1;
                const int sb = atomicAdd(&cnt[eb], 1); LIST[(size_t)eb * MTOK + sb] = row * 2 + 1; EW[row * 2 + 1] = w2; }
        }
    }
}

struct RowsGather { const bf16_t* base; const int* list; int n; __device__ __forceinline__ const bf16_t* operator()(int r) const { const int tok = (r < n) ? (list[r] >> 1) : 0; return base + (size_t)tok * DM; } };

__device__ __forceinline__ void phase5(const Args& a, int lane, int gw, int NGW) {
    unsigned char* ws = a.ws;
    const bf16_t* H2 = (const bf16_t*)(ws + WS_XN); const bf16_t* WguT = (const bf16_t*)(ws + WS_WGU); bf16_t* HID = (bf16_t*)(ws + WS_HID);
    const int* cnt = (const int*)(ws + WS_CTL); const int* LIST = (const int*)(ws + WS_LIST);
    const int fr = lane & 15, fq = lane >> 4;
    int tbase = 0, seg = 0;
    for (int e = 0; e < NEXP; ++e) {
        const int n = cnt[e], mt = (n + 63) >> 6, ntile = mt * 8;
        int t = gw - (tbase % NGW); if (t < 0) t += NGW;
        for (; t < ntile; t += NGW) {
            const int m0 = (t >> 3) * 64, q = t & 7;
            f32x4 acc[4][4];
            wave_gemm_64x64(acc, RowsGather{H2, LIST + (size_t)e * MTOK, n}, WguT + (size_t)e * 512 * DM, DM, DM, m0, 64 * q, lane);
#pragma unroll
            for (int mi = 0; mi < 4; ++mi) { const int r = m0 + 16 * mi + fr;
#pragma unroll
                for (int ni = 0; ni < 2; ++ni) { const f32x4 g = acc[mi][ni], uu = acc[mi][ni + 2]; f32x4 hdn;
                    hdn.x = g.x * sigmoidf_(g.x) * uu.x; hdn.y = g.y * sigmoidf_(g.y) * uu.y; hdn.z = g.z * sigmoidf_(g.z) * uu.z; hdn.w = g.w * sigmoidf_(g.w) * uu.w;
                    store_bf16x4(HID + (size_t)(seg + r) * DEXP + 32 * q + 16 * ni + 4 * fq, hdn); } }
        }
        tbase += ntile; seg += mt * 64;
    }
}
__device__ __forceinline__ void phase6(const Args& a, int lane, int gw, int NGW) {
    unsigned char* ws = a.ws;
    const bf16_t* HID = (const bf16_t*)(ws + WS_HID); const bf16_t* WdT = (const bf16_t*)(ws + WS_WD); bf16_t* Y = (bf16_t*)(ws + WS_Y);
    const int* cnt = (const int*)(ws + WS_CTL); const int* LIST = (const int*)(ws + WS_LIST);
    const int fr = lane & 15, fq = lane >> 4;
    int tbase = 0, seg = 0;
    for (int e = 0; e < NEXP; ++e) {
        const int n = cnt[e], mt = (n + 63) >> 6, ntile = mt * 16;
        int t = gw - (tbase % NGW); if (t < 0) t += NGW;
        for (; t < ntile; t += NGW) {
            const int m0 = (t >> 4) * 64, n0 = (t & 15) * 64;
            f32x4 acc[4][4];
            wave_gemm_64x64(acc, RowsContig{HID + (size_t)seg * DEXP, DEXP}, WdT + (size_t)e * DM * DEXP, DEXP, DEXP, m0, n0, lane);
#pragma unroll
            for (int mi = 0; mi < 4; ++mi) { const int r = m0 + 16 * mi + fr;
                if (r < n) { const int dst = LIST[(size_t)e * MTOK + r];
#pragma unroll
                    for (int ni = 0; ni < 4; ++ni) store_bf16x4(Y + (size_t)dst * DM + n0 + 16 * ni + 4 * fq, acc[mi][ni]); } }
        }
        tbase += ntile; seg += mt * 64;
    }
}

__device__ __forceinline__ void phase7(const Args& a, int lane, int gw, int NGW) {
    unsigned char* ws = a.ws;
    float* out = a.out; const bf16_t* Y = (const bf16_t*)(ws + WS_Y); const float* EW = (const float*)(ws + WS_EW); const float* gf = a.in[22];
    for (int m = gw; m < MTOK; m += NGW) {
        const f32x4* xr = (const f32x4*)(out + (size_t)m * DM) + lane;
        const u32x2* y0 = (const u32x2*)(Y + (size_t)(2 * m) * DM) + lane; const u32x2* y1 = (const u32x2*)(Y + (size_t)(2 * m + 1) * DM) + lane;
        const float w0 = EW[2 * m], w1 = EW[2 * m + 1];
        f32x4 v[4]; float s = 0.f;
#pragma unroll
        for (int j = 0; j < 4; ++j) { const f32x4 xv = xr[64 * j]; const u32x2 a0 = y0[64 * j], a1 = y1[64 * j];
            f32x4 t;
            t.x = xv.x + w0 * __builtin_bit_cast(float, a0.x << 16) + w1 * __builtin_bit_cast(float, a1.x << 16);
            t.y = xv.y + w0 * __builtin_bit_cast(float, a0.x & 0xffff0000u) + w1 * __builtin_bit_cast(float, a1.x & 0xffff0000u);
            t.z = xv.z + w0 * __builtin_bit_cast(float, a0.y << 16) + w1 * __builtin_bit_cast(float, a1.y << 16);
            t.w = xv.w + w0 * __builtin_bit_cast(float, a0.y & 0xffff0000u) + w1 * __builtin_bit_cast(float, a1.y & 0xffff0000u);
            v[j] = t; s += (t.x * t.x + t.y * t.y) + (t.z * t.z + t.w * t.w); }
        s = wave_sum(s);
        const float rstd = 1.0f / sqrtf(s * (1.0f / DM) + EPS);
        f32x4* o = (f32x4*)(out + (size_t)m * DM) + lane;
#pragma unroll
        for (int j = 0; j < 4; ++j) { const f32x4 gv = ((const f32x4*)gf)[lane + 64 * j]; o[64 * j] = v[j] * rstd * gv; }
    }
}

__global__ void __launch_bounds__(NTHREADS, 2) mega_fwd(Args args) {
    extern __shared__ __attribute__((aligned(16))) unsigned char lds[];
    const int tid = threadIdx.x, lane = tid & 63, wave = __builtin_amdgcn_readfirstlane(tid >> 6);
    const int nblk = gridDim.x, blk = blockIdx.x;
    const int gw = blk * NWAVES + wave, NGW = nblk * NWAVES;
    const int lo = args.ph_lo, hi = args.ph_hi;
#define IN(k) (lo <= (k) && (k) < hi)
#define SEAM(k) do { if (IN(k) && IN((k) + 1)) { cg::this_grid().sync(); } } while (0)
    if (IN(0)) phase0(args, (LAS unsigned char*)lds, tid, wave, lane, gw, NGW);
    SEAM(0);
    if (IN(1)) phase1(args, lane, gw, NGW);
    SEAM(1);
    if (IN(2)) phase2_attn(args, (char*)lds, nblk, blk);
    SEAM(2);
    if (IN(3)) phase2_lru(args, (LAS unsigned char*)lds, nblk, blk);
    SEAM(3);
    if (IN(4)) phase3(args, lane, gw, NGW);
    SEAM(4);
    if (IN(5)) phase4(args, lane, gw, NGW);
    SEAM(5);
    if (IN(6)) phase5(args, lane, gw, NGW);
    SEAM(6);
    if (IN(7)) phase6(args, lane, gw, NGW);
    SEAM(7);
    if (IN(8)) phase7(args, lane, gw, NGW);
#undef IN
#undef SEAM
}

extern "C" void kernel_launch(void* const* d_in, const int* in_sizes, int n_in, void* d_out, int out_size, void* d_ws, size_t ws_size, hipStream_t stream) {
    static int grid = 0;
    if (grid == 0) {
        if (n_in != 23 || out_size != MTOK * DM || ws_size < WS_END) { fprintf(stderr, "kernel_launch: unexpected shapes (n_in %d out %d ws %zu)\n", n_in, out_size, ws_size); grid = -1; return; }
        int dev = 0, cus = 0, per_cu = 0;
        hipGetDevice(&dev);
        hipDeviceGetAttribute(&cus, hipDeviceAttributeMultiprocessorCount, dev);
        hipFuncSetAttribute((const void*)mega_fwd, hipFuncAttributeMaxDynamicSharedMemorySize, LDS_BYTES);
        hipOccupancyMaxActiveBlocksPerMultiprocessor(&per_cu, (const void*)mega_fwd, NTHREADS, LDS_BYTES);
        if (per_cu < 1) per_cu = 1;
        if (per_cu > 1) per_cu = 1;
        grid = cus * per_cu;
        (void)hipGetLastError();
    }
    if (grid < 0) return;
    Args a{};
    for (int i = 0; i < 23; ++i) a.in[i] = (const float*)d_in[i];
    a.out = (float*)d_out; a.ws = (unsigned char*)d_ws;
#if MK_N_LAUNCHES == 1
    a.ph_lo = 0; a.ph_hi = NPHASES;
    void* kargs[] = {&a};
    hipError_t e = hipLaunchCooperativeKernel((const void*)mega_fwd, dim3(grid), dim3(NTHREADS), kargs, LDS_BYTES, stream);
    if (e != hipSuccess) fprintf(stderr, "cooperative launch failed: %s (grid %d)\n", hipGetErrorString(e), grid);
#else
    for (int p = 0; p < NPHASES; ++p) {
        a.ph_lo = p; a.ph_hi = p + 1;
        hipLaunchKernelGGL(mega_fwd, dim3(grid), dim3(NTHREADS), LDS_BYTES, stream, a);
    }
#endif
}
```

```cpp
#include <hip/hip_runtime.h>
#include <hip/hip_cooperative_groups.h>
#include <hip/hip_bf16.h>
#include <cstdint>
#include <cstdio>
namespace cg = cooperative_groups;

#ifndef PROBE_DUP
#define PROBE_DUP -1
#endif
#ifndef PROBE_PREFIX
#define PROBE_PREFIX 0
#endif
#ifndef PROBE_P2_MODE
#define PROBE_P2_MODE 0
#endif
#ifndef PROBE_LRU_ABL
#define PROBE_LRU_ABL 0
#endif
#ifndef PROBE_VALU
#define PROBE_VALU 0
#endif
#ifndef PROBE_ATT_THREADS
#define PROBE_ATT_THREADS 512
#endif
#ifndef PROBE_ATT_VAR
#define PROBE_ATT_VAR 0
#endif
#ifndef MK_CG_SYNC
#define MK_CG_SYNC 0
#endif
#ifndef MK_N_LAUNCHES
#define MK_N_LAUNCHES 1
#endif

#define LAS __attribute__((address_space(3)))
typedef unsigned short bf16_t;
typedef __hip_bfloat16 bf16;
typedef short bf16x8 __attribute__((ext_vector_type(8)));
typedef short s16x4 __attribute__((ext_vector_type(4)));
typedef float f32x4 __attribute__((ext_vector_type(4)));
typedef float f32x16 __attribute__((ext_vector_type(16)));
typedef unsigned u32x4 __attribute__((ext_vector_type(4)));
typedef unsigned u32x2 __attribute__((ext_vector_type(2)));
typedef float f32x2 __attribute__((ext_vector_type(2)));

constexpr int NBATCH = 8, SEQ = 4096, DM = 1024, MTOK = NBATCH * SEQ;
constexpr int NIN = 2560;
constexpr int NEXP = 32, DEXP = 256;
constexpr float EPS = 1e-6f;
constexpr float QSCALE = 0.125f * 1.4426950408889634f;
constexpr int NWAVES = 8, NTHREADS = 512;
constexpr int NPHASES = 9;

constexpr size_t MiB = 1u << 20;
constexpr size_t WS_CTL = 0;
constexpr size_t WS_RT = 1 * MiB;
constexpr size_t WS_WRH = 1 * MiB + 512 * 1024;
constexpr size_t WS_WRL = 1 * MiB + 768 * 1024;
constexpr size_t WS_WIN = 2 * MiB;
constexpr size_t WS_WOUT = 7 * MiB;
constexpr size_t WS_WGU = 9 * MiB;
constexpr size_t WS_WD = 41 * MiB;
constexpr size_t WS_EW = 58 * MiB;
constexpr size_t WS_LIST = 59 * MiB;
constexpr size_t WS_XN = 64 * MiB;
constexpr size_t WS_Q = 128 * MiB, WS_K = 160 * MiB, WS_V = 192 * MiB, WS_XR = 224 * MiB, WS_GG = 256 * MiB;
constexpr size_t WS_X1 = 128 * MiB;
constexpr size_t WS_Y = 352 * MiB;
constexpr size_t WS_O0 = 288 * MiB;
constexpr size_t WS_HID = 288 * MiB;
constexpr size_t WS_HF = 352 * MiB;
constexpr size_t WS_MIX = 416 * MiB;
constexpr size_t WS_END = 480 * MiB;

constexpr int LDS_BYTES = 136 * 1024;

struct Args { const float* in[23]; float* out; unsigned char* ws; int ph_lo, ph_hi; };

#define LDS_WAIT() asm volatile("s_waitcnt lgkmcnt(0)" ::: "memory")
__device__ __forceinline__ unsigned f2bf(float f) { unsigned u = __builtin_bit_cast(unsigned, f); return (u + 0x7fffu + ((u >> 16) & 1u)) >> 16; }
__device__ __forceinline__ unsigned pk2(float lo, float hi) { return f2bf(lo) | (f2bf(hi) << 16); }
__device__ __forceinline__ float bf2f(bf16_t b) { return __builtin_bit_cast(float, (unsigned)b << 16); }
__device__ __forceinline__ float wave_sum(float v) {
#pragma unroll
    for (int o = 1; o < 64; o <<= 1) v += __shfl_xor(v, o);
    return v;
}
__device__ __forceinline__ float gelu_tanh(float x) {
    const float y = 0.7978845608028654f * (x + 0.044715f * x * x * x);
    const float t = 1.0f - 2.0f / (1.0f + __expf(2.0f * y));
    return 0.5f * x * (1.0f + t);
}
__device__ __forceinline__ float sigmoidf_(float x) { return 1.0f / (1.0f + __expf(-x)); }

__device__ __forceinline__ void tr_item(const float* W, int N, int k0, int n0, bf16_t* WT, int ldt, int dst_row0, LAS float* scr, int lane) {
#pragma unroll 8
    for (int i = 0; i < 32; ++i) { const int kk = 2 * i + (lane >> 5); scr[kk * 33 + (lane & 31)] = W[(size_t)(k0 + kk) * N + n0 + (lane & 31)]; }
    LDS_WAIT(); asm volatile("" ::: "memory");
    const int c = lane & 7;
#pragma unroll
    for (int j = 0; j < 4; ++j) { const int n = (lane >> 3) + 8 * j; const LAS float* s = scr + (8 * c) * 33 + n;
        u32x4 o; o.x = pk2(s[0 * 33], s[1 * 33]); o.y = pk2(s[2 * 33], s[3 * 33]); o.z = pk2(s[4 * 33], s[5 * 33]); o.w = pk2(s[6 * 33], s[7 * 33]);
        *(u32x4*)(WT + (size_t)(dst_row0 + n) * ldt + k0 + 8 * c) = o; }
    LDS_WAIT(); asm volatile("" ::: "memory");
}
__device__ __forceinline__ int gu_row(int c, int is_up) { return 256 * (c >> 7) + 128 * is_up + (c & 127); }

__device__ __forceinline__ void rms_row_bf16(const float* xrow, const float* g, bf16_t* orow, int lane) {
    const f32x4* xr = (const f32x4*)xrow + lane; const f32x4* gr = (const f32x4*)g + lane;
    f32x4 v[4]; float s = 0.f;
#pragma unroll
    for (int j = 0; j < 4; ++j) { v[j] = xr[64 * j]; s += (v[j].x * v[j].x + v[j].y * v[j].y) + (v[j].z * v[j].z + v[j].w * v[j].w); }
    s = wave_sum(s);
    const float rstd = 1.0f / sqrtf(s * (1.0f / DM) + EPS);
    u32x2* o8 = (u32x2*)orow + lane;
#pragma unroll
    for (int j = 0; j < 4; ++j) { const f32x4 gv = gr[64 * j]; u32x2 w; w.x = pk2(v[j].x * rstd * gv.x, v[j].y * rstd * gv.y); w.y = pk2(v[j].z * rstd * gv.z, v[j].w * rstd * gv.w); o8[64 * j] = w; }
}

__device__ __forceinline__ void phase0(const Args& a, LAS unsigned char* lds, int tid, int wave, int lane, int gw, int NGW) {
    unsigned char* ws = a.ws;
    LAS float* scr = (LAS float*)(lds + wave * 8704);
    bf16_t* WinT = (bf16_t*)(ws + WS_WIN); bf16_t* WoutT = (bf16_t*)(ws + WS_WOUT); bf16_t* WguT = (bf16_t*)(ws + WS_WGU); bf16_t* WdT = (bf16_t*)(ws + WS_WD);
    constexpr int I_IN = 16 * 80, I_OUT = 16 * 32, I_G = 32 * 128, I_U = 32 * 128, I_D = 32 * 128, NITEMS = I_IN + I_OUT + I_G + I_U + I_D;
    for (int it = gw; it < NITEMS; it += NGW) {
        int r = it;
        if (r < I_IN) { const int kb = r / 80, nb = r % 80; tr_item(a.in[2], NIN, 64 * kb, 32 * nb, WinT, DM, 32 * nb, scr, lane); continue; } r -= I_IN;
        if (r < I_OUT) { const int kb = r / 32, nb = r % 32; tr_item(a.in[15], DM, 64 * kb, 32 * nb, WoutT, DM, 32 * nb, scr, lane); continue; } r -= I_OUT;
        if (r < I_G) { const int e = r / 128, rr = r % 128, kb = rr / 8, nb = rr % 8; tr_item(a.in[19] + (size_t)e * DM * DEXP, DEXP, 64 * kb, 32 * nb, WguT + (size_t)e * 512 * DM, DM, gu_row(32 * nb, 0), scr, lane); continue; } r -= I_G;
        if (r < I_U) { const int e = r / 128, rr = r % 128, kb = rr / 8, nb = rr % 8; tr_item(a.in[20] + (size_t)e * DM * DEXP, DEXP, 64 * kb, 32 * nb, WguT + (size_t)e * 512 * DM, DM, gu_row(32 * nb, 1), scr, lane); continue; } r -= I_U;
        { const int e = r / 128, rr = r % 128, kb = rr / 32, nb = rr % 32; tr_item(a.in[21] + (size_t)e * DEXP * DM, DM, 64 * kb, 32 * nb, WdT + (size_t)e * DM * DEXP, DEXP, 32 * nb, scr, lane); }
    }
    { bf16_t* WRH = (bf16_t*)(ws + WS_WRH); bf16_t* WRL = (bf16_t*)(ws + WS_WRL); const int gt = gw * 64 + lane, NGT = NGW * 64;
      for (int idx = gt; idx < 48 * DM; idx += NGT) { const int j = idx / DM, k = idx % DM;
          const float w = (j < 4) ? a.in[17][k * 4 + j] : (j < 36) ? a.in[18][k * 32 + (j - 4)] : 0.f; const float wg = w * a.in[16][k];
          const unsigned hi = f2bf(wg); const float hif = __builtin_bit_cast(float, hi << 16);
          WRH[idx] = (bf16_t)hi; WRL[idx] = (bf16_t)f2bf(wg - hif); }
      if (gt < 2048) ((int*)(ws + WS_CTL))[gt] = 0;
      float2* RT = (float2*)(ws + WS_RT);
      for (int idx = gt; idx < SEQ * 8; idx += NGT) { const int pos = idx >> 3, i = idx & 7;
          const float invf = __builtin_amdgcn_exp2f(-(float)i * (18.931568569324174f / 8.0f));
          const float ang = (float)pos * invf;
          const double rev = (double)ang * 0.15915494309189535; const double fr = rev - __builtin_rint(rev);
          const float frf = (float)fr;
          RT[idx] = make_float2(__builtin_amdgcn_cosf(frf), __builtin_amdgcn_sinf(frf)); }
    }
    { bf16_t* XN = (bf16_t*)(ws + WS_XN); const float* x = a.in[0];
      f32x4 gv[4];
#pragma unroll
      for (int j = 0; j < 4; ++j) gv[j] = ((const f32x4*)a.in[1])[lane + 64 * j];
      f32x4 xn[4];
      if (gw < MTOK) {
#pragma unroll
          for (int j = 0; j < 4; ++j) xn[j] = ((const f32x4*)(x + (size_t)gw * DM))[lane + 64 * j]; }
      for (int m = gw; m < MTOK; m += NGW) {
          f32x4 v[4]; float s = 0.f;
#pragma unroll
          for (int j = 0; j < 4; ++j) { v[j] = xn[j]; s += (v[j].x * v[j].x + v[j].y * v[j].y) + (v[j].z * v[j].z + v[j].w * v[j].w); }
          { const int mn = (m + NGW < MTOK) ? m + NGW : m;
#pragma unroll
            for (int j = 0; j < 4; ++j) xn[j] = ((const f32x4*)(x + (size_t)mn * DM))[lane + 64 * j]; }
          s = wave_sum(s);
          const float rstd = 1.0f / sqrtf(s * (1.0f / DM) + EPS);
          u32x2* o8 = (u32x2*)(XN + (size_t)m * DM) + lane;
#pragma unroll
          for (int j = 0; j < 4; ++j) { u32x2 w; w.x = pk2(v[j].x * rstd * gv[j].x, v[j].y * rstd * gv[j].y); w.y = pk2(v[j].z * rstd * gv[j].z, v[j].w * rstd * gv[j].w); o8[64 * j] = w; } } }
}

template <class ARow>
__device__ __forceinline__ void wave_gemm_64x64(f32x4 (&acc)[4][4], const ARow& arow, const bf16_t* __restrict__ Bt, int ldb, int K, int m0, int n0, int lane) {
    const int fr = lane & 15, fq = lane >> 4;
#pragma unroll
    for (int mi = 0; mi < 4; ++mi)
#pragma unroll
        for (int ni = 0; ni < 4; ++ni) acc[mi][ni] = (f32x4){0.f, 0.f, 0.f, 0.f};
    const bf16_t* ap[4];
#pragma unroll
    for (int mi = 0; mi < 4; ++mi) ap[mi] = arow(m0 + 16 * mi + fr) + 8 * fq;
    const bf16_t* bp = Bt + (size_t)(n0 + fr) * ldb + 8 * fq;
    for (int k0 = 0; k0 < K; k0 += 32) {
        bf16x8 av[4], bv[4];
#pragma unroll
        for (int mi = 0; mi < 4; ++mi) av[mi] = *(const bf16x8*)(ap[mi] + k0);
#pragma unroll
        for (int ni = 0; ni < 4; ++ni) bv[ni] = *(const bf16x8*)(bp + (size_t)(16 * ni) * ldb + k0);
#pragma unroll
        for (int mi = 0; mi < 4; ++mi)
#pragma unroll
            for (int ni = 0; ni < 4; ++ni) acc[mi][ni] = __builtin_amdgcn_mfma_f32_16x16x32_bf16(bv[ni], av[mi], acc[mi][ni], 0, 0, 0);
    }
}
struct RowsContig { const bf16_t* base; int ld; __device__ __forceinline__ const bf16_t* operator()(int r) const { return base + (size_t)r * ld; } };

__device__ __forceinline__ void store_bf16x4(bf16_t* p, f32x4 v) { u32x2 w; w.x = pk2(v.x, v.y); w.y = pk2(v.z, v.w); *(u32x2*)p = w; }


namespace pg8 {
constexpr int BM = 256, BK = 64, HALF = 128, HTB = HALF * BK * 2, STAGE_BYTES = 8 * HTB, NXCD = 8, WGM = 8;
__host__ __device__ __forceinline__ int lds_byte(int r, int c) { const int st = (r >> 4) * 2 + (c >> 5), rr = r & 15, cc = c & 31, ob = rr * 64 + cc * 2; return st * 1024 + (ob ^ (((ob >> 9) & 1) << 5)); }
__host__ __device__ __forceinline__ void stage_rc(int b, int& R, int& C) { const int st = b / 1024, sb = b % 1024, swz = sb ^ (((sb >> 9) & 1) << 5); R = (st >> 1) * 16 + swz / 64; C = (st & 1) * 32 + (swz % 64) / 2; }
__host__ __device__ __forceinline__ int perm32(int rho) { const int n = rho >> 4, i = rho & 15; return 8 * (i >> 2) + 4 * n + (i & 3); }

struct Unit { const char* A; const char* B; int pm, pn, e, nrows, seg; };

template <class Epi, class Sched>
__device__ __forceinline__ void gemm_phase(LAS unsigned char* lds, const int K, const Sched& S, const Epi& E) {
    const int tid = threadIdx.x, wid = __builtin_amdgcn_readfirstlane(tid >> 6), lane = tid & 63, wr = wid >> 2, wc = wid & 3, fr = lane & 15, fq = lane >> 4;
    const int nt = K / BK;
    int Rl[2], Cl[2]; unsigned voffB[2];
#pragma unroll
    for (int i = 0; i < 2; ++i) { int R, C; stage_rc(tid * 16 + i * 8192, R, C); const int Rb = Epi::PERM ? ((R & ~31) + perm32(R & 31)) : R;
        Rl[i] = R; Cl[i] = C; voffB[i] = (unsigned)(Rb * K + C) * 2u; }
    const size_t kstep = (size_t)(BK * 2);
    const size_t hstep = (size_t)HALF * K * 2;
    const unsigned ldsw = (unsigned)wid * 1024u;
    const int aoff = lds_byte(wr * 64 + fr, fq * 8), boff = lds_byte(wc * 32 + fr, fq * 8);
#define PG8_SA(b, h) (((b) * 2 + (h)) * HTB)
#define PG8_SB(b, h) ((4 + (b) * 2 + (h)) * HTB)
#define PG8_STAGE(bufoff, gbase, voff) do { _Pragma("unroll") for (int _i = 0; _i < 2; ++_i) \
        __builtin_amdgcn_global_load_lds((const unsigned*)((const char*)(gbase) + (voff)[_i]), (LAS unsigned*)(lds + (bufoff) + ldsw + _i * 8192), 16, 0, 0); } while (0)
#define PG8_LDA(dst, b, h) do { _Pragma("unroll") for (int m = 0; m < 4; ++m) _Pragma("unroll") for (int k = 0; k < 2; ++k) dst[m][k] = *(const LAS bf16x8*)(lds + PG8_SA(b, h) + aoff + m * 2048 + k * 1024); } while (0)
#define PG8_LDB(dst, b, h) do { _Pragma("unroll") for (int n = 0; n < 2; ++n) _Pragma("unroll") for (int k = 0; k < 2; ++k) dst[n][k] = *(const LAS bf16x8*)(lds + PG8_SB(b, h) + boff + n * 2048 + k * 1024); } while (0)
#define PG8_MMA(ai, bj, At, Bt) do { __builtin_amdgcn_s_setprio(1); _Pragma("unroll") for (int m = 0; m < 4; ++m) _Pragma("unroll") for (int n = 0; n < 2; ++n) _Pragma("unroll") for (int k = 0; k < 2; ++k) \
        acc[ai][bj][m][n] = __builtin_amdgcn_mfma_f32_16x16x32_bf16(Bt[n][k], At[m][k], acc[ai][bj][m][n], 0, 0, 0); __builtin_amdgcn_s_setprio(0); } while (0)
#define PG8_WAIT_V(n) asm volatile("s_waitcnt vmcnt(" #n ")" ::: "memory")
#define PG8_WAIT_L(n) asm volatile("s_waitcnt lgkmcnt(" #n ")" ::: "memory")
#define PG8_BAR __builtin_amdgcn_s_barrier()
#define PG8_SCHED __builtin_amdgcn_sched_barrier(0)
    Unit cur, nxt; int ui = 0;
    if (!S.next(0, cur)) return;
    f32x4 acc[2][2][4][2];
#pragma unroll
    for (int a = 0; a < 2; ++a)
#pragma unroll
        for (int b = 0; b < 2; ++b)
#pragma unroll
            for (int m = 0; m < 4; ++m)
#pragma unroll
                for (int n = 0; n < 2; ++n) acc[a][b][m][n] = (f32x4){0.f, 0.f, 0.f, 0.f};
    bf16x8 At[4][2], B0[2][2], B1[2][2];
    const char* cA = cur.A; const char* cB = cur.B;
    unsigned vA0[2], vA1[2], nA0[2], nA1[2];
#pragma unroll
    for (int i = 0; i < 2; ++i) { vA0[i] = S.a_row(cur, Rl[i], K) + (unsigned)Cl[i] * 2u; vA1[i] = S.a_row(cur, HALF + Rl[i], K) + (unsigned)Cl[i] * 2u; nA0[i] = vA0[i]; nA1[i] = vA1[i]; }
    PG8_STAGE(PG8_SB(0, 0), cB, voffB); PG8_STAGE(PG8_SB(0, 1), cB + hstep, voffB); PG8_STAGE(PG8_SA(0, 0), cA, vA0); PG8_STAGE(PG8_SA(0, 1), cA, vA1);
    if (wr == 1) PG8_BAR;
    PG8_WAIT_V(2); PG8_BAR;
    PG8_STAGE(PG8_SB(1, 0), cB + kstep, voffB); PG8_STAGE(PG8_SA(1, 0), cA + kstep, vA0); PG8_STAGE(PG8_SB(1, 1), cB + hstep + kstep, voffB);
    PG8_WAIT_V(6); PG8_BAR;
    for (;;) {
        const bool has_next = S.next(ui + 1, nxt);
        const char* nA = has_next ? nxt.A : cA; const char* nB = has_next ? nxt.B : cB;
        if (has_next) {
#pragma unroll
            for (int i = 0; i < 2; ++i) { nA0[i] = S.a_row(nxt, Rl[i], K) + (unsigned)Cl[i] * 2u; nA1[i] = S.a_row(nxt, HALF + Rl[i], K) + (unsigned)Cl[i] * 2u; }
        }
#pragma nounroll
        for (int t = 0; t < nt; t += 2) {
            const bool last = (t == nt - 2);
            const char* a1 = cA + (size_t)(t + 1) * kstep;
            const char* a2 = last ? nA : cA + (size_t)(t + 2) * kstep; const char* b2 = last ? nB : cB + (size_t)(t + 2) * kstep;
            const char* a3 = a2 + kstep; const char* b3 = b2 + kstep;
            unsigned w0[2], w1[2];
#pragma unroll
            for (int i = 0; i < 2; ++i) { w0[i] = last ? nA0[i] : vA0[i]; w1[i] = last ? nA1[i] : vA1[i]; }
            PG8_LDB(B0, 0, 0); PG8_LDB(B1, 0, 1); PG8_SCHED; PG8_LDA(At, 0, 0); PG8_STAGE(PG8_SA(1, 1), a1, vA1);
            PG8_WAIT_V(8); PG8_WAIT_L(0); PG8_BAR; PG8_MMA(0, 0, At, B0); PG8_MMA(0, 1, At, B1); PG8_BAR; PG8_SCHED;
            PG8_LDA(At, 0, 1); PG8_STAGE(PG8_SB(0, 0), b2, voffB); PG8_STAGE(PG8_SB(0, 1), b2 + hstep, voffB); PG8_STAGE(PG8_SA(0, 0), a2, w0);
            PG8_WAIT_V(8); PG8_WAIT_L(0); PG8_BAR; PG8_MMA(1, 0, At, B0); PG8_MMA(1, 1, At, B1); PG8_BAR; PG8_SCHED;
            PG8_LDB(B0, 1, 0); PG8_LDB(B1, 1, 1); PG8_SCHED; PG8_LDA(At, 1, 0); PG8_STAGE(PG8_SA(0, 1), a2, w1);
            PG8_WAIT_V(8); PG8_WAIT_L(0); PG8_BAR; PG8_MMA(0, 0, At, B0); PG8_MMA(0, 1, At, B1); PG8_BAR; PG8_SCHED;
            PG8_LDA(At, 1, 1); PG8_STAGE(PG8_SB(1, 0), b3, voffB); PG8_STAGE(PG8_SB(1, 1), b3 + hstep, voffB); PG8_STAGE(PG8_SA(1, 0), a3, w0);
            PG8_WAIT_V(8); PG8_WAIT_L(0); PG8_BAR; PG8_MMA(1, 0, At, B0); PG8_MMA(1, 1, At, B1); PG8_BAR; PG8_SCHED;
        }
        if (wr == 0) PG8_BAR;
        E(acc, cur, wr, wc, fr, fq);
        if (!has_next) break;
#pragma unroll
        for (int a = 0; a < 2; ++a)
#pragma unroll
            for (int b = 0; b < 2; ++b)
#pragma unroll
                for (int m = 0; m < 4; ++m)
#pragma unroll
                    for (int n = 0; n < 2; ++n) acc[a][b][m][n] = (f32x4){0.f, 0.f, 0.f, 0.f};
        cur = nxt; cA = nA; cB = nB; ++ui;
#pragma unroll
        for (int i = 0; i < 2; ++i) { vA0[i] = nA0[i]; vA1[i] = nA1[i]; }
        if (wr == 1) PG8_BAR;
    }
    PG8_WAIT_V(0);
    PG8_BAR;
#undef PG8_SA
#undef PG8_SB
#undef PG8_STAGE
#undef PG8_LDA
#undef PG8_LDB
#undef PG8_MMA
#undef PG8_WAIT_V
#undef PG8_WAIT_L
#undef PG8_BAR
#undef PG8_SCHED
}

struct DenseOrder {
    const char* A; const char* Bt; int K, nM, nN, nwg, G, c, pn0;
    __device__ void init(const void* A_, const void* Bt_, int M, int N, int K_, int G_, int c_, int pn0_ = 0) { A = (const char*)A_; Bt = (const char*)Bt_; K = K_; nM = M / BM; nN = N / BM; nwg = nM * nN; G = G_; c = c_; pn0 = pn0_; }
    __device__ __forceinline__ bool next(int i, Unit& u) const {
        const long L = (long)i * G + c; if (L >= nwg) return false;
        int wgid = (int)L; { const int q = nwg / NXCD, r = nwg % NXCD, xcd = wgid % NXCD, off = wgid / NXCD; wgid = (xcd < r ? xcd * (q + 1) : r * (q + 1) + (xcd - r) * q) + off; }
        const int nig = WGM * nN, gid = wgid / nig, fm = gid * WGM, gsz = (nM - fm) < WGM ? (nM - fm) : WGM;
        u.pm = fm + ((wgid % nig) % gsz); u.pn = pn0 + (wgid % nig) / gsz; u.e = 0; u.nrows = BM; u.seg = 0;
        u.A = A + (size_t)u.pm * BM * K * 2; u.B = Bt + (size_t)u.pn * BM * K * 2; return true;
    }
    __device__ __forceinline__ unsigned a_row(const Unit&, int r, int K_) const { return (unsigned)(r * K_) * 2u; }
};
}

struct EpiInProj {
    static constexpr bool PERM = true;
    unsigned char* ws; const float2* RT;
    __device__ __forceinline__ void operator()(const f32x4 (&acc)[2][2][4][2], const pg8::Unit& u, int wr, int wc, int fr, int fq) const {
        const int seg = u.pn >> 1;
        bf16_t* dst = (bf16_t*)(ws + (seg == 0 ? WS_Q : seg == 1 ? WS_K : seg == 2 ? WS_V : seg == 3 ? WS_XR : WS_GG));
        const int row0 = u.pm * 256 + wr * 64 + fr, col0 = (u.pn & 1) * 256 + wc * 32 + 8 * fq;
        const bool rope = (seg <= 1) && ((wc & 1) == 0);
#pragma unroll
        for (int ai = 0; ai < 2; ++ai)
#pragma unroll
            for (int m = 0; m < 4; ++m) { const int row = row0 + ai * 128 + m * 16, pos = row & (SEQ - 1);
#pragma unroll
                for (int bj = 0; bj < 2; ++bj) { f32x4 v0 = acc[ai][bj][m][0], v1 = acc[ai][bj][m][1];
                    if (rope) {
                        f32x4 p0, p1;
                        p0.x = __shfl_xor(v0.x, 16); p0.y = __shfl_xor(v0.y, 16); p0.z = __shfl_xor(v0.z, 16); p0.w = __shfl_xor(v0.w, 16);
                        p1.x = __shfl_xor(v1.x, 16); p1.y = __shfl_xor(v1.y, 16); p1.z = __shfl_xor(v1.z, 16); p1.w = __shfl_xor(v1.w, 16);
                        if (fq < 2) { const float2* cs = RT + pos * 8; const float sg = (fq == 0) ? -1.f : 1.f;
                            const float2 c0 = cs[0], c1 = cs[1], c2 = cs[2], c3 = cs[3], c4 = cs[4], c5 = cs[5], c6 = cs[6], c7 = cs[7];
                            v0.x = v0.x * c0.x + sg * p0.x * c0.y; v0.y = v0.y * c1.x + sg * p0.y * c1.y; v0.z = v0.z * c2.x + sg * p0.z * c2.y; v0.w = v0.w * c3.x + sg * p0.w * c3.y;
                            v1.x = v1.x * c4.x + sg * p1.x * c4.y; v1.y = v1.y * c5.x + sg * p1.y * c5.y; v1.z = v1.z * c6.x + sg * p1.z * c6.y; v1.w = v1.w * c7.x + sg * p1.w * c7.y; }
                    }
                    if (seg == 0) { v0 = v0 * QSCALE; v1 = v1 * QSCALE; }
                    if (seg == 4) { v0.x = gelu_tanh(v0.x); v0.y = gelu_tanh(v0.y); v0.z = gelu_tanh(v0.z); v0.w = gelu_tanh(v0.w); v1.x = gelu_tanh(v1.x); v1.y = gelu_tanh(v1.y); v1.z = gelu_tanh(v1.z); v1.w = gelu_tanh(v1.w); }
                    u32x4 w; w.x = pk2(v0.x, v0.y); w.y = pk2(v0.z, v0.w); w.z = pk2(v1.x, v1.y); w.w = pk2(v1.z, v1.w);
                    *(u32x4*)(dst + (size_t)row * 512 + col0 + bj * 128) = w; } }
    }
};
__device__ __forceinline__ void phase1(const Args& a, LAS unsigned char* lds, int G, int c, int pn0, int ncols) {
    unsigned char* ws = a.ws;
    pg8::DenseOrder S; S.init(ws + WS_XN, ws + WS_WIN, MTOK, ncols, DM, G, c, pn0);
    EpiInProj E{ws, (const float2*)(ws + WS_RT)};
    pg8::gemm_phase(lds, DM, S, E);
}

namespace att {
constexpr int DQK = 64, DV = 128, QBLK = 32, KVBLK = 64, LD = 512;
constexpr float SCALE = 0.125f, THR = 8.f;
constexpr int SHM_V = KVBLK * DV * 2, SHM_K = KVBLK * DQK * 2, SHM_ATTN = 2 * SHM_V + 2 * SHM_K + NWAVES * 64 * 4;
#define KSWZ(row, colB) ((row) * 128 + ((colB) ^ ((((row) >> 1) & 7) << 4)))
#define SBAR() __builtin_amdgcn_sched_barrier(0)
__device__ __forceinline__ int crow(int r, int hi) { return (r & 3) + 8 * (r >> 2) + 4 * hi; }
__device__ __forceinline__ float max3f(float a, float b, float c) { float r; asm("v_max3_f32 %0, %1, %2, %3" : "=v"(r) : "v"(a), "v"(b), "v"(c)); return r; }
__device__ __forceinline__ unsigned cvtpk(float lo, float hi) { unsigned r; asm volatile("v_cvt_pk_bf16_f32 %0, %1, %2" : "=v"(r) : "v"(lo), "v"(hi)); return r; }

constexpr float THRL = 11.0f;
__device__ __forceinline__ float rowmax_a(const f32x16& p0) {
    float pmax = p0[0];
#pragma unroll
    for (int r = 1; r < 16; ++r) pmax = fmaxf(pmax, p0[r]);
    return pmax;
}
__device__ __forceinline__ float rowmax_b(const f32x16& p1, float pmax) {
#pragma unroll
    for (int r = 0; r < 16; ++r) pmax = fmaxf(pmax, p1[r]);
    auto rr = __builtin_amdgcn_permlane32_swap(__float_as_uint(pmax), __float_as_uint(pmax), false, false);
    return fmaxf(__uint_as_float(rr[0]), __uint_as_float(rr[1]));
}
template <bool FIRST> __device__ __forceinline__ void decide(float rm, f32x16& p0, f32x16& p1, float& mhat, f32x16& negm, float& alpha) {
    alpha = 1.f;
    if (FIRST || __builtin_expect(__any(rm > THRL), 0)) {
        const float dl = FIRST ? rm : fmaxf(rm, 0.f);
        mhat += dl;
#pragma unroll
        for (int r = 0; r < 16; ++r) { p0[r] -= dl; p1[r] -= dl; }
#pragma unroll
        for (int r = 0; r < 16; ++r) negm[r] = -mhat;
        alpha = __builtin_amdgcn_exp2f(-dl);
    }
}
template <int VAR> __device__ __forceinline__ void exp16(f32x16& p) {
#pragma unroll
    for (int r = 0; r < 16; ++r) p[r] = (VAR & 2) ? p[r] * 0.001f : __builtin_amdgcn_exp2f(p[r]);
}
template <int VAR> __device__ __forceinline__ float expsum16(f32x16& p) {
    exp16<VAR>(p);
    float ps = 0;
#pragma unroll
    for (int r = 0; r < 16; ++r) ps += p[r];
    return ps;
}
__device__ __forceinline__ float halves_sum(float ps) {
    auto rr = __builtin_amdgcn_permlane32_swap(__float_as_uint(ps), __float_as_uint(ps), false, false);
    return __uint_as_float(rr[0]) + __uint_as_float(rr[1]);
}
__device__ __forceinline__ void pack4(const f32x16& p0, const f32x16& p1, bf16x8& pa0, bf16x8& pa1, bf16x8& pa2, bf16x8& pa3) {
#define PK4(P, BASE, OUT) do { u32x4 w = {cvtpk(P[BASE + 0], P[BASE + 1]), cvtpk(P[BASE + 2], P[BASE + 3]), cvtpk(P[BASE + 4], P[BASE + 5]), cvtpk(P[BASE + 6], P[BASE + 7])}; OUT = *reinterpret_cast<bf16x8*>(&w); } while (0)
    PK4(p0, 0, pa0); PK4(p0, 8, pa1); PK4(p1, 0, pa2); PK4(p1, 8, pa3);
#undef PK4
}
typedef short v4i16_t __attribute__((ext_vector_type(4)));
__device__ __forceinline__ s16x4 vtr(const LAS char* p) { return __builtin_bit_cast(s16x4, __builtin_amdgcn_ds_read_tr16_b64_v4i16((LAS v4i16_t*)p)); }
__device__ __forceinline__ void glds16(const void* gsrc, unsigned lds_dst) { unsigned keep;
    asm volatile("s_mov_b32 %0, m0\n\ts_mov_b32 m0, %2\n\ts_nop 0\n\tglobal_load_lds_dwordx4 %1, off\n\ts_mov_b32 m0, %0" : "=&s"(keep) : "v"(gsrc), "s"(lds_dst) : "memory"); }
#define WAIT_BAR(N) asm volatile("s_waitcnt vmcnt(" #N ") lgkmcnt(0)\n\ts_barrier" ::: "memory")

constexpr int NKS = 4, NVS = 5, SHM_VR = NVS * SHM_V, SHM_KR = NKS * SHM_K, SHM_ATTN2 = SHM_VR + SHM_KR + NWAVES * 64 * 4;
template <int VAR> __device__ __forceinline__ void attn_pass(const bf16_t* __restrict__ Qb, const bf16_t* __restrict__ Kh, const bf16_t* __restrict__ Vh, int seq, char* lds,
                                          f32x16 (&o)[4], float (&rli)[16], bool prefetched, const bf16_t* nKh, const bf16_t* nVh) {
    int tid_ = threadIdx.x; asm volatile("" : "+v"(tid_));
    const int tid = tid_, lane = tid & 63, r32 = lane & 31, hi = lane >> 5; const int wid = __builtin_amdgcn_readfirstlane(tid >> 6);
    char* V_lds = lds; char* K_lds = lds + SHM_VR;
    float* wsf = (float*)(lds + SHM_VR + SHM_KR) + wid * 64; float* li_l = wsf; float* al_l = wsf + 32;
    const unsigned ldsV = (unsigned)(uintptr_t)V_lds, ldsK = (unsigned)(uintptr_t)K_lds;
    float mhat = 0.f, l_reg = 0.f; f32x16 negm = f32x16{};
#pragma unroll
    for (int d = 0; d < 4; ++d) o[d] = f32x16{};
    bf16x8 qr[4];
    const bf16_t* Qw = Qb + (long)(wid * QBLK + r32) * LD + hi * 8;
#pragma unroll
    for (int d0 = 0; d0 < 4; ++d0) qr[d0] = *reinterpret_cast<const bf16x8*>(Qw + d0 * 16);
    const bf16_t* ksrc = Kh + (long)lane * LD + wid * 8;
    const bf16_t* vsrc0 = Vh + (long)(16 * (wid & 3) + (lane >> 2)) * LD + (wid >> 2) * 32 + (lane & 3) * 8;
    const bf16_t* vsrc1 = vsrc0 + 64;
    const unsigned kdst = ldsK + wid * 1024, vdst0 = ldsV + wid * 1024, vdst1 = ldsV + (wid + 8) * 1024;
#define DMA(t, ko, vo) do { const long go_ = (long)(t) * KVBLK * LD; \
        glds16(ksrc + go_, (unsigned)__builtin_amdgcn_readfirstlane(kdst + (ko))); \
        glds16(vsrc0 + go_, (unsigned)__builtin_amdgcn_readfirstlane(vdst0 + (vo))); \
        glds16(vsrc1 + go_, (unsigned)__builtin_amdgcn_readfirstlane(vdst1 + (vo))); } while (0)
#define RESC(al) do { if (__any((al) < 1.f)) { if (hi == 0) al_l[r32] = (al); asm volatile("s_waitcnt lgkmcnt(0)" ::: "memory"); \
    _Pragma("unroll") for (int d = 0; d < 4; ++d) _Pragma("unroll") for (int r = 0; r < 16; ++r) o[d][r] *= al_l[crow(r, hi)]; } } while (0)
    f32x16 pA0, pA1, pB0, pB1; const int NT = seq / KVBLK;
    int kr_ = 0, kw_ = 3 * SHM_K, vr_ = 4 * SHM_V, vw_ = 3 * SHM_V;
#define ROT() do { kr_ = (kr_ == 3 * SHM_K) ? 0 : kr_ + SHM_K; kw_ = (kw_ == 3 * SHM_K) ? 0 : kw_ + SHM_K; vr_ = (vr_ == 4 * SHM_V) ? 0 : vr_ + SHM_V; vw_ = (vw_ == 4 * SHM_V) ? 0 : vw_ + SHM_V; } while (0)
    const LAS char* K3 = (const LAS char*)K_lds + hi * 1024 + r32 * 16;
    const LAS char* V3 = (const LAS char*)V_lds + ((lane >> 4) & 1) * 32 + (lane & 3) * 8 + (4 * hi + ((lane & 15) >> 2)) * 64;
    bf16x8 kf[4]; s16x4 vlo[8], vhi[8]; bf16x8 pa[4];
#define KRD(i) do { if (VAR & 64) kf[(i) & 3] = qr[(i) & 3]; else kf[(i) & 3] = *(const LAS bf16x8*)(kp_ + ((i) >> 1) * 2048 + ((i) & 1) * 512); } while (0)
#define VRD(i) do { if (VAR & 32) { vlo[(i) & 7] = (s16x4){qr[0][0], qr[1][1], qr[2][2], qr[3][3]}; vhi[(i) & 7] = (s16x4){qr[0][4], qr[1][5], qr[2][6], qr[3][7]}; } \
                    else { vlo[(i) & 7] = vtr(vp_ + ((i) & 3) * 4096 + ((i) >> 2) * 1024); vhi[(i) & 7] = vtr(vp_ + ((i) & 3) * 4096 + ((i) >> 2) * 1024 + 512); } } while (0)
#define VFR(s) (bf16x8){vlo[s][0], vlo[s][1], vlo[s][2], vlo[s][3], vhi[s][0], vhi[s][1], vhi[s][2], vhi[s][3]}
#define QKM(PC0, PC1, i) do { if (VAR & 16) { if (((i) >> 1) == 0) { if (((i) & 1) == 0) PC0 = negm; else PC1 = negm; } if (((i) & 1) == 0) PC0[(i)] += __builtin_bit_cast(float, (int)kf[(i) & 3][0]); else PC1[(i)] += __builtin_bit_cast(float, (int)kf[(i) & 3][1]); } \
        else if (((i) & 1) == 0) PC0 = __builtin_amdgcn_mfma_f32_32x32x16_bf16(kf[(i) & 3], qr[(i) >> 1], ((i) >> 1) == 0 ? negm : PC0, 0, 0, 0); \
        else PC1 = __builtin_amdgcn_mfma_f32_32x32x16_bf16(kf[(i) & 3], qr[(i) >> 1], ((i) >> 1) == 0 ? negm : PC1, 0, 0, 0); } while (0)
#define PVM(i) do { if (VAR & 8) o[(i) & 3][(i)] += __builtin_bit_cast(float, (int)(pa[(i) >> 2][0] + vlo[(i) & 7][0] + vhi[(i) & 7][1])); else o[(i) & 3] = __builtin_amdgcn_mfma_f32_32x32x16_bf16(pa[(i) >> 2], VFR((i) & 7), o[(i) & 3], 0, 0, 0); } while (0)
#define PKA(P, B) do { ca0_ = cvtpk(P[B + 0], P[B + 1]); ca1_ = cvtpk(P[B + 2], P[B + 3]); cb0_ = cvtpk(P[B + 4], P[B + 5]); cb1_ = cvtpk(P[B + 6], P[B + 7]); } while (0)
#define PKB(k) do { u32x4 w_ = {ca0_, ca1_, cb0_, cb1_}; pa[k] = __builtin_bit_cast(bf16x8, w_); } while (0)
#define MAX8(acc, P, B) if (!(VAR & 256)) { acc = max3f(acc, P[B], P[B + 1]); pmb_ = max3f(pmb_, P[B + 2], P[B + 3]); acc = max3f(acc, P[B + 4], P[B + 5]); pmb_ = max3f(pmb_, P[B + 6], P[B + 7]); }
#define EX4(P, B) do { P[B] = (VAR & 2) ? P[B] * 0.001f : __builtin_amdgcn_exp2f(P[B]); P[B + 1] = (VAR & 2) ? P[B + 1] * 0.001f : __builtin_amdgcn_exp2f(P[B + 1]); \
                       P[B + 2] = (VAR & 2) ? P[B + 2] * 0.001f : __builtin_amdgcn_exp2f(P[B + 2]); P[B + 3] = (VAR & 2) ? P[B + 3] * 0.001f : __builtin_amdgcn_exp2f(P[B + 3]); \
                       ps2_ += (f32x2){P[B], P[B + 1]}; ps2_ += (f32x2){P[B + 2], P[B + 3]}; } while (0)
#define ENDW(j) do { if (VAR & 2048) { asm volatile("s_waitcnt lgkmcnt(0)" ::: "memory"); } else if ((j) + 3 < NT) WAIT_BAR(6); else if ((j) + 2 < NT) WAIT_BAR(3); else WAIT_BAR(0); } while (0)
    if (!prefetched) { __syncthreads();
        DMA(0, 0, 0); DMA(1, SHM_K, SHM_V); DMA(2, 2 * SHM_K, 2 * SHM_V);
        WAIT_BAR(6); }
    else WAIT_BAR(0);
    { DMA(3, kw_, vw_); SBAR();
      const LAS char* kp_ = K3 + kr_;
      KRD(0); KRD(1); KRD(2); KRD(3);
      QKM(pA0, pA1, 0); KRD(4); QKM(pA0, pA1, 1); KRD(5); QKM(pA0, pA1, 2); KRD(6); QKM(pA0, pA1, 3); KRD(7);
      QKM(pA0, pA1, 4); QKM(pA0, pA1, 5); QKM(pA0, pA1, 6); QKM(pA0, pA1, 7);
      const float rm = rowmax_b(pA1, rowmax_a(pA0)); float al_; decide<true>(rm, pA0, pA1, mhat, negm, al_); float ps = expsum16<VAR>(pA0); ps += expsum16<VAR>(pA1); l_reg = halves_sum(ps); }
    ENDW(0); ROT();
#define STEP(PC0, PC1, PP0, PP1, j) do { \
        if (!(VAR & 4096)) { if ((j) + 3 < NT) DMA((j) + 3, kw_, vw_); } SBAR(); \
        const LAS char* kp_ = K3 + kr_; const LAS char* vp_ = V3 + vr_; \
        unsigned ca0_, ca1_, cb0_, cb1_; float pmx_, pmb_, al_; f32x2 ps2_ = (f32x2){0.f, 0.f}; \
        KRD(0); KRD(1); KRD(2); KRD(3); VRD(0); VRD(1); PKA(PP0, 0); PKB(0); PKA(PP0, 8); PKB(1); SBAR(); \
        QKM(PC0, PC1, 0); KRD(4); VRD(2); PKA(PP1, 0); SBAR(); \
        QKM(PC0, PC1, 1); KRD(5); VRD(3); PKB(2); SBAR(); \
        QKM(PC0, PC1, 2); KRD(6); VRD(4); PKA(PP1, 8); SBAR(); \
        QKM(PC0, PC1, 3); KRD(7); VRD(5); PKB(3); SBAR(); \
        QKM(PC0, PC1, 4); VRD(6); SBAR(); \
        QKM(PC0, PC1, 5); VRD(7); SBAR(); \
        QKM(PC0, PC1, 6); SBAR(); \
        QKM(PC0, PC1, 7); SBAR(); \
        PVM(0); VRD(8); pmx_ = PC0[0]; pmb_ = PC0[2]; MAX8(pmx_, PC0, 0); SBAR(); \
        PVM(1); VRD(9); MAX8(pmx_, PC0, 8); SBAR(); \
        PVM(2); VRD(10); MAX8(pmx_, PC1, 0); SBAR(); \
        PVM(3); VRD(11); MAX8(pmx_, PC1, 8); pmx_ = fmaxf(pmx_, pmb_); { auto rr_ = __builtin_amdgcn_permlane32_swap(__float_as_uint(pmx_), __float_as_uint(pmx_), false, false); pmx_ = fmaxf(__uint_as_float(rr_[0]), __uint_as_float(rr_[1])); } SBAR(); \
        PVM(4); VRD(12); decide<false>(pmx_, PC0, PC1, mhat, negm, al_); SBAR(); \
        PVM(5); VRD(13); EX4(PC0, 0); SBAR(); \
        PVM(6); VRD(14); EX4(PC0, 4); SBAR(); \
        PVM(7); VRD(15); EX4(PC0, 8); SBAR(); \
        PVM(8); EX4(PC0, 12); SBAR(); \
        PVM(9); EX4(PC1, 0); SBAR(); \
        PVM(10); EX4(PC1, 4); SBAR(); \
        PVM(11); EX4(PC1, 8); SBAR(); \
        PVM(12); EX4(PC1, 12); SBAR(); \
        PVM(13); l_reg = l_reg * al_ + halves_sum(ps2_.x + ps2_.y); SBAR(); \
        PVM(14); PVM(15); SBAR(); \
        ENDW(j); RESC(al_); ROT(); } while (0)
    for (int j = 1; j + 1 < NT; j += 2) {
        STEP(pB0, pB1, pA0, pA1, j);
        STEP(pA0, pA1, pB0, pB1, j + 1);
    }
    STEP(pB0, pB1, pA0, pA1, NT - 1);
    if (nKh) {
        const bf16_t* ksrcn = nKh + (long)lane * LD + wid * 8; const bf16_t* vsrcn = nVh + (long)(16 * (wid & 3) + (lane >> 2)) * LD + (wid >> 2) * 32 + (lane & 3) * 8;
#pragma unroll
        for (int t = 0; t < 3; ++t) { const long go_ = (long)t * KVBLK * LD;
            glds16(ksrcn + go_, (unsigned)__builtin_amdgcn_readfirstlane(kdst + t * SHM_K));
            glds16(vsrcn + go_, (unsigned)__builtin_amdgcn_readfirstlane(vdst0 + t * SHM_V));
            glds16(vsrcn + 64 + go_, (unsigned)__builtin_amdgcn_readfirstlane(vdst1 + t * SHM_V)); } }
    { const LAS char* vp_ = V3 + vr_; unsigned ca0_, ca1_, cb0_, cb1_;
      PKA(pB0, 0); PKB(0); PKA(pB0, 8); PKB(1); PKA(pB1, 0); PKB(2); PKA(pB1, 8); PKB(3);
      VRD(0); VRD(1); VRD(2); VRD(3); VRD(4); VRD(5); VRD(6); VRD(7);
      PVM(0); VRD(8); PVM(1); VRD(9); PVM(2); VRD(10); PVM(3); VRD(11); PVM(4); VRD(12); PVM(5); VRD(13); PVM(6); VRD(14); PVM(7); VRD(15);
      PVM(8); PVM(9); PVM(10); PVM(11); PVM(12); PVM(13); PVM(14); PVM(15); }
    if (hi == 0) li_l[r32] = l_reg; asm volatile("s_waitcnt lgkmcnt(0)" ::: "memory");
#pragma unroll
    for (int r = 0; r < 16; ++r) rli[r] = __builtin_amdgcn_rcpf(li_l[crow(r, hi)]);
#undef DMA
#undef RESC
#undef ROT
#undef KRD
#undef VRD
#undef VFR
#undef QKM
#undef PVM
#undef PKA
#undef PKB
#undef MAX8
#undef EX4
#undef ENDW
#undef STEP
}
#undef WAIT_BAR
#undef KSWZ
#undef SBAR
}

template <int VAR> __device__ __forceinline__ void phase2_attn(const Args& a, char* lds, int nblk, int blk) {
    unsigned char* ws = a.ws;
    const bf16_t* Qb = (const bf16_t*)(ws + WS_Q); const bf16_t* Kb = (const bf16_t*)(ws + WS_K); const bf16_t* Vb = (const bf16_t*)(ws + WS_V);
    float* OS = (float*)(ws + WS_O0) + (size_t)blk * 32768;
    bf16_t* MIX = (bf16_t*)(ws + WS_MIX);
    const float lambda_init = 0.2f;
    float lam;
    { const int l0 = threadIdx.x & 63; const float d1 = wave_sum(a.in[3][l0] * a.in[4][l0]), d2 = wave_sum(a.in[5][l0] * a.in[6][l0]); lam = expf(d1) - expf(d2) + lambda_init; }
    const int seq = (VAR & 16384) ? SEQ / 2 : SEQ;
    bool pref = false;
    for (int u = blk; u < NBATCH * 4 * 16; u += nblk) {
        const int b = u >> 6, h = (u >> 4) & 3, qb = u & 15;
        const long row0 = (long)b * SEQ + qb * 256;
        const bf16_t* Kbh = Kb + (long)b * SEQ * 512 + h * 128; const bf16_t* Vbh = Vb + (long)b * SEQ * 512 + h * 128;
        const int un = u + nblk; const bool hasn = un < NBATCH * 4 * 16;
        const bf16_t* Kn = hasn ? Kb + (long)(un >> 6) * SEQ * 512 + ((un >> 4) & 3) * 128 : nullptr; const bf16_t* Vn = hasn ? Vb + (long)(un >> 6) * SEQ * 512 + ((un >> 4) & 3) * 128 : nullptr;
        for (int m = 0; m < 2; ++m) {
            f32x16 o[4]; float rli[16];
            att::attn_pass<VAR>(Qb + row0 * 512 + (h * 2 + m) * 64, Kbh + m * 64, Vbh, seq, lds, o, rli, pref, m == 0 ? Kbh + 64 : Kn, m == 0 ? Vbh : Vn);
            pref = (m == 0) || hasn;
            int tid_ = threadIdx.x; asm volatile("" : "+v"(tid_));
            const int wid = tid_ >> 6, r32 = tid_ & 31, hi = (tid_ >> 5) & 1;
            float* od = OS + (wid * 32) * 128 + r32;
            if (m == 0) {
#pragma unroll
                for (int r = 0; r < 16; ++r) { const int orow = att::crow(r, hi);
#pragma unroll
                    for (int d0 = 0; d0 < 4; ++d0) od[orow * 128 + d0 * 32] = o[d0][r] * rli[r]; }
            } else {
                float ss[16];
#pragma unroll
                for (int r = 0; r < 16; ++r) ss[r] = 0.f;
#pragma unroll
                for (int d0 = 0; d0 < 4; ++d0) {
#pragma unroll
                    for (int r = 0; r < 16; ++r) { const float v = od[att::crow(r, hi) * 128 + d0 * 32] - lam * (o[d0][r] * rli[r]); o[d0][r] = v; ss[r] = fmaf(v, v, ss[r]); }
                    asm volatile("" ::: "memory"); }
                float gs[4];
#pragma unroll
                for (int d0 = 0; d0 < 4; ++d0) gs[d0] = a.in[7][d0 * 32 + r32] * (1.0f - lambda_init);
                bf16_t* dst = MIX + (size_t)(row0 + wid * 32) * 1024 + h * 128 + r32;
#pragma unroll
                for (int r = 0; r < 16; ++r) { float s = ss[r];
                    s += __shfl_xor(s, 1); s += __shfl_xor(s, 2); s += __shfl_xor(s, 4); s += __shfl_xor(s, 8); s += __shfl_xor(s, 16);
                    const float rstd = 1.0f / sqrtf(s * (1.0f / 128.f) + EPS);
                    if (VAR == 0) {
#pragma unroll
                        for (int d0 = 0; d0 < 4; ++d0) dst[att::crow(r, hi) * 1024 + d0 * 32] = (bf16_t)f2bf(o[d0][r] * rstd * gs[d0]); }
                    else if (rstd == 123.456f) dst[0] = 1; }
            }
        }
    }
}

constexpr int LRU_XS = 68;
constexpr int LRU_HS = 36;
__device__ __forceinline__ void phase2_lru(const Args& a, LAS unsigned char* lds, int nblk, int blk) {
    unsigned char* ws = a.ws;
    const bf16_t* XR = (const bf16_t*)(ws + WS_XR); const bf16_t* GG = (const bf16_t*)(ws + WS_GG);
    float* H1 = (float*)(ws + WS_HF); bf16_t* MIX = (bf16_t*)(ws + WS_MIX);
    LAS float* xcf = (LAS float*)lds;
    LAS float* hsm = xcf + 2 * 2 * 64 * LRU_XS;
    const int tid = threadIdx.x, lane = tid & 63, wave = __builtin_amdgcn_readfirstlane(tid >> 6);
    const int c16 = lane & 15, fq = lane >> 4;
    const int sch = tid & 63, sdir = wave >> 2, sp0 = 16 * (wave & 3);
    const int dir = wave >> 1, cth = wave & 1;
    const int io = tid & 255, ic4 = io & 7, iorow = io >> 3;
    for (int u = blk; u < NBATCH * 16; u += nblk) {
        const int b = u >> 4, kb = (u >> 1) & 7, chalf = u & 1;
        const bf16_t* XRb = XR + (size_t)b * SEQ * 512; const bf16_t* GGb = GG + (size_t)b * SEQ * 512; float* H1b = H1 + (size_t)b * SEQ * 512; bf16_t* MIXb = MIX + (size_t)b * SEQ * 1024;
        const int schg = kb * 64 + sch;
        float k0, k1, k2, k3; const float cbias = a.in[9][schg];
        { const float w0 = a.in[8][0 * 512 + schg], w1 = a.in[8][1 * 512 + schg], w2 = a.in[8][2 * 512 + schg], w3 = a.in[8][3 * 512 + schg];
          if (sdir == 0) { k0 = w0; k1 = w1; k2 = w2; k3 = w3; } else { k0 = w3; k1 = w2; k2 = w1; k3 = w0; } }
        const int chl = chalf * 32 + cth * 16 + c16, chg = kb * 64 + chl;
        bf16x8 wrf[2], wif[2]; float brs = 0.f, bis = 0.f, kA2 = 0.f;
        if (wave < 4) {
            const float* wrp = a.in[10] + (size_t)(dir * 8 + kb) * 4096 + chl; const float* wip = a.in[12] + (size_t)(dir * 8 + kb) * 4096 + chl;
            constexpr float NL2E = -1.4426950408889634f;
#pragma unroll
            for (int ks = 0; ks < 2; ++ks) { u32x4 pr, pi;
                const int kk = 32 * ks + 8 * fq;
                pr.x = pk2(wrp[(kk + 0) * 64] * NL2E, wrp[(kk + 1) * 64] * NL2E); pr.y = pk2(wrp[(kk + 2) * 64] * NL2E, wrp[(kk + 3) * 64] * NL2E);
                pr.z = pk2(wrp[(kk + 4) * 64] * NL2E, wrp[(kk + 5) * 64] * NL2E); pr.w = pk2(wrp[(kk + 6) * 64] * NL2E, wrp[(kk + 7) * 64] * NL2E);
                pi.x = pk2(wip[(kk + 0) * 64] * NL2E, wip[(kk + 1) * 64] * NL2E); pi.y = pk2(wip[(kk + 2) * 64] * NL2E, wip[(kk + 3) * 64] * NL2E);
                pi.z = pk2(wip[(kk + 4) * 64] * NL2E, wip[(kk + 5) * 64] * NL2E); pi.w = pk2(wip[(kk + 6) * 64] * NL2E, wip[(kk + 7) * 64] * NL2E);
                wrf[ks] = __builtin_bit_cast(bf16x8, pr); wif[ks] = __builtin_bit_cast(bf16x8, pi); }
            brs = a.in[11][dir * 512 + chg] * NL2E; bis = a.in[13][dir * 512 + chg] * NL2E;
            const float nl = -a.in[14][dir * 512 + chg];
            const float sp = (nl > 15.f) ? nl : log1pf(expf(nl));
            kA2 = -8.0f * sp * 1.4426950408889634f;
        }
        float carry = 0.f;
        unsigned short er0[19], er1[19];
        auto stage_ld = [&](int st, unsigned short (&er)[19]) {
            const int t0 = (sdir == 0) ? 64 * st : 64 * (63 - st);
            const int tk0 = (sdir == 0) ? (t0 + sp0) : (t0 + 63 - sp0);
            const int sgn = (sdir == 0) ? 1 : -1, tbase = (sdir == 0) ? tk0 - 2 : tk0 + 1;
#pragma unroll
            for (int i = 0; i < 19; ++i) { const int t = tbase + sgn * i; er[i] = XRb[(long)(t * 512 + schg)]; }
        };
        auto stage_wr = [&](int st, const unsigned short (&er)[19]) {
            const int stc = st < 64 ? st : 63;
            const int t0 = (sdir == 0) ? 64 * stc : 64 * (63 - stc);
            const int tk0 = (sdir == 0) ? (t0 + sp0) : (t0 + 63 - sp0);
            const int sgn = (sdir == 0) ? 1 : -1, tbase = (sdir == 0) ? tk0 - 2 : tk0 + 1;
            float e[19];
            if (stc == 0 || stc == 63) {
#pragma unroll
                for (int i = 0; i < 19; ++i) { const int t = tbase + sgn * i; e[i] = (t >= 0 && t < SEQ) ? bf2f(er[i]) : 0.f; }
            } else {
#pragma unroll
                for (int i = 0; i < 19; ++i) e[i] = bf2f(er[i]);
            }
            LAS float* xd = xcf + ((st & 1) * 2 + sdir) * 64 * LRU_XS + sp0 * LRU_XS + sch;
#pragma unroll
            for (int q = 0; q < 16; ++q) xd[q * LRU_XS] = cbias + k0 * e[q] + k1 * e[q + 1] + k2 * e[q + 2] + k3 * e[q + 3];
        };
        const int ichg = kb * 64 + chalf * 32 + 4 * ic4;
        f32x4 hoth0[4], hoth1[4]; u32x2 ggv0[4], ggv1[4];
        auto io_ld = [&](int st, f32x4 (&hoth)[4], u32x2 (&ggv)[4]) {
#pragma unroll
            for (int k = 0; k < 4; ++k) { const int r = iorow + 32 * k, d = r >> 6, p = r & 63; const int tok = (d == 0) ? 64 * st + p : 64 * (63 - st) + 63 - p;
                hoth[k] = *(const f32x4*)(H1b + (unsigned)(tok * 512 + ichg)); ggv[k] = *(const u32x2*)(GGb + (unsigned)(tok * 512 + ichg)); }
        };
        auto io_out = [&](int st, const f32x4 (&hoth)[4], const u32x2 (&ggv)[4]) {
#pragma unroll
            for (int k = 0; k < 4; ++k) { const int r = iorow + 32 * k, d = r >> 6, p = r & 63; const int tok = (d == 0) ? 64 * st + p : 64 * (63 - st) + 63 - p;
                const f32x4 h = *(const LAS f32x4*)(hsm + ((st & 1) * 2 + d) * 64 * LRU_HS + p * LRU_HS + 4 * ic4);
                if (st < 32) *(f32x4*)(H1b + (unsigned)(tok * 512 + ichg)) = h;
                else { f32x4 g; g.x = __builtin_bit_cast(float, ggv[k].x << 16); g.y = __builtin_bit_cast(float, ggv[k].x & 0xffff0000u); g.z = __builtin_bit_cast(float, ggv[k].y << 16); g.w = __builtin_bit_cast(float, ggv[k].y & 0xffff0000u);
                    store_bf16x4(MIXb + (unsigned)(tok * 1024 + 512 + ichg), (h + hoth[k]) * g); } }
        };
        auto body = [&](int s, bool second, unsigned short (&er)[19], f32x4 (&hoth)[4], u32x2 (&ggv)[4]) {
            stage_wr(s + 1, er);
            stage_ld(s + 3 < 64 ? s + 3 : 63, er);
            if (wave < 4) {
                if (s < 64) {
                const LAS float* xb = xcf + ((s & 1) * 2 + dir) * 64 * LRU_XS;
                LAS float* hb = hsm + ((s & 1) * 2 + dir) * 64 * LRU_HS + cth * 16 + c16;
#pragma unroll
                for (int tt = 0; tt < 4; ++tt) {
                    f32x4 ra = (f32x4){0.f, 0.f, 0.f, 0.f}, ia = (f32x4){0.f, 0.f, 0.f, 0.f};
#pragma unroll
                    for (int ks = 0; ks < 2; ++ks) { const LAS f32x4* xp = (const LAS f32x4*)(xb + (16 * tt + c16) * LRU_XS + 32 * ks + 8 * fq);
                        const f32x4 x0 = xp[0], x1 = xp[1]; u32x4 pa; pa.x = att::cvtpk(x0.x, x0.y); pa.y = att::cvtpk(x0.z, x0.w); pa.z = att::cvtpk(x1.x, x1.y); pa.w = att::cvtpk(x1.z, x1.w);
                        const bf16x8 af = __builtin_bit_cast(bf16x8, pa);
                        ra = __builtin_amdgcn_mfma_f32_16x16x32_bf16(af, wrf[ks], ra, 0, 0, 0);
                        ia = __builtin_amdgcn_mfma_f32_16x16x32_bf16(af, wif[ks], ia, 0, 0, 0); }
                    float Ap[4], Hp[4];
#pragma unroll
                    for (int j = 0; j < 4; ++j) { const float xv = xb[(16 * tt + 4 * fq + j) * LRU_XS + chl];
                        const float r = __builtin_amdgcn_rcpf(1.0f + __builtin_amdgcn_exp2f(ra[j] + brs));
                        const float ig = __builtin_amdgcn_rcpf(1.0f + __builtin_amdgcn_exp2f(ia[j] + bis));
                        const float aa = __builtin_amdgcn_exp2f(kA2 * r);
                        const float uv = __builtin_amdgcn_sqrtf(fmaxf(1.0f - aa * aa, 0.f)) * (ig * xv);
                        if (j == 0) { Ap[0] = aa; Hp[0] = uv; } else { Ap[j] = aa * Ap[j - 1]; Hp[j] = fmaf(aa, Hp[j - 1], uv); } }
                    float Ag = Ap[3], Hg = Hp[3];
                    { const float A1 = __shfl_up(Ag, 16), Hs1 = __shfl_up(Hg, 16); if (fq >= 1) { Hg = fmaf(Ag, Hs1, Hg); Ag = Ag * A1; } }
                    { const float A2 = __shfl_up(Ag, 32), Hs2 = __shfl_up(Hg, 32); if (fq >= 2) { Hg = fmaf(Ag, Hs2, Hg); Ag = Ag * A2; } }
                    float EA = __shfl_up(Ag, 16), EH = __shfl_up(Hg, 16); if (fq == 0) { EA = 1.f; EH = 0.f; }
                    const float TA = __shfl(Ag, 48 + c16), TH = __shfl(Hg, 48 + c16);
                    const float gin = fmaf(EA, carry, EH);
#pragma unroll
                    for (int j = 0; j < 4; ++j) hb[(16 * tt + 4 * fq + j) * LRU_HS] = fmaf(Ap[j], gin, Hp[j]);
                    carry = fmaf(TA, carry, TH);
                }
                }
            } else {
                if (s >= 1) io_out(s - 1, hoth, ggv);
                if (second) io_ld(s + 1 < 64 ? s + 1 : 63, hoth, ggv);
            }
            __syncthreads();
        };
        __syncthreads();
        stage_ld(0, er0); stage_wr(0, er0); stage_ld(1, er1); stage_ld(2, er0);
        __syncthreads();
        body(0, false, er1, hoth1, ggv1);
        for (int s = 1; s <= 31; s += 2) { body(s, false, er0, hoth0, ggv0); body(s + 1, false, er1, hoth1, ggv1); }
        if (wave >= 4) { io_ld(32, hoth0, ggv0); io_ld(33, hoth1, ggv1); }
        for (int s = 33; s <= 63; s += 2) { body(s, true, er0, hoth0, ggv0); body(s + 1, true, er1, hoth1, ggv1); }
    }
}

struct EpiOutProj {
    static constexpr bool PERM = true;
    const float* x; bf16_t* X1;
    __device__ __forceinline__ void operator()(const f32x4 (&acc)[2][2][4][2], const pg8::Unit& u, int wr, int wc, int fr, int fq) const {
        const int row0 = u.pm * 256 + wr * 64 + fr, col0 = u.pn * 256 + wc * 32 + 8 * fq;
#pragma unroll
        for (int ai = 0; ai < 2; ++ai)
#pragma unroll
            for (int m = 0; m < 4; ++m) { const size_t rowoff = (size_t)(row0 + ai * 128 + m * 16) * DM + col0;
#pragma unroll
                for (int bj = 0; bj < 2; ++bj) { const size_t off = rowoff + bj * 128;
                    const f32x4 v0 = *(const f32x4*)(x + off) + acc[ai][bj][m][0], v1 = *(const f32x4*)(x + off + 4) + acc[ai][bj][m][1];
                    u32x4 w; w.x = pk2(v0.x, v0.y); w.y = pk2(v0.z, v0.w); w.z = pk2(v1.x, v1.y); w.w = pk2(v1.z, v1.w);
                    *(u32x4*)(X1 + off) = w; } }
    }
};
__device__ __forceinline__ void phase3(const Args& a, LAS unsigned char* lds, int nblk, int blk) {
    unsigned char* ws = a.ws;
    pg8::DenseOrder S; S.init(ws + WS_MIX, ws + WS_WOUT, MTOK, DM, DM, nblk, blk);
    EpiOutProj E{a.in[0], (bf16_t*)(ws + WS_X1)};
    pg8::gemm_phase(lds, DM, S, E);
}

template <bool DUMMY> __device__ __forceinline__ void phase4(const Args& a, LAS unsigned char* lds, int nblk, int blk) {
    unsigned char* ws = a.ws;
    const bf16_t* X1 = (const bf16_t*)(ws + WS_X1); const float* g2 = a.in[16]; bf16_t* H2 = (bf16_t*)(ws + WS_XN);
    const bf16_t* WRH = (const bf16_t*)(ws + WS_WRH); const bf16_t* WRL = (const bf16_t*)(ws + WS_WRL);
    int* cnt = (int*)(ws + WS_CTL); int* LIST = (int*)(ws + WS_LIST); float* EW = (float*)(ws + WS_EW);
    LAS float* part = (LAS float*)lds;
    LAS float* tot = part + 8 * 16 * 52;
    LAS float* rs = tot + 16 * 52;
    const int tid = threadIdx.x, lane = tid & 63, wave = __builtin_amdgcn_readfirstlane(tid >> 6), r16 = lane & 15, kg = lane >> 4;
    const int kbase = 128 * wave + 8 * kg;
    bf16x8 bh[4][3], bl[4][3];
#pragma unroll
    for (int ks = 0; ks < 4; ++ks)
#pragma unroll
        for (int nt = 0; nt < 3; ++nt) { bh[ks][nt] = *(const bf16x8*)(WRH + (size_t)(16 * nt + r16) * DM + kbase + 32 * ks); bl[ks][nt] = *(const bf16x8*)(WRL + (size_t)(16 * nt + r16) * DM + kbase + 32 * ks); }
    constexpr int NTILE = MTOK / 16;
    LAS float* lg = rs + 16;
    LAS int* lcnt = (LAS int*)(lg + 8 * 16 * 36); LAS int* lbase = lcnt + 32;
    if (tid < NEXP) lcnt[tid] = 0;
    u32x4 xn[4];
    { const int t0 = blk; if (t0 < NTILE) {
#pragma unroll
        for (int ks = 0; ks < 4; ++ks) xn[ks] = *(const u32x4*)(X1 + (size_t)(t0 * 16 + r16) * DM + kbase + 32 * ks); } }
    int ti = 0;
    for (int t = blk; t < NTILE; t += nblk, ++ti) {
        u32x4 xv[4];
#pragma unroll
        for (int ks = 0; ks < 4; ++ks) xv[ks] = xn[ks];
        { const int tn = (t + nblk < NTILE) ? t + nblk : t;
#pragma unroll
          for (int ks = 0; ks < 4; ++ks) xn[ks] = *(const u32x4*)(X1 + (size_t)(tn * 16 + r16) * DM + kbase + 32 * ks); }
        f32x4 acc[3]; acc[0] = (f32x4){0.f, 0.f, 0.f, 0.f}; acc[1] = acc[0]; acc[2] = acc[0];
        float ss = 0.f;
#pragma unroll
        for (int ks = 0; ks < 4; ++ks) { const u32x4 xw = xv[ks];
            const float f0 = __builtin_bit_cast(float, xw.x << 16), f1 = __builtin_bit_cast(float, xw.x & 0xffff0000u), f2 = __builtin_bit_cast(float, xw.y << 16), f3 = __builtin_bit_cast(float, xw.y & 0xffff0000u);
            const float f4 = __builtin_bit_cast(float, xw.z << 16), f5 = __builtin_bit_cast(float, xw.z & 0xffff0000u), f6 = __builtin_bit_cast(float, xw.w << 16), f7 = __builtin_bit_cast(float, xw.w & 0xffff0000u);
            ss += (f0 * f0 + f1 * f1) + (f2 * f2 + f3 * f3) + (f4 * f4 + f5 * f5) + (f6 * f6 + f7 * f7);
            const bf16x8 ah = __builtin_bit_cast(bf16x8, xw);
#pragma unroll
            for (int nt = 0; nt < 3; ++nt) {
                acc[nt] = __builtin_amdgcn_mfma_f32_16x16x32_bf16(ah, bh[ks][nt], acc[nt], 0, 0, 0);
                acc[nt] = __builtin_amdgcn_mfma_f32_16x16x32_bf16(ah, bl[ks][nt], acc[nt], 0, 0, 0); } }
        ss += __shfl_xor(ss, 16); ss += __shfl_xor(ss, 32);
#pragma unroll
        for (int nt = 0; nt < 3; ++nt)
#pragma unroll
            for (int j = 0; j < 4; ++j) part[(wave * 16 + 4 * kg + j) * 52 + 16 * nt + r16] = acc[nt][j];
        if (kg == 0) part[(wave * 16 + r16) * 52 + 48] = ss;
        __syncthreads();
        for (int idx = tid; idx < 16 * 49; idx += NTHREADS) { const int row = idx / 49, o = idx % 49; float s = 0.f;
#pragma unroll
            for (int w = 0; w < 8; ++w) s += part[(w * 16 + row) * 52 + o];
            tot[row * 52 + o] = s; }
        __syncthreads();
        { const float rstd = 1.0f / sqrtf(tot[r16 * 52 + 48] * (1.0f / DM) + EPS);
#pragma unroll
          for (int ks = 0; ks < 4; ++ks) { const f32x4* gp4 = (const f32x4*)(g2 + kbase + 32 * ks); const f32x4 ga = gp4[0], gb = gp4[1]; const u32x4 xw = xv[ks];
              u32x4 w;
              w.x = pk2(__builtin_bit_cast(float, xw.x << 16) * rstd * ga.x, __builtin_bit_cast(float, xw.x & 0xffff0000u) * rstd * ga.y);
              w.y = pk2(__builtin_bit_cast(float, xw.y << 16) * rstd * ga.z, __builtin_bit_cast(float, xw.y & 0xffff0000u) * rstd * ga.w);
              w.z = pk2(__builtin_bit_cast(float, xw.z << 16) * rstd * gb.x, __builtin_bit_cast(float, xw.z & 0xffff0000u) * rstd * gb.y);
              w.w = pk2(__builtin_bit_cast(float, xw.w << 16) * rstd * gb.z, __builtin_bit_cast(float, xw.w & 0xffff0000u) * rstd * gb.w);
              *(u32x4*)(H2 + (size_t)(t * 16 + r16) * DM + kbase + 32 * ks) = w; } }
        for (int idx = tid; idx < 16 * 36; idx += NTHREADS) { const int row = idx / 36, o = idx % 36;
            const float rstd = 1.0f / sqrtf(tot[row * 52 + 48] * (1.0f / DM) + EPS);
            lg[((ti & 7) * 16 + row) * 36 + o] = tot[row * 52 + o] * rstd; }
        const bool lastt = (t + nblk >= NTILE);
        if ((ti & 7) == 7 || lastt) {
            __syncthreads();
            const int nch = (ti & 7) + 1;
            int ea = 0, eb = 0, ra = 0, rb = 0, rowg = 0; float w1 = 0.f, w2 = 0.f;
            const bool act = !DUMMY && tid < nch * 16;
            if (act) {
                const int ci = tid >> 4, row16 = tid & 15;
                const LAS float* tr = lg + (ci * 16 + row16) * 36;
                const float g0 = tr[0], g1 = tr[1], g2l = tr[2], g3 = tr[3];
                int gi = 0; float gm = g0;
                if (g1 > gm) { gm = g1; gi = 1; } if (g2l > gm) { gm = g2l; gi = 2; } if (g3 > gm) { gm = g3; gi = 3; }
                const float gp = 1.0f / (expf(g0 - gm) + expf(g1 - gm) + expf(g2l - gm) + expf(g3 - gm));
                const LAS float* ep = tr + 4 + gi * 8;
                int i1 = 0; float l1 = ep[0];
                for (int j = 1; j < 8; ++j) { const float v = ep[j]; if (v > l1) { l1 = v; i1 = j; } }
                int i2 = -1; float l2 = -3.0e38f;
                for (int j = 0; j < 8; ++j) { const float v = ep[j]; if (j != i1 && v > l2) { l2 = v; i2 = j; } }
                const float e2 = expf(l2 - l1); w1 = gp / (1.0f + e2); w2 = gp * e2 / (1.0f + e2);
                const int tile = t - (nch - 1 - ci) * nblk;
                rowg = tile * 16 + row16; ea = gi * 8 + i1; eb = gi * 8 + i2;
                ra = __hip_atomic_fetch_add((int*)(lcnt + ea), 1, __ATOMIC_RELAXED, __HIP_MEMORY_SCOPE_WORKGROUP); rb = __hip_atomic_fetch_add((int*)(lcnt + eb), 1, __ATOMIC_RELAXED, __HIP_MEMORY_SCOPE_WORKGROUP);
            }
            __syncthreads();
            if (tid < NEXP) { const int n = lcnt[tid]; lbase[tid] = (n > 0) ? atomicAdd(&cnt[tid * 64], n) : 0; lcnt[tid] = 0; }
            __syncthreads();
            if (act) {
                LIST[(size_t)ea * MTOK + lbase[ea] + ra] = rowg * 2 + 0; EW[rowg * 2 + 0] = w1;
                LIST[(size_t)eb * MTOK + lbase[eb] + rb] = rowg * 2 + 1; EW[rowg * 2 + 1] = w2;
            }
            __syncthreads();
        }
    }
}

constexpr int MOE_TAB_OFF = 131072;
constexpr int MOE_MAXT = 320;
__device__ __forceinline__ int moe_build_table(const int* cnt, LAS int* tab) {
    __syncthreads();
    if (threadIdx.x == 0) { int nt = 0, seg = 0;
        for (int e = 0; e < NEXP; ++e) { const int n = cnt[e * 64], mt = (n + 255) >> 8;
            for (int m = 0; m < mt; ++m) { tab[3 * nt] = e | (m << 8); tab[3 * nt + 1] = seg + m * 256; tab[3 * nt + 2] = (n - m * 256) < 256 ? (n - m * 256) : 256; ++nt; }
            seg += mt * 256; }
        tab[3 * MOE_MAXT] = nt; }
    __syncthreads();
    return tab[3 * MOE_MAXT];
}
struct MoeOrder1 {
    const char* H2; const char* W; const int* LIST; LAS const int* tab; int nunits, G, c;
    __device__ __forceinline__ bool next(int i, pg8::Unit& u) const {
        const int L = i * G + c; if (L >= nunits) return false;
        const int t = L >> 1; const int em = tab[3 * t]; u.e = em & 255; u.pm = em >> 8; u.pn = L & 1; u.seg = tab[3 * t + 1]; u.nrows = tab[3 * t + 2];
        u.A = H2; u.B = W + ((size_t)(u.e * 512 + u.pn * 256) * DM) * 2; return true;
    }
    __device__ __forceinline__ unsigned a_row(const pg8::Unit& u, int r, int K_) const { const int tok = (r < u.nrows) ? (LIST[(size_t)u.e * MTOK + u.pm * 256 + r] >> 1) : 0; return (unsigned)(tok * K_) * 2u; }
};
struct EpiMoe1 {
    static constexpr bool PERM = true;
    bf16_t* HID;
    __device__ __forceinline__ void operator()(const f32x4 (&acc)[2][2][4][2], const pg8::Unit& u, int wr, int wc, int fr, int fq) const {
        const int col0 = u.pn * 128 + wc * 32 + 8 * fq;
#pragma unroll
        for (int ai = 0; ai < 2; ++ai)
#pragma unroll
            for (int m = 0; m < 4; ++m) { const int r = ai * 128 + wr * 64 + m * 16 + fr;
                const f32x4 g0 = acc[ai][0][m][0], g1 = acc[ai][0][m][1], u0 = acc[ai][1][m][0], u1 = acc[ai][1][m][1];
                f32x4 h0, h1;
                h0.x = g0.x * sigmoidf_(g0.x) * u0.x; h0.y = g0.y * sigmoidf_(g0.y) * u0.y; h0.z = g0.z * sigmoidf_(g0.z) * u0.z; h0.w = g0.w * sigmoidf_(g0.w) * u0.w;
                h1.x = g1.x * sigmoidf_(g1.x) * u1.x; h1.y = g1.y * sigmoidf_(g1.y) * u1.y; h1.z = g1.z * sigmoidf_(g1.z) * u1.z; h1.w = g1.w * sigmoidf_(g1.w) * u1.w;
                u32x4 w; w.x = pk2(h0.x, h0.y); w.y = pk2(h0.z, h0.w); w.z = pk2(h1.x, h1.y); w.w = pk2(h1.z, h1.w);
                *(u32x4*)(HID + (size_t)(u.seg + r) * DEXP + col0) = w; }
    }
};
struct MoeOrder2 {
    const char* HID; const char* W; LAS const int* tab; int nunits, G, c;
    __device__ __forceinline__ bool next(int i, pg8::Unit& u) const {
        const int L = i * G + c; if (L >= nunits) return false;
        const int t = L >> 2; const int em = tab[3 * t]; u.e = em & 255; u.pm = em >> 8; u.pn = L & 3; u.seg = tab[3 * t + 1]; u.nrows = tab[3 * t + 2];
        u.A = HID + (size_t)u.seg * DEXP * 2; u.B = W + ((size_t)(u.e * DM + u.pn * 256) * DEXP) * 2; return true;
    }
    __device__ __forceinline__ unsigned a_row(const pg8::Unit&, int r, int K_) const { return (unsigned)(r * K_) * 2u; }
};
struct EpiMoe2 {
    static constexpr bool PERM = true;
    bf16_t* Y; const int* LIST;
    __device__ __forceinline__ void operator()(const f32x4 (&acc)[2][2][4][2], const pg8::Unit& u, int wr, int wc, int fr, int fq) const {
        const int col0 = u.pn * 256 + wc * 32 + 8 * fq;
        const int* lp = LIST + (size_t)u.e * MTOK + u.pm * 256;
        int dst[2][4];
#pragma unroll
        for (int ai = 0; ai < 2; ++ai)
#pragma unroll
            for (int m = 0; m < 4; ++m) { const int r = ai * 128 + wr * 64 + m * 16 + fr; dst[ai][m] = (r < u.nrows) ? lp[r] : -1; }
#pragma unroll
        for (int ai = 0; ai < 2; ++ai)
#pragma unroll
            for (int m = 0; m < 4; ++m) {
                if (dst[ai][m] >= 0) {
#pragma unroll
                    for (int bj = 0; bj < 2; ++bj) { const f32x4 v0 = acc[ai][bj][m][0], v1 = acc[ai][bj][m][1];
                        u32x4 w; w.x = pk2(v0.x, v0.y); w.y = pk2(v0.z, v0.w); w.z = pk2(v1.x, v1.y); w.w = pk2(v1.z, v1.w);
                        *(u32x4*)(Y + ((unsigned)dst[ai][m] * (unsigned)DM + (unsigned)(col0 + bj * 128))) = w; } } }
    }
};
__device__ __forceinline__ void phase5(const Args& a, LAS unsigned char* lds, int nblk, int blk) {
    unsigned char* ws = a.ws;
    LAS int* tab = (LAS int*)(lds + MOE_TAB_OFF);
    const int nt = moe_build_table((const int*)(ws + WS_CTL), tab);
    MoeOrder1 S{(const char*)(ws + WS_XN), (const char*)(ws + WS_WGU), (const int*)(ws + WS_LIST), tab, nt * 2, nblk, blk};
    EpiMoe1 E{(bf16_t*)(ws + WS_HID)};
    pg8::gemm_phase(lds, DM, S, E);
}
__device__ __forceinline__ void phase6(const Args& a, LAS unsigned char* lds, int nblk, int blk) {
    unsigned char* ws = a.ws;
    LAS int* tab = (LAS int*)(lds + MOE_TAB_OFF);
    const int nt = moe_build_table((const int*)(ws + WS_CTL), tab);
    MoeOrder2 S{(const char*)(ws + WS_HID), (const char*)(ws + WS_WD), tab, nt * 4, nblk, blk};
    EpiMoe2 E{(bf16_t*)(ws + WS_Y), (const int*)(ws + WS_LIST)};
    pg8::gemm_phase(lds, DEXP, S, E);
}

template <bool DUMMY> __device__ __forceinline__ void phase7(const Args& a, int lane, int gw, int NGW) {
    unsigned char* ws = a.ws;
    float* out = a.out; const bf16_t* X1 = (const bf16_t*)(ws + WS_X1); const bf16_t* Y = (const bf16_t*)(ws + WS_Y); const float* EW = (const float*)(ws + WS_EW); const float* gf = a.in[22];
    f32x4 gv[4];
#pragma unroll
    for (int j = 0; j < 4; ++j) gv[j] = ((const f32x4*)gf)[lane + 64 * j];
    u32x2 xn[4]; u32x2 y0n[4], y1n[4]; float w0n, w1n;
    auto ld = [&](int m) {
        const u32x2* xr = (const u32x2*)(X1 + (size_t)m * DM) + lane;
        const u32x2* y0 = (const u32x2*)(Y + (size_t)(2 * m) * DM) + lane; const u32x2* y1 = (const u32x2*)(Y + (size_t)(2 * m + 1) * DM) + lane;
#pragma unroll
        for (int j = 0; j < 4; ++j) { xn[j] = xr[64 * j]; y0n[j] = y0[64 * j]; y1n[j] = y1[64 * j]; }
        w0n = EW[2 * m]; w1n = EW[2 * m + 1];
    };
    if (gw < MTOK) ld(gw);
    for (int m = gw; m < MTOK; m += NGW) {
        f32x4 xv[4]; u32x2 a0[4], a1[4];
#pragma unroll
        for (int j = 0; j < 4; ++j) { xv[j].x = __builtin_bit_cast(float, xn[j].x << 16); xv[j].y = __builtin_bit_cast(float, xn[j].x & 0xffff0000u); xv[j].z = __builtin_bit_cast(float, xn[j].y << 16); xv[j].w = __builtin_bit_cast(float, xn[j].y & 0xffff0000u); a0[j] = y0n[j]; a1[j] = y1n[j]; }
        const float w0 = w0n, w1 = w1n;
        ld(m + NGW < MTOK ? m + NGW : m);
        f32x4 v[4]; float s = 0.f;
#pragma unroll
        for (int j = 0; j < 4; ++j) { f32x4 t;
            t.x = xv[j].x + w0 * __builtin_bit_cast(float, a0[j].x << 16) + w1 * __builtin_bit_cast(float, a1[j].x << 16);
            t.y = xv[j].y + w0 * __builtin_bit_cast(float, a0[j].x & 0xffff0000u) + w1 * __builtin_bit_cast(float, a1[j].x & 0xffff0000u);
            t.z = xv[j].z + w0 * __builtin_bit_cast(float, a0[j].y << 16) + w1 * __builtin_bit_cast(float, a1[j].y << 16);
            t.w = xv[j].w + w0 * __builtin_bit_cast(float, a0[j].y & 0xffff0000u) + w1 * __builtin_bit_cast(float, a1[j].y & 0xffff0000u);
            v[j] = t; s += (t.x * t.x + t.y * t.y) + (t.z * t.z + t.w * t.w); }
        s = wave_sum(s);
        const float rstd = 1.0f / sqrtf(s * (1.0f / DM) + EPS);
        f32x4* o = (f32x4*)(out + (size_t)m * DM) + lane;
#pragma unroll
        for (int j = 0; j < 4; ++j) { if (!DUMMY || rstd == 123.4567f) o[64 * j] = v[j] * rstd * gv[j]; }
    }
}

#define XB_TMO      128
#define XB_XCNT(j)  (256  + 64 * (j))
#define XB_XSUB(j)  (1280 + 64 * (j))
#define XB_XGEN(j)  (2304 + 64 * (j))
#define XB_TOP      3328
#define XB_TOPGEN   3392
#define XCD_BAR_WORDS 3456
#define XB_SPIN_CAP (1u << 22)
__device__ __forceinline__ unsigned xb_ld(unsigned* p)              { return __hip_atomic_load(p, __ATOMIC_RELAXED, __HIP_MEMORY_SCOPE_AGENT); }
__device__ __forceinline__ unsigned xb_add(unsigned* p, unsigned v) { return __hip_atomic_fetch_add(p, v, __ATOMIC_RELAXED, __HIP_MEMORY_SCOPE_AGENT); }
__device__ __forceinline__ unsigned xb_xcc_id() { return (unsigned)__builtin_amdgcn_s_getreg((3 << 11) | 20) & 0xFu; }
#define XB_SPIN(cond, bar) do { unsigned _sp = 0; while (cond) { __builtin_amdgcn_s_sleep(1); \
    if ((++_sp & 255u) == 0u) { if (xb_ld(&(bar)[XB_TMO])) break; if (_sp > XB_SPIN_CAP) { atomicAdd(&(bar)[XB_TMO], 1u); break; } } } } while (0)
struct XcdBarrier { unsigned* bar; unsigned x; volatile LAS unsigned* st; };
__device__ __forceinline__ XcdBarrier xcd_barrier_post(unsigned* bar, volatile LAS unsigned* st) {
    XcdBarrier b; b.bar = bar; b.x = xb_xcc_id(); b.st = st;
    if (threadIdx.x == 0) (void)xb_add(&bar[XB_XCNT(b.x)], 1u);
    return b;
}
__device__ __forceinline__ void xcd_barrier_complete(unsigned* bar, unsigned x, unsigned& nloc, unsigned& nx) {
    const unsigned G = gridDim.x * gridDim.y * gridDim.z;
    unsigned sum, cnt, mine, sp = 0u;
    for (;;) {
        sum = 0u; cnt = 0u; mine = 0u;
#pragma unroll
        for (unsigned j = 0; j < 16; ++j) { const unsigned c = xb_ld(&bar[XB_XCNT(j)]); sum += c; cnt += (c > 0u) ? 1u : 0u; mine = (j == x) ? c : mine; }
        if (sum == G) break;
        __builtin_amdgcn_s_sleep(1);
        if ((++sp & 255u) == 0u) { if (xb_ld(&bar[XB_TMO])) break; if (sp > XB_SPIN_CAP) { atomicAdd(&bar[XB_TMO], 1u); break; } }
    }
    nloc = mine > 0u ? mine : 1u; nx = cnt > 0u ? cnt : 1u;
}
__device__ __forceinline__ void xcd_barrier(const XcdBarrier& b) {
    asm volatile("s_waitcnt vmcnt(0)" ::: "memory");
    __syncthreads();
    if (threadIdx.x == 0) {
        unsigned* bar = b.bar;
        __builtin_amdgcn_s_waitcnt(0);
        unsigned nloc = b.st[0], nx = b.st[1];
        if (nloc == 0u) { xcd_barrier_complete(bar, b.x, nloc, nx); b.st[0] = nloc; b.st[1] = nx; }
        const unsigned old = xb_add(&bar[XB_XSUB(b.x)], 1u);
        const unsigned gen = old / nloc;
        if (old + 1u == (gen + 1u) * nloc) {
            __builtin_amdgcn_fence(__ATOMIC_RELEASE, "agent");
            asm volatile("s_waitcnt vmcnt(0)" ::: "memory");
            const unsigned og = xb_add(&bar[XB_TOP], 1u);
            const unsigned tg = og / nx;
            if (og + 1u == (tg + 1u) * nx) xb_add(&bar[XB_TOPGEN], 1u);
            else XB_SPIN(xb_ld(&bar[XB_TOPGEN]) == tg, bar);
            __builtin_amdgcn_fence(__ATOMIC_ACQUIRE, "agent");
            xb_add(&bar[XB_XGEN(b.x)], 1u);
            asm volatile("s_waitcnt vmcnt(0)" ::: "memory");
        } else {
            XB_SPIN(xb_ld(&bar[XB_XGEN(b.x)]) == gen, bar);
            __builtin_amdgcn_fence(__ATOMIC_ACQUIRE, "agent");
            asm volatile("s_waitcnt vmcnt(0)" ::: "memory");
        }
    }
    __syncthreads();
}

__global__ void __launch_bounds__(NTHREADS, 2) mega_fwd(Args args) {
    extern __shared__ __attribute__((aligned(16))) unsigned char lds[];
    const int tid = threadIdx.x, lane = tid & 63, wave = __builtin_amdgcn_readfirstlane(tid >> 6);
    const int nblk = gridDim.x, blk = blockIdx.x;
    const int gw = blk * NWAVES + wave, NGW = nblk * NWAVES;
    const int lo = args.ph_lo, hi = args.ph_hi;
#define IN(k) (lo <= (k) && (k) < hi)
#if MK_CG_SYNC
#define SEAM(k) do { if (IN(k) && IN((k) + 1)) { cg::this_grid().sync(); } } while (0)
#else
    volatile LAS unsigned* bst = (volatile LAS unsigned*)((LAS unsigned char*)lds + LDS_BYTES - 64);
    if (tid == 0) { bst[0] = 0u; bst[1] = 0u; }
    __syncthreads();
    const XcdBarrier gbar = xcd_barrier_post((unsigned*)(args.ws + WS_CTL) + 4096, bst);
#define SEAM(k) do { if (IN(k) && IN((k) + 1)) { xcd_barrier(gbar); } } while (0)
#endif
    if (IN(0)) { phase0(args, (LAS unsigned char*)lds, tid, wave, lane, gw, NGW); if (PROBE_DUP == 0) phase0(args, (LAS unsigned char*)lds, tid, wave, lane, gw, NGW); }
    SEAM(0);
    if (IN(1)) { phase1(args, (LAS unsigned char*)lds, nblk, blk, 6, 1024); if (PROBE_DUP == 1) phase1(args, (LAS unsigned char*)lds, nblk, blk, 6, 1024); }
    SEAM(1);
    if (IN(2)) { const int nl = (nblk >= 256) ? 128 : nblk / 2, ng = nblk - nl;
        const bool probe_ = (hi != NPHASES);
        if (blk < ng) { if (!(probe_ && PROBE_P2_MODE == 1)) phase1(args, (LAS unsigned char*)lds, ng, blk, 0, 1536); }
        else { if (!(probe_ && PROBE_P2_MODE == 2)) phase2_lru(args, (LAS unsigned char*)lds, nl, blk - ng); } }
    SEAM(2);
    if (IN(3)) { phase2_attn<0>(args, (char*)lds, nblk, blk); if (PROBE_DUP == 3) phase2_attn<0>(args, (char*)lds, nblk, blk); }
    SEAM(3);
    if (IN(4)) { phase3(args, (LAS unsigned char*)lds, nblk, blk); if (PROBE_DUP == 4) phase3(args, (LAS unsigned char*)lds, nblk, blk); }
    SEAM(4);
    if (IN(5)) { phase4<false>(args, (LAS unsigned char*)lds, nblk, blk); if (PROBE_DUP == 5) phase4<true>(args, (LAS unsigned char*)lds, nblk, blk); }
    SEAM(5);
    if (IN(6)) { phase5(args, (LAS unsigned char*)lds, nblk, blk); if (PROBE_DUP == 6) phase5(args, (LAS unsigned char*)lds, nblk, blk); }
    SEAM(6);
    if (IN(7)) { phase6(args, (LAS unsigned char*)lds, nblk, blk); if (PROBE_DUP == 7) phase6(args, (LAS unsigned char*)lds, nblk, blk); }
    SEAM(7);
    if (IN(8)) { if (PROBE_DUP == 8) phase7<true>(args, lane, gw, NGW); phase7<false>(args, lane, gw, NGW); }
#undef IN
#undef SEAM
}

#if PROBE_ATT_VAR > 0
__global__ void __launch_bounds__(NTHREADS, 2) probe_attn(Args args) {
    extern __shared__ __attribute__((aligned(16))) unsigned char lds[];
    phase2_attn<PROBE_ATT_VAR>(args, (char*)lds, gridDim.x, blockIdx.x);
}
#endif
#if PROBE_VALU > 0
__global__ void __launch_bounds__(NTHREADS, 2) probe_valu(float* out, float seed) {
    float v[16];
#pragma unroll
    for (int i = 0; i < 16; ++i) v[i] = seed + (float)(threadIdx.x + i);
    f32x16 macc0 = f32x16{}, macc1 = f32x16{}; bf16x8 ma, mb;
#pragma unroll
    for (int i = 0; i < 8; ++i) { ma[i] = (short)(0x3F80 + threadIdx.x + i); mb[i] = (short)(0x3F00 + threadIdx.x * 3 + i); }
    for (int it = 0; it < 4096; ++it) {
#pragma unroll
        for (int i = 0; i < 16; ++i) {
#if PROBE_VALU == 1
            v[i] = fmaf(v[i], 1.0001f, 0.5f);
#elif PROBE_VALU == 2
            v[i] = __builtin_amdgcn_exp2f(v[i]);
#elif PROBE_VALU == 3
            v[i] = fmaxf(fmaxf(v[i], v[(i + 1) & 15]), seed);
#endif
        }
#if PROBE_VALU == 4 || PROBE_VALU == 5
        macc0 = __builtin_amdgcn_mfma_f32_32x32x16_bf16(ma, mb, macc0, 0, 0, 0);
#if PROBE_VALU == 4
        v[0] = fmaf(v[0], 1.0001f, 0.5f); v[1] = fmaf(v[1], 1.0001f, 0.5f); v[2] = fmaf(v[2], 1.0001f, 0.5f); v[3] = fmaf(v[3], 1.0001f, 0.5f); v[4] = fmaf(v[4], 1.0001f, 0.5f); v[5] = fmaf(v[5], 1.0001f, 0.5f);
#endif
        macc1 = __builtin_amdgcn_mfma_f32_32x32x16_bf16(ma, mb, macc1, 0, 0, 0);
#if PROBE_VALU == 4
        v[6] = fmaf(v[6], 1.0001f, 0.5f); v[7] = fmaf(v[7], 1.0001f, 0.5f); v[8] = fmaf(v[8], 1.0001f, 0.5f); v[9] = fmaf(v[9], 1.0001f, 0.5f); v[10] = fmaf(v[10], 1.0001f, 0.5f); v[11] = fmaf(v[11], 1.0001f, 0.5f);
#endif
#endif
        asm volatile("" : "+v"(v[0]), "+v"(v[1]), "+v"(v[2]), "+v"(v[3]), "+v"(v[4]), "+v"(v[5]), "+v"(v[6]), "+v"(v[7]));
    }
    float s = 0.f;
#pragma unroll
    for (int i = 0; i < 16; ++i) s += v[i] + macc0[i] + macc1[i];
    if (s == 123.456f) out[threadIdx.x] = s;
}
#endif
extern "C" void kernel_launch(void* const* d_in, const int* in_sizes, int n_in, void* d_out, int out_size, void* d_ws, size_t ws_size, hipStream_t stream) {
    static int grid = 0;
    if (grid == 0) {
        if (n_in != 23 || out_size != MTOK * DM || ws_size < WS_END) { fprintf(stderr, "kernel_launch: unexpected shapes (n_in %d out %d ws %zu)\n", n_in, out_size, ws_size); grid = -1; return; }
        int dev = 0, cus = 0, per_cu = 0;
        hipGetDevice(&dev);
        hipDeviceGetAttribute(&cus, hipDeviceAttributeMultiprocessorCount, dev);
        hipFuncSetAttribute((const void*)mega_fwd, hipFuncAttributeMaxDynamicSharedMemorySize, LDS_BYTES);
        hipOccupancyMaxActiveBlocksPerMultiprocessor(&per_cu, (const void*)mega_fwd, NTHREADS, LDS_BYTES);
        if (per_cu < 1) per_cu = 1;
        if (per_cu > 1) per_cu = 1;
        grid = cus * per_cu;
        (void)hipGetLastError();
    }
    if (grid < 0) return;
    (void)hipMemsetAsync((char*)d_ws + WS_CTL, 0, 65536, stream);
    Args a{};
    for (int i = 0; i < 23; ++i) a.in[i] = (const float*)d_in[i];
    a.out = (float*)d_out; a.ws = (unsigned char*)d_ws;
#if MK_N_LAUNCHES == 1
#if PROBE_VALU > 0
    hipLaunchKernelGGL(probe_valu, dim3(grid), dim3(NTHREADS), 0, stream, (float*)((char*)d_ws + WS_O0), 1.0f);
#endif
#if PROBE_PREFIX > 0
    { a.ph_lo = 0; a.ph_hi = PROBE_PREFIX; void* kargs0[] = {&a};
      (void)hipLaunchCooperativeKernel((const void*)mega_fwd, dim3(grid), dim3(NTHREADS), kargs0, LDS_BYTES, stream);
      (void)hipMemsetAsync((char*)d_ws + WS_CTL, 0, 65536, stream); }
#if PROBE_ATT_VAR > 0
    { (void)hipFuncSetAttribute((const void*)probe_attn, hipFuncAttributeMaxDynamicSharedMemorySize, LDS_BYTES); hipLaunchKernelGGL(probe_attn, dim3(grid), dim3(PROBE_ATT_THREADS), LDS_BYTES, stream, a); }
#endif
#endif
    a.ph_lo = 0; a.ph_hi = NPHASES;
    void* kargs[] = {&a};
    hipError_t e = hipLaunchCooperativeKernel((const void*)mega_fwd, dim3(grid), dim3(NTHREADS), kargs, LDS_BYTES, stream);
    if (e != hipSuccess) fprintf(stderr, "cooperative launch failed: %s (grid %d)\n", hipGetErrorString(e), grid);
#else
    for (int p = 0; p < NPHASES; ++p) {
        a.ph_lo = p; a.ph_hi = p + 1;
        hipLaunchKernelGGL(mega_fwd, dim3(grid), dim3(NTHREADS), LDS_BYTES, stream, a);
    }
#endif
}
```

```cpp
#include <hip/hip_runtime.h>
#include <hip/hip_cooperative_groups.h>
#include <hip/hip_bf16.h>
#include <cstdint>
#include <cstdio>
namespace cg = cooperative_groups;

#ifndef PROBE_DUP
#define PROBE_DUP -1
#endif
#ifndef PROBE_PREFIX
#define PROBE_PREFIX 0
#endif
#ifndef PROBE_P2_MODE
#define PROBE_P2_MODE 0
#endif
#ifndef PROBE_LRU_ABL
#define PROBE_LRU_ABL 0
#endif
#ifndef PROBE_VALU
#define PROBE_VALU 0
#endif
#ifndef PROBE_ATT_THREADS
#define PROBE_ATT_THREADS 512
#endif
#ifndef PROBE_ATT_VAR
#define PROBE_ATT_VAR 0
#endif
#ifndef MK_CG_SYNC
#define MK_CG_SYNC 0
#endif
#ifndef MK_N_LAUNCHES
#define MK_N_LAUNCHES 1
#endif

#define LAS __attribute__((address_space(3)))
typedef unsigned short bf16_t;
typedef __hip_bfloat16 bf16;
typedef short bf16x8 __attribute__((ext_vector_type(8)));
typedef short s16x4 __attribute__((ext_vector_type(4)));
typedef float f32x4 __attribute__((ext_vector_type(4)));
typedef float f32x16 __attribute__((ext_vector_type(16)));
typedef unsigned u32x4 __attribute__((ext_vector_type(4)));
typedef unsigned u32x2 __attribute__((ext_vector_type(2)));
typedef float f32x2 __attribute__((ext_vector_type(2)));

constexpr int NBATCH = 8, SEQ = 4096, DM = 1024, MTOK = NBATCH * SEQ;
constexpr int NIN = 2560;
constexpr int NEXP = 32, DEXP = 256;
constexpr float EPS = 1e-6f;
constexpr float QSCALE = 0.125f * 1.4426950408889634f;
constexpr int NWAVES = 8, NTHREADS = 512;
constexpr int NPHASES = 9;

constexpr size_t MiB = 1u << 20;
constexpr size_t WS_CTL = 0;
constexpr size_t WS_RT = 1 * MiB;
constexpr size_t WS_WRH = 1 * MiB + 512 * 1024;
constexpr size_t WS_WRL = 1 * MiB + 768 * 1024;
constexpr size_t WS_WIN = 2 * MiB;
constexpr size_t WS_WOUT = 7 * MiB;
constexpr size_t WS_WGU = 9 * MiB;
constexpr size_t WS_WD = 41 * MiB;
constexpr size_t WS_EW = 58 * MiB;
constexpr size_t WS_LIST = 59 * MiB;
constexpr size_t WS_XN = 64 * MiB;
constexpr size_t WS_Q = 128 * MiB, WS_K = 160 * MiB, WS_V = 192 * MiB, WS_XR = 224 * MiB, WS_GG = 256 * MiB;
constexpr size_t WS_X1 = 128 * MiB;
constexpr size_t WS_Y = 352 * MiB;
constexpr size_t WS_O0 = 288 * MiB;
constexpr size_t WS_HID = 288 * MiB;
constexpr size_t WS_HF = 352 * MiB;
constexpr size_t WS_MIX = 416 * MiB;
constexpr size_t WS_END = 480 * MiB;

constexpr int LDS_BYTES = 136 * 1024;

struct Args { const float* in[23]; float* out; unsigned char* ws; int ph_lo, ph_hi; };

#define LDS_WAIT() asm volatile("s_waitcnt lgkmcnt(0)" ::: "memory")
__device__ __forceinline__ unsigned f2bf(float f) { unsigned u = __builtin_bit_cast(unsigned, f); return (u + 0x7fffu + ((u >> 16) & 1u)) >> 16; }
__device__ __forceinline__ unsigned pk2(float lo, float hi) { unsigned r; asm("v_cvt_pk_bf16_f32 %0, %1, %2" : "=v"(r) : "v"(lo), "v"(hi)); return r; }
__device__ __forceinline__ float bf2f(bf16_t b) { return __builtin_bit_cast(float, (unsigned)b << 16); }
__device__ __forceinline__ float wave_sum(float v) {
#pragma unroll
    for (int o = 1; o < 64; o <<= 1) v += __shfl_xor(v, o);
    return v;
}
__device__ __forceinline__ float gelu_tanh(float x) {
    const float y = 0.7978845608028654f * (x + 0.044715f * x * x * x);
    const float t = 1.0f - 2.0f * __builtin_amdgcn_rcpf(1.0f + __builtin_amdgcn_exp2f(2.885390081777927f * y));
    return 0.5f * x * (1.0f + t);
}
__device__ __forceinline__ float sigmoidf_(float x) { return __builtin_amdgcn_rcpf(1.0f + __builtin_amdgcn_exp2f(-1.4426950408889634f * x)); }

__device__ __forceinline__ void tr_item(const float* W, int N, int k0, int n0, bf16_t* WT, int ldt, int dst_row0, LAS float* scr, int lane) {
#pragma unroll 8
    for (int i = 0; i < 32; ++i) { const int kk = 2 * i + (lane >> 5); scr[kk * 33 + (lane & 31)] = W[(size_t)(k0 + kk) * N + n0 + (lane & 31)]; }
    LDS_WAIT(); asm volatile("" ::: "memory");
    const int c = lane & 7;
#pragma unroll
    for (int j = 0; j < 4; ++j) { const int n = (lane >> 3) + 8 * j; const LAS float* s = scr + (8 * c) * 33 + n;
        u32x4 o; o.x = pk2(s[0 * 33], s[1 * 33]); o.y = pk2(s[2 * 33], s[3 * 33]); o.z = pk2(s[4 * 33], s[5 * 33]); o.w = pk2(s[6 * 33], s[7 * 33]);
        *(u32x4*)(WT + (size_t)(dst_row0 + n) * ldt + k0 + 8 * c) = o; }
    LDS_WAIT(); asm volatile("" ::: "memory");
}
__device__ __forceinline__ int gu_row(int c, int is_up) { return 256 * (c >> 7) + 128 * is_up + (c & 127); }

__device__ __forceinline__ void rms_row_bf16(const float* xrow, const float* g, bf16_t* orow, int lane) {
    const f32x4* xr = (const f32x4*)xrow + lane; const f32x4* gr = (const f32x4*)g + lane;
    f32x4 v[4]; float s = 0.f;
#pragma unroll
    for (int j = 0; j < 4; ++j) { v[j] = xr[64 * j]; s += (v[j].x * v[j].x + v[j].y * v[j].y) + (v[j].z * v[j].z + v[j].w * v[j].w); }
    s = wave_sum(s);
    const float rstd = 1.0f / sqrtf(s * (1.0f / DM) + EPS);
    u32x2* o8 = (u32x2*)orow + lane;
#pragma unroll
    for (int j = 0; j < 4; ++j) { const f32x4 gv = gr[64 * j]; u32x2 w; w.x = pk2(v[j].x * rstd * gv.x, v[j].y * rstd * gv.y); w.y = pk2(v[j].z * rstd * gv.z, v[j].w * rstd * gv.w); o8[64 * j] = w; }
}

__device__ __forceinline__ void phase0(const Args& a, LAS unsigned char* lds, int tid, int wave, int lane, int gw, int NGW) {
    unsigned char* ws = a.ws;
    LAS float* scr = (LAS float*)(lds + wave * 8704);
    bf16_t* WinT = (bf16_t*)(ws + WS_WIN); bf16_t* WoutT = (bf16_t*)(ws + WS_WOUT); bf16_t* WguT = (bf16_t*)(ws + WS_WGU); bf16_t* WdT = (bf16_t*)(ws + WS_WD);
    constexpr int I_IN = 16 * 80, I_OUT = 16 * 32, I_G = 32 * 128, I_U = 32 * 128, I_D = 32 * 128, NITEMS = I_IN + I_OUT + I_G + I_U + I_D;
    for (int it = gw; it < NITEMS; it += NGW) {
        int r = it;
        if (r < I_IN) { const int kb = r / 80, nb = r % 80; tr_item(a.in[2], NIN, 64 * kb, 32 * nb, WinT, DM, 32 * nb, scr, lane); continue; } r -= I_IN;
        if (r < I_OUT) { const int kb = r / 32, nb = r % 32; tr_item(a.in[15], DM, 64 * kb, 32 * nb, WoutT, DM, 32 * nb, scr, lane); continue; } r -= I_OUT;
        if (r < I_G) { const int e = r / 128, rr = r % 128, kb = rr / 8, nb = rr % 8; tr_item(a.in[19] + (size_t)e * DM * DEXP, DEXP, 64 * kb, 32 * nb, WguT + (size_t)e * 512 * DM, DM, gu_row(32 * nb, 0), scr, lane); continue; } r -= I_G;
        if (r < I_U) { const int e = r / 128, rr = r % 128, kb = rr / 8, nb = rr % 8; tr_item(a.in[20] + (size_t)e * DM * DEXP, DEXP, 64 * kb, 32 * nb, WguT + (size_t)e * 512 * DM, DM, gu_row(32 * nb, 1), scr, lane); continue; } r -= I_U;
        { const int e = r / 128, rr = r % 128, kb = rr / 32, nb = rr % 32; tr_item(a.in[21] + (size_t)e * DEXP * DM, DM, 64 * kb, 32 * nb, WdT + (size_t)e * DM * DEXP, DEXP, 32 * nb, scr, lane); }
    }
    { bf16_t* WRH = (bf16_t*)(ws + WS_WRH); bf16_t* WRL = (bf16_t*)(ws + WS_WRL); const int gt = gw * 64 + lane, NGT = NGW * 64;
      for (int idx = gt; idx < 48 * DM; idx += NGT) { const int j = idx / DM, k = idx % DM;
          const float w = (j < 4) ? a.in[17][k * 4 + j] : (j < 36) ? a.in[18][k * 32 + (j - 4)] : 0.f; const float wg = w * a.in[16][k];
          const unsigned hi = f2bf(wg); const float hif = __builtin_bit_cast(float, hi << 16);
          WRH[idx] = (bf16_t)hi; WRL[idx] = (bf16_t)f2bf(wg - hif); }
      if (gt < 2048) ((int*)(ws + WS_CTL))[gt] = 0;
      float2* RT = (float2*)(ws + WS_RT);
      for (int idx = gt; idx < SEQ * 8; idx += NGT) { const int pos = idx >> 3, i = idx & 7;
          const float invf = __builtin_amdgcn_exp2f(-(float)i * (18.931568569324174f / 8.0f));
          const float ang = (float)pos * invf;
          const double rev = (double)ang * 0.15915494309189535; const double fr = rev - __builtin_rint(rev);
          const float frf = (float)fr;
          RT[idx] = make_float2(__builtin_amdgcn_cosf(frf), __builtin_amdgcn_sinf(frf)); }
    }
    { bf16_t* XN = (bf16_t*)(ws + WS_XN); const float* x = a.in[0];
      f32x4 gv[4];
#pragma unroll
      for (int j = 0; j < 4; ++j) gv[j] = ((const f32x4*)a.in[1])[lane + 64 * j];
      f32x4 xn[4];
      if (gw < MTOK) {
#pragma unroll
          for (int j = 0; j < 4; ++j) xn[j] = ((const f32x4*)(x + (size_t)gw * DM))[lane + 64 * j]; }
      for (int m = gw; m < MTOK; m += NGW) {
          f32x4 v[4]; float s = 0.f;
#pragma unroll
          for (int j = 0; j < 4; ++j) { v[j] = xn[j]; s += (v[j].x * v[j].x + v[j].y * v[j].y) + (v[j].z * v[j].z + v[j].w * v[j].w); }
          { const int mn = (m + NGW < MTOK) ? m + NGW : m;
#pragma unroll
            for (int j = 0; j < 4; ++j) xn[j] = ((const f32x4*)(x + (size_t)mn * DM))[lane + 64 * j]; }
          s = wave_sum(s);
          const float rstd = 1.0f / sqrtf(s * (1.0f / DM) + EPS);
          u32x2* o8 = (u32x2*)(XN + (size_t)m * DM) + lane;
#pragma unroll
          for (int j = 0; j < 4; ++j) { u32x2 w; w.x = pk2(v[j].x * rstd * gv[j].x, v[j].y * rstd * gv[j].y); w.y = pk2(v[j].z * rstd * gv[j].z, v[j].w * rstd * gv[j].w); o8[64 * j] = w; } } }
}

template <class ARow>
__device__ __forceinline__ void wave_gemm_64x64(f32x4 (&acc)[4][4], const ARow& arow, const bf16_t* __restrict__ Bt, int ldb, int K, int m0, int n0, int lane) {
    const int fr = lane & 15, fq = lane >> 4;
#pragma unroll
    for (int mi = 0; mi < 4; ++mi)
#pragma unroll
        for (int ni = 0; ni < 4; ++ni) acc[mi][ni] = (f32x4){0.f, 0.f, 0.f, 0.f};
    const bf16_t* ap[4];
#pragma unroll
    for (int mi = 0; mi < 4; ++mi) ap[mi] = arow(m0 + 16 * mi + fr) + 8 * fq;
    const bf16_t* bp = Bt + (size_t)(n0 + fr) * ldb + 8 * fq;
    for (int k0 = 0; k0 < K; k0 += 32) {
        bf16x8 av[4], bv[4];
#pragma unroll
        for (int mi = 0; mi < 4; ++mi) av[mi] = *(const bf16x8*)(ap[mi] + k0);
#pragma unroll
        for (int ni = 0; ni < 4; ++ni) bv[ni] = *(const bf16x8*)(bp + (size_t)(16 * ni) * ldb + k0);
#pragma unroll
        for (int mi = 0; mi < 4; ++mi)
#pragma unroll
            for (int ni = 0; ni < 4; ++ni) acc[mi][ni] = __builtin_amdgcn_mfma_f32_16x16x32_bf16(bv[ni], av[mi], acc[mi][ni], 0, 0, 0);
    }
}
struct RowsContig { const bf16_t* base; int ld; __device__ __forceinline__ const bf16_t* operator()(int r) const { return base + (size_t)r * ld; } };

__device__ __forceinline__ void store_bf16x4(bf16_t* p, f32x4 v) { u32x2 w; w.x = pk2(v.x, v.y); w.y = pk2(v.z, v.w); *(u32x2*)p = w; }


namespace pg8 {
constexpr int BM = 256, BK = 64, HALF = 128, HTB = HALF * BK * 2, STAGE_BYTES = 8 * HTB, NXCD = 8, WGM = 8;
__host__ __device__ __forceinline__ int lds_byte(int r, int c) { const int st = (r >> 4) * 2 + (c >> 5), rr = r & 15, cc = c & 31, ob = rr * 64 + cc * 2; return st * 1024 + (ob ^ (((ob >> 9) & 1) << 5)); }
__host__ __device__ __forceinline__ void stage_rc(int b, int& R, int& C) { const int st = b / 1024, sb = b % 1024, swz = sb ^ (((sb >> 9) & 1) << 5); R = (st >> 1) * 16 + swz / 64; C = (st & 1) * 32 + (swz % 64) / 2; }
__host__ __device__ __forceinline__ int perm32(int rho) { const int n = rho >> 4, i = rho & 15; return 8 * (i >> 2) + 4 * n + (i & 3); }

struct Unit { const char* A; const char* B; int pm, pn, e, nrows, seg; };

template <class Epi, class Sched>
__device__ __forceinline__ void gemm_phase(LAS unsigned char* lds, const int K, const Sched& S, const Epi& E) {
    const int tid = threadIdx.x, wid = __builtin_amdgcn_readfirstlane(tid >> 6), lane = tid & 63, wr = wid >> 2, wc = wid & 3, fr = lane & 15, fq = lane >> 4;
    const int nt = K / BK;
    int Rl[2], Cl[2]; unsigned voffB[2];
#pragma unroll
    for (int i = 0; i < 2; ++i) { int R, C; stage_rc(tid * 16 + i * 8192, R, C); const int Rb = Epi::PERM ? ((R & ~31) + perm32(R & 31)) : R;
        Rl[i] = R; Cl[i] = C; voffB[i] = (unsigned)(Rb * K + C) * 2u; }
    const size_t kstep = (size_t)(BK * 2);
    const size_t hstep = (size_t)HALF * K * 2;
    const unsigned ldsw = (unsigned)wid * 1024u;
    const int aoff = lds_byte(wr * 64 + fr, fq * 8), boff = lds_byte(wc * 32 + fr, fq * 8);
#define PG8_SA(b, h) (((b) * 2 + (h)) * HTB)
#define PG8_SB(b, h) ((4 + (b) * 2 + (h)) * HTB)
#define PG8_STAGE(bufoff, gbase, voff) do { _Pragma("unroll") for (int _i = 0; _i < 2; ++_i) \
        __builtin_amdgcn_global_load_lds((const unsigned*)((const char*)(gbase) + (voff)[_i]), (LAS unsigned*)(lds + (bufoff) + ldsw + _i * 8192), 16, 0, 0); } while (0)
#define PG8_LDA(dst, b, h) do { _Pragma("unroll") for (int m = 0; m < 4; ++m) _Pragma("unroll") for (int k = 0; k < 2; ++k) dst[m][k] = *(const LAS bf16x8*)(lds + PG8_SA(b, h) + aoff + m * 2048 + k * 1024); } while (0)
#define PG8_LDB(dst, b, h) do { _Pragma("unroll") for (int n = 0; n < 2; ++n) _Pragma("unroll") for (int k = 0; k < 2; ++k) dst[n][k] = *(const LAS bf16x8*)(lds + PG8_SB(b, h) + boff + n * 2048 + k * 1024); } while (0)
#define PG8_MMA(ai, bj, At, Bt) do { __builtin_amdgcn_s_setprio(1); _Pragma("unroll") for (int m = 0; m < 4; ++m) _Pragma("unroll") for (int n = 0; n < 2; ++n) _Pragma("unroll") for (int k = 0; k < 2; ++k) \
        acc[ai][bj][m][n] = __builtin_amdgcn_mfma_f32_16x16x32_bf16(Bt[n][k], At[m][k], acc[ai][bj][m][n], 0, 0, 0); __builtin_amdgcn_s_setprio(0); } while (0)
#define PG8_WAIT_V(n) asm volatile("s_waitcnt vmcnt(" #n ")" ::: "memory")
#define PG8_WAIT_L(n) asm volatile("s_waitcnt lgkmcnt(" #n ")" ::: "memory")
#define PG8_BAR __builtin_amdgcn_s_barrier()
#define PG8_SCHED __builtin_amdgcn_sched_barrier(0)
    Unit cur, nxt; int ui = 0;
    if (!S.next(0, cur)) return;
    f32x4 acc[2][2][4][2];
#pragma unroll
    for (int a = 0; a < 2; ++a)
#pragma unroll
        for (int b = 0; b < 2; ++b)
#pragma unroll
            for (int m = 0; m < 4; ++m)
#pragma unroll
                for (int n = 0; n < 2; ++n) acc[a][b][m][n] = (f32x4){0.f, 0.f, 0.f, 0.f};
    bf16x8 At[4][2], B0[2][2], B1[2][2];
    const char* cA = cur.A; const char* cB = cur.B;
    unsigned vA0[2], vA1[2], nA0[2], nA1[2];
#pragma unroll
    for (int i = 0; i < 2; ++i) { vA0[i] = S.a_row(cur, Rl[i], K) + (unsigned)Cl[i] * 2u; vA1[i] = S.a_row(cur, HALF + Rl[i], K) + (unsigned)Cl[i] * 2u; nA0[i] = vA0[i]; nA1[i] = vA1[i]; }
    PG8_STAGE(PG8_SB(0, 0), cB, voffB); PG8_STAGE(PG8_SB(0, 1), cB + hstep, voffB); PG8_STAGE(PG8_SA(0, 0), cA, vA0); PG8_STAGE(PG8_SA(0, 1), cA, vA1);
    if (wr == 1) PG8_BAR;
    PG8_WAIT_V(2); PG8_BAR;
    PG8_STAGE(PG8_SB(1, 0), cB + kstep, voffB); PG8_STAGE(PG8_SA(1, 0), cA + kstep, vA0); PG8_STAGE(PG8_SB(1, 1), cB + hstep + kstep, voffB);
    PG8_WAIT_V(6); PG8_BAR;
    for (;;) {
        const bool has_next = S.next(ui + 1, nxt);
        const char* nA = has_next ? nxt.A : cA; const char* nB = has_next ? nxt.B : cB;
        if (has_next) {
#pragma unroll
            for (int i = 0; i < 2; ++i) { nA0[i] = S.a_row(nxt, Rl[i], K) + (unsigned)Cl[i] * 2u; nA1[i] = S.a_row(nxt, HALF + Rl[i], K) + (unsigned)Cl[i] * 2u; }
        }
#pragma nounroll
        for (int t = 0; t < nt; t += 2) {
            const bool last = (t == nt - 2);
            const char* a1 = cA + (size_t)(t + 1) * kstep;
            const char* a2 = last ? nA : cA + (size_t)(t + 2) * kstep; const char* b2 = last ? nB : cB + (size_t)(t + 2) * kstep;
            const char* a3 = a2 + kstep; const char* b3 = b2 + kstep;
            unsigned w0[2], w1[2];
#pragma unroll
            for (int i = 0; i < 2; ++i) { w0[i] = last ? nA0[i] : vA0[i]; w1[i] = last ? nA1[i] : vA1[i]; }
            PG8_LDB(B0, 0, 0); PG8_LDB(B1, 0, 1); PG8_SCHED; PG8_LDA(At, 0, 0); PG8_STAGE(PG8_SA(1, 1), a1, vA1);
            PG8_WAIT_V(8); PG8_WAIT_L(0); PG8_BAR; PG8_MMA(0, 0, At, B0); PG8_MMA(0, 1, At, B1); PG8_BAR; PG8_SCHED;
            PG8_LDA(At, 0, 1); PG8_STAGE(PG8_SB(0, 0), b2, voffB); PG8_STAGE(PG8_SB(0, 1), b2 + hstep, voffB); PG8_STAGE(PG8_SA(0, 0), a2, w0);
            PG8_WAIT_V(8); PG8_WAIT_L(0); PG8_BAR; PG8_MMA(1, 0, At, B0); PG8_MMA(1, 1, At, B1); PG8_BAR; PG8_SCHED;
            PG8_LDB(B0, 1, 0); PG8_LDB(B1, 1, 1); PG8_SCHED; PG8_LDA(At, 1, 0); PG8_STAGE(PG8_SA(0, 1), a2, w1);
            PG8_WAIT_V(8); PG8_WAIT_L(0); PG8_BAR; PG8_MMA(0, 0, At, B0); PG8_MMA(0, 1, At, B1); PG8_BAR; PG8_SCHED;
            PG8_LDA(At, 1, 1); PG8_STAGE(PG8_SB(1, 0), b3, voffB); PG8_STAGE(PG8_SB(1, 1), b3 + hstep, voffB); PG8_STAGE(PG8_SA(1, 0), a3, w0);
            PG8_WAIT_V(8); PG8_WAIT_L(0); PG8_BAR; PG8_MMA(1, 0, At, B0); PG8_MMA(1, 1, At, B1); PG8_BAR; PG8_SCHED;
        }
        if (wr == 0) PG8_BAR;
        E(acc, cur, wr, wc, fr, fq);
        if (!has_next) break;
#pragma unroll
        for (int a = 0; a < 2; ++a)
#pragma unroll
            for (int b = 0; b < 2; ++b)
#pragma unroll
                for (int m = 0; m < 4; ++m)
#pragma unroll
                    for (int n = 0; n < 2; ++n) acc[a][b][m][n] = (f32x4){0.f, 0.f, 0.f, 0.f};
        cur = nxt; cA = nA; cB = nB; ++ui;
#pragma unroll
        for (int i = 0; i < 2; ++i) { vA0[i] = nA0[i]; vA1[i] = nA1[i]; }
        if (wr == 1) PG8_BAR;
    }
    PG8_WAIT_V(0);
    PG8_BAR;
#undef PG8_SA
#undef PG8_SB
#undef PG8_STAGE
#undef PG8_LDA
#undef PG8_LDB
#undef PG8_MMA
#undef PG8_WAIT_V
#undef PG8_WAIT_L
#undef PG8_BAR
#undef PG8_SCHED
}

struct DenseOrder {
    const char* A; const char* Bt; int K, nM, nN, nwg, G, c, pn0;
    __device__ void init(const void* A_, const void* Bt_, int M, int N, int K_, int G_, int c_, int pn0_ = 0) { A = (const char*)A_; Bt = (const char*)Bt_; K = K_; nM = M / BM; nN = N / BM; nwg = nM * nN; G = G_; c = c_; pn0 = pn0_; }
    __device__ __forceinline__ bool next(int i, Unit& u) const {
        const long L = (long)i * G + c; if (L >= nwg) return false;
        int wgid = (int)L; { const int q = nwg / NXCD, r = nwg % NXCD, xcd = wgid % NXCD, off = wgid / NXCD; wgid = (xcd < r ? xcd * (q + 1) : r * (q + 1) + (xcd - r) * q) + off; }
        const int nig = WGM * nN, gid = wgid / nig, fm = gid * WGM, gsz = (nM - fm) < WGM ? (nM - fm) : WGM;
        u.pm = fm + ((wgid % nig) % gsz); u.pn = pn0 + (wgid % nig) / gsz; u.e = 0; u.nrows = BM; u.seg = 0;
        u.A = A + (size_t)u.pm * BM * K * 2; u.B = Bt + (size_t)u.pn * BM * K * 2; return true;
    }
    __device__ __forceinline__ unsigned a_row(const Unit&, int r, int K_) const { return (unsigned)(r * K_) * 2u; }
};
}

struct EpiInProj {
    static constexpr bool PERM = true;
    unsigned char* ws; const float2* RT;
    __device__ __forceinline__ void operator()(const f32x4 (&acc)[2][2][4][2], const pg8::Unit& u, int wr, int wc, int fr, int fq) const {
        const int seg = u.pn >> 1;
        bf16_t* dst = (bf16_t*)(ws + (seg == 0 ? WS_Q : seg == 1 ? WS_K : seg == 2 ? WS_V : seg == 3 ? WS_XR : WS_GG));
        const int row0 = u.pm * 256 + wr * 64 + fr, col0 = (u.pn & 1) * 256 + wc * 32 + 8 * fq;
        const bool rope = (seg <= 1) && ((wc & 1) == 0);
#pragma unroll
        for (int ai = 0; ai < 2; ++ai)
#pragma unroll
            for (int m = 0; m < 4; ++m) { const int row = row0 + ai * 128 + m * 16, pos = row & (SEQ - 1);
#pragma unroll
                for (int bj = 0; bj < 2; ++bj) { f32x4 v0 = acc[ai][bj][m][0], v1 = acc[ai][bj][m][1];
                    if (rope) {
                        f32x4 p0, p1;
                        p0.x = __shfl_xor(v0.x, 16); p0.y = __shfl_xor(v0.y, 16); p0.z = __shfl_xor(v0.z, 16); p0.w = __shfl_xor(v0.w, 16);
                        p1.x = __shfl_xor(v1.x, 16); p1.y = __shfl_xor(v1.y, 16); p1.z = __shfl_xor(v1.z, 16); p1.w = __shfl_xor(v1.w, 16);
                        if (fq < 2) { const float2* cs = RT + pos * 8; const float sg = (fq == 0) ? -1.f : 1.f;
                            const float2 c0 = cs[0], c1 = cs[1], c2 = cs[2], c3 = cs[3], c4 = cs[4], c5 = cs[5], c6 = cs[6], c7 = cs[7];
                            v0.x = v0.x * c0.x + sg * p0.x * c0.y; v0.y = v0.y * c1.x + sg * p0.y * c1.y; v0.z = v0.z * c2.x + sg * p0.z * c2.y; v0.w = v0.w * c3.x + sg * p0.w * c3.y;
                            v1.x = v1.x * c4.x + sg * p1.x * c4.y; v1.y = v1.y * c5.x + sg * p1.y * c5.y; v1.z = v1.z * c6.x + sg * p1.z * c6.y; v1.w = v1.w * c7.x + sg * p1.w * c7.y; }
                    }
                    if (seg == 0) { v0 = v0 * QSCALE; v1 = v1 * QSCALE; }
                    if (seg == 4) { v0.x = gelu_tanh(v0.x); v0.y = gelu_tanh(v0.y); v0.z = gelu_tanh(v0.z); v0.w = gelu_tanh(v0.w); v1.x = gelu_tanh(v1.x); v1.y = gelu_tanh(v1.y); v1.z = gelu_tanh(v1.z); v1.w = gelu_tanh(v1.w); }
                    u32x4 w; w.x = pk2(v0.x, v0.y); w.y = pk2(v0.z, v0.w); w.z = pk2(v1.x, v1.y); w.w = pk2(v1.z, v1.w);
                    *(u32x4*)(dst + (size_t)row * 512 + col0 + bj * 128) = w; } }
    }
};
__device__ __forceinline__ void phase1(const Args& a, LAS unsigned char* lds, int G, int c, int pn0, int ncols) {
    unsigned char* ws = a.ws;
    pg8::DenseOrder S; S.init(ws + WS_XN, ws + WS_WIN, MTOK, ncols, DM, G, c, pn0);
    EpiInProj E{ws, (const float2*)(ws + WS_RT)};
    pg8::gemm_phase(lds, DM, S, E);
}

namespace att {
constexpr int DQK = 64, DV = 128, QBLK = 32, KVBLK = 64, LD = 512;
constexpr float SCALE = 0.125f, THR = 8.f;
constexpr int SHM_V = KVBLK * DV * 2, SHM_K = KVBLK * DQK * 2, SHM_ATTN = 2 * SHM_V + 2 * SHM_K + NWAVES * 64 * 4;
#define KSWZ(row, colB) ((row) * 128 + ((colB) ^ ((((row) >> 1) & 7) << 4)))
#define SBAR() __builtin_amdgcn_sched_barrier(0)
__device__ __forceinline__ int crow(int r, int hi) { return (r & 3) + 8 * (r >> 2) + 4 * hi; }
__device__ __forceinline__ float max3f(float a, float b, float c) { float r; asm("v_max3_f32 %0, %1, %2, %3" : "=v"(r) : "v"(a), "v"(b), "v"(c)); return r; }
__device__ __forceinline__ unsigned cvtpk(float lo, float hi) { unsigned r; asm volatile("v_cvt_pk_bf16_f32 %0, %1, %2" : "=v"(r) : "v"(lo), "v"(hi)); return r; }

constexpr float THRL = 11.0f;
__device__ __forceinline__ float rowmax_a(const f32x16& p0) {
    float pmax = p0[0];
#pragma unroll
    for (int r = 1; r < 16; ++r) pmax = fmaxf(pmax, p0[r]);
    return pmax;
}
__device__ __forceinline__ float rowmax_b(const f32x16& p1, float pmax) {
#pragma unroll
    for (int r = 0; r < 16; ++r) pmax = fmaxf(pmax, p1[r]);
    auto rr = __builtin_amdgcn_permlane32_swap(__float_as_uint(pmax), __float_as_uint(pmax), false, false);
    return fmaxf(__uint_as_float(rr[0]), __uint_as_float(rr[1]));
}
template <bool FIRST> __device__ __forceinline__ void decide(float rm, f32x16& p0, f32x16& p1, float& mhat, f32x16& negm, float& alpha) {
    alpha = 1.f;
    if (FIRST || __builtin_expect(__any(rm > THRL), 0)) {
        const float dl = FIRST ? rm : fmaxf(rm, 0.f);
        mhat += dl;
#pragma unroll
        for (int r = 0; r < 16; ++r) { p0[r] -= dl; p1[r] -= dl; }
#pragma unroll
        for (int r = 0; r < 16; ++r) negm[r] = -mhat;
        alpha = __builtin_amdgcn_exp2f(-dl);
    }
}
template <int VAR> __device__ __forceinline__ void exp16(f32x16& p) {
#pragma unroll
    for (int r = 0; r < 16; ++r) p[r] = (VAR & 2) ? p[r] * 0.001f : __builtin_amdgcn_exp2f(p[r]);
}
template <int VAR> __device__ __forceinline__ float expsum16(f32x16& p) {
    exp16<VAR>(p);
    float ps = 0;
#pragma unroll
    for (int r = 0; r < 16; ++r) ps += p[r];
    return ps;
}
__device__ __forceinline__ float halves_sum(float ps) {
    auto rr = __builtin_amdgcn_permlane32_swap(__float_as_uint(ps), __float_as_uint(ps), false, false);
    return __uint_as_float(rr[0]) + __uint_as_float(rr[1]);
}
__device__ __forceinline__ void pack4(const f32x16& p0, const f32x16& p1, bf16x8& pa0, bf16x8& pa1, bf16x8& pa2, bf16x8& pa3) {
#define PK4(P, BASE, OUT) do { u32x4 w = {cvtpk(P[BASE + 0], P[BASE + 1]), cvtpk(P[BASE + 2], P[BASE + 3]), cvtpk(P[BASE + 4], P[BASE + 5]), cvtpk(P[BASE + 6], P[BASE + 7])}; OUT = *reinterpret_cast<bf16x8*>(&w); } while (0)
    PK4(p0, 0, pa0); PK4(p0, 8, pa1); PK4(p1, 0, pa2); PK4(p1, 8, pa3);
#undef PK4
}
typedef short v4i16_t __attribute__((ext_vector_type(4)));
__device__ __forceinline__ s16x4 vtr(const LAS char* p) { return __builtin_bit_cast(s16x4, __builtin_amdgcn_ds_read_tr16_b64_v4i16((LAS v4i16_t*)p)); }
__device__ __forceinline__ void glds16(const void* gsrc, unsigned lds_dst) { unsigned keep;
    asm volatile("s_mov_b32 %0, m0\n\ts_mov_b32 m0, %2\n\ts_nop 0\n\tglobal_load_lds_dwordx4 %1, off\n\ts_mov_b32 m0, %0" : "=&s"(keep) : "v"(gsrc), "s"(lds_dst) : "memory"); }
#define WAIT_BAR(N) asm volatile("s_waitcnt vmcnt(" #N ") lgkmcnt(0)\n\ts_barrier" ::: "memory")

constexpr int NKS = 4, NVS = 5, SHM_VR = NVS * SHM_V, SHM_KR = NKS * SHM_K, SHM_ATTN2 = SHM_VR + SHM_KR + NWAVES * 64 * 4;
template <int VAR> __device__ __forceinline__ void attn_pass(const bf16_t* __restrict__ Qb, const bf16_t* __restrict__ Kh, const bf16_t* __restrict__ Vh, int seq, char* lds,
                                          f32x16 (&o)[4], float (&rli)[16], bool prefetched, const bf16_t* nKh, const bf16_t* nVh) {
    int tid_ = threadIdx.x; asm volatile("" : "+v"(tid_));
    const int tid = tid_, lane = tid & 63, r32 = lane & 31, hi = lane >> 5; const int wid = __builtin_amdgcn_readfirstlane(tid >> 6);
    char* V_lds = lds; char* K_lds = lds + SHM_VR;
    float* wsf = (float*)(lds + SHM_VR + SHM_KR) + wid * 64; float* li_l = wsf; float* al_l = wsf + 32;
    const unsigned ldsV = (unsigned)(uintptr_t)V_lds, ldsK = (unsigned)(uintptr_t)K_lds;
    float mhat = 0.f, l_reg = 0.f; f32x16 negm = f32x16{};
#pragma unroll
    for (int d = 0; d < 4; ++d) o[d] = f32x16{};
    bf16x8 qr[4];
    const bf16_t* Qw = Qb + (long)(wid * QBLK + r32) * LD + hi * 8;
#pragma unroll
    for (int d0 = 0; d0 < 4; ++d0) qr[d0] = *reinterpret_cast<const bf16x8*>(Qw + d0 * 16);
    const bf16_t* ksrc = Kh + (long)lane * LD + wid * 8;
    const bf16_t* vsrc0 = Vh + (long)(16 * (wid & 3) + (lane >> 2)) * LD + (wid >> 2) * 32 + (lane & 3) * 8;
    const bf16_t* vsrc1 = vsrc0 + 64;
    const unsigned kdst = ldsK + wid * 1024, vdst0 = ldsV + wid * 1024, vdst1 = ldsV + (wid + 8) * 1024;
#define DMA(t, ko, vo) do { const long go_ = (long)(t) * KVBLK * LD; \
        glds16(ksrc + go_, (unsigned)__builtin_amdgcn_readfirstlane(kdst + (ko))); \
        glds16(vsrc0 + go_, (unsigned)__builtin_amdgcn_readfirstlane(vdst0 + (vo))); \
        glds16(vsrc1 + go_, (unsigned)__builtin_amdgcn_readfirstlane(vdst1 + (vo))); } while (0)
#define RESC(al) do { if (__any((al) < 1.f)) { if (hi == 0) al_l[r32] = (al); asm volatile("s_waitcnt lgkmcnt(0)" ::: "memory"); \
    _Pragma("unroll") for (int d = 0; d < 4; ++d) _Pragma("unroll") for (int r = 0; r < 16; ++r) o[d][r] *= al_l[crow(r, hi)]; } } while (0)
    f32x16 pA0, pA1, pB0, pB1; const int NT = seq / KVBLK;
    int kr_ = 0, kw_ = 3 * SHM_K, vr_ = 4 * SHM_V, vw_ = 3 * SHM_V;
#define ROT() do { kr_ = (kr_ == 3 * SHM_K) ? 0 : kr_ + SHM_K; kw_ = (kw_ == 3 * SHM_K) ? 0 : kw_ + SHM_K; vr_ = (vr_ == 4 * SHM_V) ? 0 : vr_ + SHM_V; vw_ = (vw_ == 4 * SHM_V) ? 0 : vw_ + SHM_V; } while (0)
    const LAS char* K3 = (const LAS char*)K_lds + hi * 1024 + r32 * 16;
    const LAS char* V3 = (const LAS char*)V_lds + ((lane >> 4) & 1) * 32 + (lane & 3) * 8 + (4 * hi + ((lane & 15) >> 2)) * 64;
    bf16x8 kf[4]; s16x4 vlo[8], vhi[8]; bf16x8 pa[4];
#define KRD(i) do { if (VAR & 64) kf[(i) & 3] = qr[(i) & 3]; else kf[(i) & 3] = *(const LAS bf16x8*)(kp_ + ((i) >> 1) * 2048 + ((i) & 1) * 512); } while (0)
#define VRD(i) do { if (VAR & 32) { vlo[(i) & 7] = (s16x4){qr[0][0], qr[1][1], qr[2][2], qr[3][3]}; vhi[(i) & 7] = (s16x4){qr[0][4], qr[1][5], qr[2][6], qr[3][7]}; } \
                    else { vlo[(i) & 7] = vtr(vp_ + ((i) & 3) * 4096 + ((i) >> 2) * 1024); vhi[(i) & 7] = vtr(vp_ + ((i) & 3) * 4096 + ((i) >> 2) * 1024 + 512); } } while (0)
#define VFR(s) (bf16x8){vlo[s][0], vlo[s][1], vlo[s][2], vlo[s][3], vhi[s][0], vhi[s][1], vhi[s][2], vhi[s][3]}
#define QKM(PC0, PC1, i) do { if (VAR & 16) { if (((i) >> 1) == 0) { if (((i) & 1) == 0) PC0 = negm; else PC1 = negm; } if (((i) & 1) == 0) PC0[(i)] += __builtin_bit_cast(float, (int)kf[(i) & 3][0]); else PC1[(i)] += __builtin_bit_cast(float, (int)kf[(i) & 3][1]); } \
        else if (((i) & 1) == 0) PC0 = __builtin_amdgcn_mfma_f32_32x32x16_bf16(kf[(i) & 3], qr[(i) >> 1], ((i) >> 1) == 0 ? negm : PC0, 0, 0, 0); \
        else PC1 = __builtin_amdgcn_mfma_f32_32x32x16_bf16(kf[(i) & 3], qr[(i) >> 1], ((i) >> 1) == 0 ? negm : PC1, 0, 0, 0); } while (0)
#define PVM(i) do { if (VAR & 8) o[(i) & 3][(i)] += __builtin_bit_cast(float, (int)(pa[(i) >> 2][0] + vlo[(i) & 7][0] + vhi[(i) & 7][1])); else o[(i) & 3] = __builtin_amdgcn_mfma_f32_32x32x16_bf16(pa[(i) >> 2], VFR((i) & 7), o[(i) & 3], 0, 0, 0); } while (0)
#define PKA(P, B) do { ca0_ = cvtpk(P[B + 0], P[B + 1]); ca1_ = cvtpk(P[B + 2], P[B + 3]); cb0_ = cvtpk(P[B + 4], P[B + 5]); cb1_ = cvtpk(P[B + 6], P[B + 7]); } while (0)
#define PKB(k) do { u32x4 w_ = {ca0_, ca1_, cb0_, cb1_}; pa[k] = __builtin_bit_cast(bf16x8, w_); } while (0)
#define MAX8(acc, P, B) if (!(VAR & 256)) { acc = max3f(acc, P[B], P[B + 1]); pmb_ = max3f(pmb_, P[B + 2], P[B + 3]); acc = max3f(acc, P[B + 4], P[B + 5]); pmb_ = max3f(pmb_, P[B + 6], P[B + 7]); }
#define EX4(P, B) do { P[B] = (VAR & 2) ? P[B] * 0.001f : __builtin_amdgcn_exp2f(P[B]); P[B + 1] = (VAR & 2) ? P[B + 1] * 0.001f : __builtin_amdgcn_exp2f(P[B + 1]); \
                       P[B + 2] = (VAR & 2) ? P[B + 2] * 0.001f : __builtin_amdgcn_exp2f(P[B + 2]); P[B + 3] = (VAR & 2) ? P[B + 3] * 0.001f : __builtin_amdgcn_exp2f(P[B + 3]); \
                       ps2_ += (f32x2){P[B], P[B + 1]}; ps2_ += (f32x2){P[B + 2], P[B + 3]}; } while (0)
#define ENDW(j) do { if (VAR & 2048) { asm volatile("s_waitcnt lgkmcnt(0)" ::: "memory"); } else if ((j) + 3 < NT) WAIT_BAR(6); else if ((j) + 2 < NT) WAIT_BAR(3); else WAIT_BAR(0); } while (0)
    if (!prefetched) { __syncthreads();
        DMA(0, 0, 0); DMA(1, SHM_K, SHM_V); DMA(2, 2 * SHM_K, 2 * SHM_V);
        WAIT_BAR(6); }
    else WAIT_BAR(0);
    { DMA(3, kw_, vw_); SBAR();
      const LAS char* kp_ = K3 + kr_;
      KRD(0); KRD(1); KRD(2); KRD(3);
      QKM(pA0, pA1, 0); KRD(4); QKM(pA0, pA1, 1); KRD(5); QKM(pA0, pA1, 2); KRD(6); QKM(pA0, pA1, 3); KRD(7);
      QKM(pA0, pA1, 4); QKM(pA0, pA1, 5); QKM(pA0, pA1, 6); QKM(pA0, pA1, 7);
      const float rm = rowmax_b(pA1, rowmax_a(pA0)); float al_; decide<true>(rm, pA0, pA1, mhat, negm, al_); float ps = expsum16<VAR>(pA0); ps += expsum16<VAR>(pA1); l_reg = halves_sum(ps); }
    ENDW(0); ROT();
#define STEP(PC0, PC1, PP0, PP1, j) do { \
        if (!(VAR & 4096)) { if ((j) + 3 < NT) DMA((j) + 3, kw_, vw_); } SBAR(); \
        const LAS char* kp_ = K3 + kr_; const LAS char* vp_ = V3 + vr_; \
        unsigned ca0_, ca1_, cb0_, cb1_; float pmx_, pmb_, al_; f32x2 ps2_ = (f32x2){0.f, 0.f}; \
        KRD(0); KRD(1); KRD(2); KRD(3); VRD(0); VRD(1); PKA(PP0, 0); PKB(0); PKA(PP0, 8); PKB(1); SBAR(); \
        QKM(PC0, PC1, 0); KRD(4); VRD(2); PKA(PP1, 0); SBAR(); \
        QKM(PC0, PC1, 1); KRD(5); VRD(3); PKB(2); SBAR(); \
        QKM(PC0, PC1, 2); KRD(6); VRD(4); PKA(PP1, 8); SBAR(); \
        QKM(PC0, PC1, 3); KRD(7); VRD(5); PKB(3); SBAR(); \
        QKM(PC0, PC1, 4); VRD(6); SBAR(); \
        QKM(PC0, PC1, 5); VRD(7); SBAR(); \
        QKM(PC0, PC1, 6); SBAR(); \
        QKM(PC0, PC1, 7); SBAR(); \
        PVM(0); VRD(8); pmx_ = PC0[0]; pmb_ = PC0[2]; MAX8(pmx_, PC0, 0); SBAR(); \
        PVM(1); VRD(9); MAX8(pmx_, PC0, 8); SBAR(); \
        PVM(2); VRD(10); MAX8(pmx_, PC1, 0); SBAR(); \
        PVM(3); VRD(11); MAX8(pmx_, PC1, 8); pmx_ = fmaxf(pmx_, pmb_); { auto rr_ = __builtin_amdgcn_permlane32_swap(__float_as_uint(pmx_), __float_as_uint(pmx_), false, false); pmx_ = fmaxf(__uint_as_float(rr_[0]), __uint_as_float(rr_[1])); } SBAR(); \
        PVM(4); VRD(12); decide<false>(pmx_, PC0, PC1, mhat, negm, al_); SBAR(); \
        PVM(5); VRD(13); EX4(PC0, 0); SBAR(); \
        PVM(6); VRD(14); EX4(PC0, 4); SBAR(); \
        PVM(7); VRD(15); EX4(PC0, 8); SBAR(); \
        PVM(8); EX4(PC0, 12); SBAR(); \
        PVM(9); EX4(PC1, 0); SBAR(); \
        PVM(10); EX4(PC1, 4); SBAR(); \
        PVM(11); EX4(PC1, 8); SBAR(); \
        PVM(12); EX4(PC1, 12); SBAR(); \
        PVM(13); l_reg = l_reg * al_ + halves_sum(ps2_.x + ps2_.y); SBAR(); \
        PVM(14); PVM(15); SBAR(); \
        ENDW(j); RESC(al_); ROT(); } while (0)
    for (int j = 1; j + 1 < NT; j += 2) {
        STEP(pB0, pB1, pA0, pA1, j);
        STEP(pA0, pA1, pB0, pB1, j + 1);
    }
    STEP(pB0, pB1, pA0, pA1, NT - 1);
    if (nKh) {
        const bf16_t* ksrcn = nKh + (long)lane * LD + wid * 8; const bf16_t* vsrcn = nVh + (long)(16 * (wid & 3) + (lane >> 2)) * LD + (wid >> 2) * 32 + (lane & 3) * 8;
#pragma unroll
        for (int t = 0; t < 3; ++t) { const long go_ = (long)t * KVBLK * LD;
            glds16(ksrcn + go_, (unsigned)__builtin_amdgcn_readfirstlane(kdst + t * SHM_K));
            glds16(vsrcn + go_, (unsigned)__builtin_amdgcn_readfirstlane(vdst0 + t * SHM_V));
            glds16(vsrcn + 64 + go_, (unsigned)__builtin_amdgcn_readfirstlane(vdst1 + t * SHM_V)); } }
    { const LAS char* vp_ = V3 + vr_; unsigned ca0_, ca1_, cb0_, cb1_;
      PKA(pB0, 0); PKB(0); PKA(pB0, 8); PKB(1); PKA(pB1, 0); PKB(2); PKA(pB1, 8); PKB(3);
      VRD(0); VRD(1); VRD(2); VRD(3); VRD(4); VRD(5); VRD(6); VRD(7);
      PVM(0); VRD(8); PVM(1); VRD(9); PVM(2); VRD(10); PVM(3); VRD(11); PVM(4); VRD(12); PVM(5); VRD(13); PVM(6); VRD(14); PVM(7); VRD(15);
      PVM(8); PVM(9); PVM(10); PVM(11); PVM(12); PVM(13); PVM(14); PVM(15); }
    if (hi == 0) li_l[r32] = l_reg; asm volatile("s_waitcnt lgkmcnt(0)" ::: "memory");
#pragma unroll
    for (int r = 0; r < 16; ++r) rli[r] = __builtin_amdgcn_rcpf(li_l[crow(r, hi)]);
#undef DMA
#undef RESC
#undef ROT
#undef KRD
#undef VRD
#undef VFR
#undef QKM
#undef PVM
#undef PKA
#undef PKB
#undef MAX8
#undef EX4
#undef ENDW
#undef STEP
}
#undef WAIT_BAR
#undef KSWZ
#undef SBAR
}

template <int VAR> __device__ __forceinline__ void phase2_attn(const Args& a, char* lds, int nblk, int blk) {
    unsigned char* ws = a.ws;
    const bf16_t* Qb = (const bf16_t*)(ws + WS_Q); const bf16_t* Kb = (const bf16_t*)(ws + WS_K); const bf16_t* Vb = (const bf16_t*)(ws + WS_V);
    float* OS = (float*)(ws + WS_O0) + (size_t)blk * 32768;
    bf16_t* MIX = (bf16_t*)(ws + WS_MIX);
    const float lambda_init = 0.2f;
    float lam;
    { const int l0 = threadIdx.x & 63; const float d1 = wave_sum(a.in[3][l0] * a.in[4][l0]), d2 = wave_sum(a.in[5][l0] * a.in[6][l0]); lam = expf(d1) - expf(d2) + lambda_init; }
    const int seq = (VAR & 16384) ? SEQ / 2 : SEQ;
    bool pref = false;
    for (int u = blk; u < NBATCH * 4 * 16; u += nblk) {
        const int b = u >> 6, h = (u >> 4) & 3, qb = u & 15;
        const long row0 = (long)b * SEQ + qb * 256;
        const bf16_t* Kbh = Kb + (long)b * SEQ * 512 + h * 128; const bf16_t* Vbh = Vb + (long)b * SEQ * 512 + h * 128;
        const int un = u + nblk; const bool hasn = un < NBATCH * 4 * 16;
        const bf16_t* Kn = hasn ? Kb + (long)(un >> 6) * SEQ * 512 + ((un >> 4) & 3) * 128 : nullptr; const bf16_t* Vn = hasn ? Vb + (long)(un >> 6) * SEQ * 512 + ((un >> 4) & 3) * 128 : nullptr;
        for (int m = 0; m < 2; ++m) {
            f32x16 o[4]; float rli[16];
            att::attn_pass<VAR>(Qb + row0 * 512 + (h * 2 + m) * 64, Kbh + m * 64, Vbh, seq, lds, o, rli, pref, m == 0 ? Kbh + 64 : Kn, m == 0 ? Vbh : Vn);
            pref = (m == 0) || hasn;
            int tid_ = threadIdx.x; asm volatile("" : "+v"(tid_));
            const int wid = tid_ >> 6, r32 = tid_ & 31, hi = (tid_ >> 5) & 1;
            float* od = OS + (wid * 32) * 128 + r32;
            if (m == 0) {
#pragma unroll
                for (int r = 0; r < 16; ++r) { const int orow = att::crow(r, hi);
#pragma unroll
                    for (int d0 = 0; d0 < 4; ++d0) od[orow * 128 + d0 * 32] = o[d0][r] * rli[r]; }
            } else {
                float ss[16];
#pragma unroll
                for (int r = 0; r < 16; ++r) ss[r] = 0.f;
#pragma unroll
                for (int d0 = 0; d0 < 4; ++d0) {
#pragma unroll
                    for (int r = 0; r < 16; ++r) { const float v = od[att::crow(r, hi) * 128 + d0 * 32] - lam * (o[d0][r] * rli[r]); o[d0][r] = v; ss[r] = fmaf(v, v, ss[r]); }
                    asm volatile("" ::: "memory"); }
                float gs[4];
#pragma unroll
                for (int d0 = 0; d0 < 4; ++d0) gs[d0] = a.in[7][d0 * 32 + r32] * (1.0f - lambda_init);
                bf16_t* dst = MIX + (size_t)(row0 + wid * 32) * 1024 + h * 128 + r32;
#pragma unroll
                for (int r = 0; r < 16; ++r) { float s = ss[r];
                    s += __shfl_xor(s, 1); s += __shfl_xor(s, 2); s += __shfl_xor(s, 4); s += __shfl_xor(s, 8); s += __shfl_xor(s, 16);
                    const float rstd = __builtin_amdgcn_rsqf(s * (1.0f / 128.f) + EPS);
                    if (VAR == 0) {
#pragma unroll
                        for (int d0 = 0; d0 < 4; ++d0) dst[att::crow(r, hi) * 1024 + d0 * 32] = (bf16_t)pk2(o[d0][r] * rstd * gs[d0], 0.f); }
                    else if (rstd == 123.456f) dst[0] = 1; }
            }
        }
    }
}

constexpr int LRU_XS = 68;
constexpr int LRU_HS = 36;
__device__ __forceinline__ void phase2_lru(const Args& a, LAS unsigned char* lds, int nblk, int blk) {
    unsigned char* ws = a.ws;
    const bf16_t* XR = (const bf16_t*)(ws + WS_XR); const bf16_t* GG = (const bf16_t*)(ws + WS_GG);
    float* H1 = (float*)(ws + WS_HF); bf16_t* MIX = (bf16_t*)(ws + WS_MIX);
    LAS float* xcf = (LAS float*)lds;
    LAS float* hsm = xcf + 2 * 2 * 64 * LRU_XS;
    const int tid = threadIdx.x, lane = tid & 63, wave = __builtin_amdgcn_readfirstlane(tid >> 6);
    const int c16 = lane & 15, fq = lane >> 4;
    const int sch = tid & 63, sdir = wave >> 2, sp0 = 16 * (wave & 3);
    const int dir = wave >> 1, cth = wave & 1;
    const int io = tid & 255, ic4 = io & 7, iorow = io >> 3;
    for (int u = blk; u < NBATCH * 16; u += nblk) {
        const int b = u >> 4, kb = (u >> 1) & 7, chalf = u & 1;
        const bf16_t* XRb = XR + (size_t)b * SEQ * 512; const bf16_t* GGb = GG + (size_t)b * SEQ * 512; float* H1b = H1 + (size_t)b * SEQ * 512; bf16_t* MIXb = MIX + (size_t)b * SEQ * 1024;
        const int schg = kb * 64 + sch;
        float k0, k1, k2, k3; const float cbias = a.in[9][schg];
        { const float w0 = a.in[8][0 * 512 + schg], w1 = a.in[8][1 * 512 + schg], w2 = a.in[8][2 * 512 + schg], w3 = a.in[8][3 * 512 + schg];
          if (sdir == 0) { k0 = w0; k1 = w1; k2 = w2; k3 = w3; } else { k0 = w3; k1 = w2; k2 = w1; k3 = w0; } }
        const int chl = chalf * 32 + cth * 16 + c16, chg = kb * 64 + chl;
        bf16x8 wrf[2], wif[2]; float brs = 0.f, bis = 0.f, kA2 = 0.f;
        if (wave < 4) {
            const float* wrp = a.in[10] + (size_t)(dir * 8 + kb) * 4096 + chl; const float* wip = a.in[12] + (size_t)(dir * 8 + kb) * 4096 + chl;
            constexpr float NL2E = -1.4426950408889634f;
#pragma unroll
            for (int ks = 0; ks < 2; ++ks) { u32x4 pr, pi;
                const int kk = 32 * ks + 8 * fq;
                pr.x = pk2(wrp[(kk + 0) * 64] * NL2E, wrp[(kk + 1) * 64] * NL2E); pr.y = pk2(wrp[(kk + 2) * 64] * NL2E, wrp[(kk + 3) * 64] * NL2E);
                pr.z = pk2(wrp[(kk + 4) * 64] * NL2E, wrp[(kk + 5) * 64] * NL2E); pr.w = pk2(wrp[(kk + 6) * 64] * NL2E, wrp[(kk + 7) * 64] * NL2E);
                pi.x = pk2(wip[(kk + 0) * 64] * NL2E, wip[(kk + 1) * 64] * NL2E); pi.y = pk2(wip[(kk + 2) * 64] * NL2E, wip[(kk + 3) * 64] * NL2E);
                pi.z = pk2(wip[(kk + 4) * 64] * NL2E, wip[(kk + 5) * 64] * NL2E); pi.w = pk2(wip[(kk + 6) * 64] * NL2E, wip[(kk + 7) * 64] * NL2E);
                wrf[ks] = __builtin_bit_cast(bf16x8, pr); wif[ks] = __builtin_bit_cast(bf16x8, pi); }
            brs = a.in[11][dir * 512 + chg] * NL2E; bis = a.in[13][dir * 512 + chg] * NL2E;
            const float nl = -a.in[14][dir * 512 + chg];
            const float sp = (nl > 15.f) ? nl : log1pf(expf(nl));
            kA2 = -8.0f * sp * 1.4426950408889634f;
        }
        float carry = 0.f;
        unsigned short er0[19], er1[19];
        auto stage_ld = [&](int st, unsigned short (&er)[19]) {
            const int t0 = (sdir == 0) ? 64 * st : 64 * (63 - st);
            const int tk0 = (sdir == 0) ? (t0 + sp0) : (t0 + 63 - sp0);
            const int sgn = (sdir == 0) ? 1 : -1, tbase = (sdir == 0) ? tk0 - 2 : tk0 + 1;
#pragma unroll
            for (int i = 0; i < 19; ++i) { const int t = tbase + sgn * i; er[i] = XRb[(long)(t * 512 + schg)]; }
        };
        auto stage_wr = [&](int st, const unsigned short (&er)[19]) {
            const int stc = st < 64 ? st : 63;
            const int t0 = (sdir == 0) ? 64 * stc : 64 * (63 - stc);
            const int tk0 = (sdir == 0) ? (t0 + sp0) : (t0 + 63 - sp0);
            const int sgn = (sdir == 0) ? 1 : -1, tbase = (sdir == 0) ? tk0 - 2 : tk0 + 1;
            float e[19];
            if (stc == 0 || stc == 63) {
#pragma unroll
                for (int i = 0; i < 19; ++i) { const int t = tbase + sgn * i; e[i] = (t >= 0 && t < SEQ) ? bf2f(er[i]) : 0.f; }
            } else {
#pragma unroll
                for (int i = 0; i < 19; ++i) e[i] = bf2f(er[i]);
            }
            LAS float* xd = xcf + ((st & 1) * 2 + sdir) * 64 * LRU_XS + sp0 * LRU_XS + sch;
#pragma unroll
            for (int q = 0; q < 16; ++q) xd[q * LRU_XS] = cbias + k0 * e[q] + k1 * e[q + 1] + k2 * e[q + 2] + k3 * e[q + 3];
        };
        const int ichg = kb * 64 + chalf * 32 + 4 * ic4;
        f32x4 hoth0[4], hoth1[4]; u32x2 ggv0[4], ggv1[4];
        auto io_ld = [&](int st, f32x4 (&hoth)[4], u32x2 (&ggv)[4]) {
#pragma unroll
            for (int k = 0; k < 4; ++k) { const int r = iorow + 32 * k, d = r >> 6, p = r & 63; const int tok = (d == 0) ? 64 * st + p : 64 * (63 - st) + 63 - p;
                hoth[k] = *(const f32x4*)(H1b + (unsigned)(tok * 512 + ichg)); ggv[k] = *(const u32x2*)(GGb + (unsigned)(tok * 512 + ichg)); }
        };
        auto io_out = [&](int st, const f32x4 (&hoth)[4], const u32x2 (&ggv)[4]) {
#pragma unroll
            for (int k = 0; k < 4; ++k) { const int r = iorow + 32 * k, d = r >> 6, p = r & 63; const int tok = (d == 0) ? 64 * st + p : 64 * (63 - st) + 63 - p;
                const f32x4 h = *(const LAS f32x4*)(hsm + ((st & 1) * 2 + d) * 64 * LRU_HS + p * LRU_HS + 4 * ic4);
                if (st < 32) *(f32x4*)(H1b + (unsigned)(tok * 512 + ichg)) = h;
                else { f32x4 g; g.x = __builtin_bit_cast(float, ggv[k].x << 16); g.y = __builtin_bit_cast(float, ggv[k].x & 0xffff0000u); g.z = __builtin_bit_cast(float, ggv[k].y << 16); g.w = __builtin_bit_cast(float, ggv[k].y & 0xffff0000u);
                    store_bf16x4(MIXb + (unsigned)(tok * 1024 + 512 + ichg), (h + hoth[k]) * g); } }
        };
        auto body = [&](int s, bool second, unsigned short (&er)[19], f32x4 (&hoth)[4], u32x2 (&ggv)[4]) {
            stage_wr(s + 1, er);
            stage_ld(s + 3 < 64 ? s + 3 : 63, er);
            if (wave < 4) {
                if (s < 64) {
                const LAS float* xb = xcf + ((s & 1) * 2 + dir) * 64 * LRU_XS;
                LAS float* hb = hsm + ((s & 1) * 2 + dir) * 64 * LRU_HS + cth * 16 + c16;
#pragma unroll
                for (int tt = 0; tt < 4; ++tt) {
                    f32x4 ra = (f32x4){0.f, 0.f, 0.f, 0.f}, ia = (f32x4){0.f, 0.f, 0.f, 0.f};
#pragma unroll
                    for (int ks = 0; ks < 2; ++ks) { const LAS f32x4* xp = (const LAS f32x4*)(xb + (16 * tt + c16) * LRU_XS + 32 * ks + 8 * fq);
                        const f32x4 x0 = xp[0], x1 = xp[1]; u32x4 pa; pa.x = att::cvtpk(x0.x, x0.y); pa.y = att::cvtpk(x0.z, x0.w); pa.z = att::cvtpk(x1.x, x1.y); pa.w = att::cvtpk(x1.z, x1.w);
                        const bf16x8 af = __builtin_bit_cast(bf16x8, pa);
                        ra = __builtin_amdgcn_mfma_f32_16x16x32_bf16(af, wrf[ks], ra, 0, 0, 0);
                        ia = __builtin_amdgcn_mfma_f32_16x16x32_bf16(af, wif[ks], ia, 0, 0, 0); }
                    float Ap[4], Hp[4];
#pragma unroll
                    for (int j = 0; j < 4; ++j) { const float xv = xb[(16 * tt + 4 * fq + j) * LRU_XS + chl];
                        const float r = __builtin_amdgcn_rcpf(1.0f + __builtin_amdgcn_exp2f(ra[j] + brs));
                        const float ig = __builtin_amdgcn_rcpf(1.0f + __builtin_amdgcn_exp2f(ia[j] + bis));
                        const float aa = __builtin_amdgcn_exp2f(kA2 * r);
                        const float uv = __builtin_amdgcn_sqrtf(fmaxf(1.0f - aa * aa, 0.f)) * (ig * xv);
                        if (j == 0) { Ap[0] = aa; Hp[0] = uv; } else { Ap[j] = aa * Ap[j - 1]; Hp[j] = fmaf(aa, Hp[j - 1], uv); } }
                    float Ag = Ap[3], Hg = Hp[3];
                    { const float A1 = __shfl_up(Ag, 16), Hs1 = __shfl_up(Hg, 16); if (fq >= 1) { Hg = fmaf(Ag, Hs1, Hg); Ag = Ag * A1; } }
                    { const float A2 = __shfl_up(Ag, 32), Hs2 = __shfl_up(Hg, 32); if (fq >= 2) { Hg = fmaf(Ag, Hs2, Hg); Ag = Ag * A2; } }
                    float EA = __shfl_up(Ag, 16), EH = __shfl_up(Hg, 16); if (fq == 0) { EA = 1.f; EH = 0.f; }
                    const float TA = __shfl(Ag, 48 + c16), TH = __shfl(Hg, 48 + c16);
                    const float gin = fmaf(EA, carry, EH);
#pragma unroll
                    for (int j = 0; j < 4; ++j) hb[(16 * tt + 4 * fq + j) * LRU_HS] = fmaf(Ap[j], gin, Hp[j]);
                    carry = fmaf(TA, carry, TH);
                }
                }
            } else {
                if (s >= 1) io_out(s - 1, hoth, ggv);
                if (second) io_ld(s + 1 < 64 ? s + 1 : 63, hoth, ggv);
            }
            __syncthreads();
        };
        __syncthreads();
        stage_ld(0, er0); stage_wr(0, er0); stage_ld(1, er1); stage_ld(2, er0);
        __syncthreads();
        body(0, false, er1, hoth1, ggv1);
        for (int s = 1; s <= 31; s += 2) { body(s, false, er0, hoth0, ggv0); body(s + 1, false, er1, hoth1, ggv1); }
        if (wave >= 4) { io_ld(32, hoth0, ggv0); io_ld(33, hoth1, ggv1); }
        for (int s = 33; s <= 63; s += 2) { body(s, true, er0, hoth0, ggv0); body(s + 1, true, er1, hoth1, ggv1); }
    }
}

struct EpiOutProj {
    static constexpr bool PERM = true;
    const float* x; bf16_t* X1;
    __device__ __forceinline__ void operator()(const f32x4 (&acc)[2][2][4][2], const pg8::Unit& u, int wr, int wc, int fr, int fq) const {
        const int row0 = u.pm * 256 + wr * 64 + fr, col0 = u.pn * 256 + wc * 32 + 8 * fq;
#pragma unroll
        for (int ai = 0; ai < 2; ++ai)
#pragma unroll
            for (int m = 0; m < 4; ++m) { const size_t rowoff = (size_t)(row0 + ai * 128 + m * 16) * DM + col0;
#pragma unroll
                for (int bj = 0; bj < 2; ++bj) { const size_t off = rowoff + bj * 128;
                    const f32x4 v0 = *(const f32x4*)(x + off) + acc[ai][bj][m][0], v1 = *(const f32x4*)(x + off + 4) + acc[ai][bj][m][1];
                    u32x4 w; w.x = pk2(v0.x, v0.y); w.y = pk2(v0.z, v0.w); w.z = pk2(v1.x, v1.y); w.w = pk2(v1.z, v1.w);
                    *(u32x4*)(X1 + off) = w; } }
    }
};
__device__ __forceinline__ void phase3(const Args& a, LAS unsigned char* lds, int nblk, int blk) {
    unsigned char* ws = a.ws;
    pg8::DenseOrder S; S.init(ws + WS_MIX, ws + WS_WOUT, MTOK, DM, DM, nblk, blk);
    EpiOutProj E{a.in[0], (bf16_t*)(ws + WS_X1)};
    pg8::gemm_phase(lds, DM, S, E);
}

template <bool DUMMY> __device__ __forceinline__ void phase4(const Args& a, LAS unsigned char* lds, int nblk, int blk) {
    unsigned char* ws = a.ws;
    const bf16_t* X1 = (const bf16_t*)(ws + WS_X1); const float* g2 = a.in[16]; bf16_t* H2 = (bf16_t*)(ws + WS_XN);
    const bf16_t* WRH = (const bf16_t*)(ws + WS_WRH); const bf16_t* WRL = (const bf16_t*)(ws + WS_WRL);
    int* cnt = (int*)(ws + WS_CTL); int* LIST = (int*)(ws + WS_LIST); float* EW = (float*)(ws + WS_EW);
    LAS float* part = (LAS float*)lds;
    LAS float* tot = part + 8 * 16 * 52;
    LAS float* rs = tot + 16 * 52;
    const int tid = threadIdx.x, lane = tid & 63, wave = __builtin_amdgcn_readfirstlane(tid >> 6), r16 = lane & 15, kg = lane >> 4;
    const int kbase = 128 * wave + 8 * kg;
    bf16x8 bh[4][3], bl[4][3];
#pragma unroll
    for (int ks = 0; ks < 4; ++ks)
#pragma unroll
        for (int nt = 0; nt < 3; ++nt) { bh[ks][nt] = *(const bf16x8*)(WRH + (size_t)(16 * nt + r16) * DM + kbase + 32 * ks); bl[ks][nt] = *(const bf16x8*)(WRL + (size_t)(16 * nt + r16) * DM + kbase + 32 * ks); }
    constexpr int NTILE = MTOK / 16;
    LAS float* lg = rs + 16;
    LAS int* lcnt = (LAS int*)(lg + 8 * 16 * 36); LAS int* lbase = lcnt + 32;
    if (tid < NEXP) lcnt[tid] = 0;
    u32x4 xn[4];
    { const int t0 = blk; if (t0 < NTILE) {
#pragma unroll
        for (int ks = 0; ks < 4; ++ks) xn[ks] = *(const u32x4*)(X1 + (size_t)(t0 * 16 + r16) * DM + kbase + 32 * ks); } }
    int ti = 0;
    for (int t = blk; t < NTILE; t += nblk, ++ti) {
        u32x4 xv[4];
#pragma unroll
        for (int ks = 0; ks < 4; ++ks) xv[ks] = xn[ks];
        { const int tn = (t + nblk < NTILE) ? t + nblk : t;
#pragma unroll
          for (int ks = 0; ks < 4; ++ks) xn[ks] = *(const u32x4*)(X1 + (size_t)(tn * 16 + r16) * DM + kbase + 32 * ks); }
        f32x4 acc[3]; acc[0] = (f32x4){0.f, 0.f, 0.f, 0.f}; acc[1] = acc[0]; acc[2] = acc[0];
        float ss = 0.f;
#pragma unroll
        for (int ks = 0; ks < 4; ++ks) { const u32x4 xw = xv[ks];
            const float f0 = __builtin_bit_cast(float, xw.x << 16), f1 = __builtin_bit_cast(float, xw.x & 0xffff0000u), f2 = __builtin_bit_cast(float, xw.y << 16), f3 = __builtin_bit_cast(float, xw.y & 0xffff0000u);
            const float f4 = __builtin_bit_cast(float, xw.z << 16), f5 = __builtin_bit_cast(float, xw.z & 0xffff0000u), f6 = __builtin_bit_cast(float, xw.w << 16), f7 = __builtin_bit_cast(float, xw.w & 0xffff0000u);
            ss += (f0 * f0 + f1 * f1) + (f2 * f2 + f3 * f3) + (f4 * f4 + f5 * f5) + (f6 * f6 + f7 * f7);
            const bf16x8 ah = __builtin_bit_cast(bf16x8, xw);
#pragma unroll
            for (int nt = 0; nt < 3; ++nt) {
                acc[nt] = __builtin_amdgcn_mfma_f32_16x16x32_bf16(ah, bh[ks][nt], acc[nt], 0, 0, 0);
                acc[nt] = __builtin_amdgcn_mfma_f32_16x16x32_bf16(ah, bl[ks][nt], acc[nt], 0, 0, 0); } }
        ss += __shfl_xor(ss, 16); ss += __shfl_xor(ss, 32);
#pragma unroll
        for (int nt = 0; nt < 3; ++nt)
#pragma unroll
            for (int j = 0; j < 4; ++j) part[(wave * 16 + 4 * kg + j) * 52 + 16 * nt + r16] = acc[nt][j];
        if (kg == 0) part[(wave * 16 + r16) * 52 + 48] = ss;
        __syncthreads();
        for (int idx = tid; idx < 16 * 49; idx += NTHREADS) { const int row = idx / 49, o = idx % 49; float s = 0.f;
#pragma unroll
            for (int w = 0; w < 8; ++w) s += part[(w * 16 + row) * 52 + o];
            tot[row * 52 + o] = s; }
        __syncthreads();
        { const float rstd = 1.0f / sqrtf(tot[r16 * 52 + 48] * (1.0f / DM) + EPS);
#pragma unroll
          for (int ks = 0; ks < 4; ++ks) { const f32x4* gp4 = (const f32x4*)(g2 + kbase + 32 * ks); const f32x4 ga = gp4[0], gb = gp4[1]; const u32x4 xw = xv[ks];
              u32x4 w;
              w.x = pk2(__builtin_bit_cast(float, xw.x << 16) * rstd * ga.x, __builtin_bit_cast(float, xw.x & 0xffff0000u) * rstd * ga.y);
              w.y = pk2(__builtin_bit_cast(float, xw.y << 16) * rstd * ga.z, __builtin_bit_cast(float, xw.y & 0xffff0000u) * rstd * ga.w);
              w.z = pk2(__builtin_bit_cast(float, xw.z << 16) * rstd * gb.x, __builtin_bit_cast(float, xw.z & 0xffff0000u) * rstd * gb.y);
              w.w = pk2(__builtin_bit_cast(float, xw.w << 16) * rstd * gb.z, __builtin_bit_cast(float, xw.w & 0xffff0000u) * rstd * gb.w);
              *(u32x4*)(H2 + (size_t)(t * 16 + r16) * DM + kbase + 32 * ks) = w; } }
        for (int idx = tid; idx < 16 * 36; idx += NTHREADS) { const int row = idx / 36, o = idx % 36;
            const float rstd = 1.0f / sqrtf(tot[row * 52 + 48] * (1.0f / DM) + EPS);
            lg[((ti & 7) * 16 + row) * 36 + o] = tot[row * 52 + o] * rstd; }
        const bool lastt = (t + nblk >= NTILE);
        if ((ti & 7) == 7 || lastt) {
            __syncthreads();
            const int nch = (ti & 7) + 1;
            int ea = 0, eb = 0, ra = 0, rb = 0, rowg = 0; float w1 = 0.f, w2 = 0.f;
            const bool act = !DUMMY && tid < nch * 16;
            if (act) {
                const int ci = tid >> 4, row16 = tid & 15;
                const LAS float* tr = lg + (ci * 16 + row16) * 36;
                const float g0 = tr[0], g1 = tr[1], g2l = tr[2], g3 = tr[3];
                int gi = 0; float gm = g0;
                if (g1 > gm) { gm = g1; gi = 1; } if (g2l > gm) { gm = g2l; gi = 2; } if (g3 > gm) { gm = g3; gi = 3; }
                const float gp = 1.0f / (expf(g0 - gm) + expf(g1 - gm) + expf(g2l - gm) + expf(g3 - gm));
                const LAS float* ep = tr + 4 + gi * 8;
                int i1 = 0; float l1 = ep[0];
                for (int j = 1; j < 8; ++j) { const float v = ep[j]; if (v > l1) { l1 = v; i1 = j; } }
                int i2 = -1; float l2 = -3.0e38f;
                for (int j = 0; j < 8; ++j) { const float v = ep[j]; if (j != i1 && v > l2) { l2 = v; i2 = j; } }
                const float e2 = expf(l2 - l1); w1 = gp / (1.0f + e2); w2 = gp * e2 / (1.0f + e2);
                const int tile = t - (nch - 1 - ci) * nblk;
                rowg = tile * 16 + row16; ea = gi * 8 + i1; eb = gi * 8 + i2;
                ra = __hip_atomic_fetch_add((int*)(lcnt + ea), 1, __ATOMIC_RELAXED, __HIP_MEMORY_SCOPE_WORKGROUP); rb = __hip_atomic_fetch_add((int*)(lcnt + eb), 1, __ATOMIC_RELAXED, __HIP_MEMORY_SCOPE_WORKGROUP);
            }
            __syncthreads();
            if (tid < NEXP) { const int n = lcnt[tid]; lbase[tid] = (n > 0) ? atomicAdd(&cnt[tid * 64], n) : 0; lcnt[tid] = 0; }
            __syncthreads();
            if (act) {
                LIST[(size_t)ea * MTOK + lbase[ea] + ra] = rowg * 2 + 0; EW[rowg * 2 + 0] = w1;
                LIST[(size_t)eb * MTOK + lbase[eb] + rb] = rowg * 2 + 1; EW[rowg * 2 + 1] = w2;
            }
            __syncthreads();
        }
    }
}

constexpr int MOE_TAB_OFF = 131072;
constexpr int MOE_MAXT = 320;
__device__ __forceinline__ int moe_build_table(const int* cnt, LAS int* tab) {
    __syncthreads();
    if (threadIdx.x == 0) { int nt = 0, seg = 0;
        for (int e = 0; e < NEXP; ++e) { const int n = cnt[e * 64], mt = (n + 255) >> 8;
            for (int m = 0; m < mt; ++m) { tab[3 * nt] = e | (m << 8); tab[3 * nt + 1] = seg + m * 256; tab[3 * nt + 2] = (n - m * 256) < 256 ? (n - m * 256) : 256; ++nt; }
            seg += mt * 256; }
        tab[3 * MOE_MAXT] = nt; }
    __syncthreads();
    return tab[3 * MOE_MAXT];
}
struct MoeOrder1 {
    const char* H2; const char* W; const int* LIST; LAS const int* tab; int nunits, G, c;
    __device__ __forceinline__ bool next(int i, pg8::Unit& u) const {
        const int L = i * G + c; if (L >= nunits) return false;
        const int t = L >> 1; const int em = tab[3 * t]; u.e = em & 255; u.pm = em >> 8; u.pn = L & 1; u.seg = tab[3 * t + 1]; u.nrows = tab[3 * t + 2];
        u.A = H2; u.B = W + ((size_t)(u.e * 512 + u.pn * 256) * DM) * 2; return true;
    }
    __device__ __forceinline__ unsigned a_row(const pg8::Unit& u, int r, int K_) const { const int tok = (r < u.nrows) ? (LIST[(size_t)u.e * MTOK + u.pm * 256 + r] >> 1) : 0; return (unsigned)(tok * K_) * 2u; }
};
struct EpiMoe1 {
    static constexpr bool PERM = true;
    bf16_t* HID;
    __device__ __forceinline__ void operator()(const f32x4 (&acc)[2][2][4][2], const pg8::Unit& u, int wr, int wc, int fr, int fq) const {
        const int col0 = u.pn * 128 + wc * 32 + 8 * fq;
#pragma unroll
        for (int ai = 0; ai < 2; ++ai)
#pragma unroll
            for (int m = 0; m < 4; ++m) { const int r = ai * 128 + wr * 64 + m * 16 + fr;
                const f32x4 g0 = acc[ai][0][m][0], g1 = acc[ai][0][m][1], u0 = acc[ai][1][m][0], u1 = acc[ai][1][m][1];
                f32x4 h0, h1;
                h0.x = g0.x * sigmoidf_(g0.x) * u0.x; h0.y = g0.y * sigmoidf_(g0.y) * u0.y; h0.z = g0.z * sigmoidf_(g0.z) * u0.z; h0.w = g0.w * sigmoidf_(g0.w) * u0.w;
                h1.x = g1.x * sigmoidf_(g1.x) * u1.x; h1.y = g1.y * sigmoidf_(g1.y) * u1.y; h1.z = g1.z * sigmoidf_(g1.z) * u1.z; h1.w = g1.w * sigmoidf_(g1.w) * u1.w;
                u32x4 w; w.x = pk2(h0.x, h0.y); w.y = pk2(h0.z, h0.w); w.z = pk2(h1.x, h1.y); w.w = pk2(h1.z, h1.w);
                *(u32x4*)(HID + (size_t)(u.seg + r) * DEXP + col0) = w; }
    }
};
struct MoeOrder2 {
    const char* HID; const char* W; LAS const int* tab; int nunits, G, c;
    __device__ __forceinline__ bool next(int i, pg8::Unit& u) const {
        const int L = i * G + c; if (L >= nunits) return false;
        const int t = L >> 2; const int em = tab[3 * t]; u.e = em & 255; u.pm = em >> 8; u.pn = L & 3; u.seg = tab[3 * t + 1]; u.nrows = tab[3 * t + 2];
        u.A = HID + (size_t)u.seg * DEXP * 2; u.B = W + ((size_t)(u.e * DM + u.pn * 256) * DEXP) * 2; return true;
    }
    __device__ __forceinline__ unsigned a_row(const pg8::Unit&, int r, int K_) const { return (unsigned)(r * K_) * 2u; }
};
struct EpiMoe2 {
    static constexpr bool PERM = true;
    bf16_t* Y; const int* LIST;
    __device__ __forceinline__ void operator()(const f32x4 (&acc)[2][2][4][2], const pg8::Unit& u, int wr, int wc, int fr, int fq) const {
        const int col0 = u.pn * 256 + wc * 32 + 8 * fq;
        const int* lp = LIST + (size_t)u.e * MTOK + u.pm * 256;
        int dst[2][4];
#pragma unroll
        for (int ai = 0; ai < 2; ++ai)
#pragma unroll
            for (int m = 0; m < 4; ++m) { const int r = ai * 128 + wr * 64 + m * 16 + fr; dst[ai][m] = (r < u.nrows) ? lp[r] : -1; }
#pragma unroll
        for (int ai = 0; ai < 2; ++ai)
#pragma unroll
            for (int m = 0; m < 4; ++m) {
                if (dst[ai][m] >= 0) {
#pragma unroll
                    for (int bj = 0; bj < 2; ++bj) { const f32x4 v0 = acc[ai][bj][m][0], v1 = acc[ai][bj][m][1];
                        u32x4 w; w.x = pk2(v0.x, v0.y); w.y = pk2(v0.z, v0.w); w.z = pk2(v1.x, v1.y); w.w = pk2(v1.z, v1.w);
                        *(u32x4*)(Y + ((unsigned)dst[ai][m] * (unsigned)DM + (unsigned)(col0 + bj * 128))) = w; } } }
    }
};
__device__ __forceinline__ void phase5(const Args& a, LAS unsigned char* lds, int nblk, int blk) {
    unsigned char* ws = a.ws;
    LAS int* tab = (LAS int*)(lds + MOE_TAB_OFF);
    const int nt = moe_build_table((const int*)(ws + WS_CTL), tab);
    MoeOrder1 S{(const char*)(ws + WS_XN), (const char*)(ws + WS_WGU), (const int*)(ws + WS_LIST), tab, nt * 2, nblk, blk};
    EpiMoe1 E{(bf16_t*)(ws + WS_HID)};
    pg8::gemm_phase(lds, DM, S, E);
}
__device__ __forceinline__ void phase6(const Args& a, LAS unsigned char* lds, int nblk, int blk) {
    unsigned char* ws = a.ws;
    LAS int* tab = (LAS int*)(lds + MOE_TAB_OFF);
    const int nt = moe_build_table((const int*)(ws + WS_CTL), tab);
    MoeOrder2 S{(const char*)(ws + WS_HID), (const char*)(ws + WS_WD), tab, nt * 4, nblk, blk};
    EpiMoe2 E{(bf16_t*)(ws + WS_Y), (const int*)(ws + WS_LIST)};
    pg8::gemm_phase(lds, DEXP, S, E);
}

template <bool DUMMY> __device__ __forceinline__ void phase7(const Args& a, int lane, int gw, int NGW) {
    unsigned char* ws = a.ws;
    float* out = a.out; const bf16_t* X1 = (const bf16_t*)(ws + WS_X1); const bf16_t* Y = (const bf16_t*)(ws + WS_Y); const float* EW = (const float*)(ws + WS_EW); const float* gf = a.in[22];
    f32x4 gv[4];
#pragma unroll
    for (int j = 0; j < 4; ++j) gv[j] = ((const f32x4*)gf)[lane + 64 * j];
    u32x2 xn[4]; u32x2 y0n[4], y1n[4]; float w0n, w1n;
    auto ld = [&](int m) {
        const u32x2* xr = (const u32x2*)(X1 + (size_t)m * DM) + lane;
        const u32x2* y0 = (const u32x2*)(Y + (size_t)(2 * m) * DM) + lane; const u32x2* y1 = (const u32x2*)(Y + (size_t)(2 * m + 1) * DM) + lane;
#pragma unroll
        for (int j = 0; j < 4; ++j) { xn[j] = xr[64 * j]; y0n[j] = y0[64 * j]; y1n[j] = y1[64 * j]; }
        w0n = EW[2 * m]; w1n = EW[2 * m + 1];
    };
    if (gw < MTOK) ld(gw);
    for (int m = gw; m < MTOK; m += NGW) {
        f32x4 xv[4]; u32x2 a0[4], a1[4];
#pragma unroll
        for (int j = 0; j < 4; ++j) { xv[j].x = __builtin_bit_cast(float, xn[j].x << 16); xv[j].y = __builtin_bit_cast(float, xn[j].x & 0xffff0000u); xv[j].z = __builtin_bit_cast(float, xn[j].y << 16); xv[j].w = __builtin_bit_cast(float, xn[j].y & 0xffff0000u); a0[j] = y0n[j]; a1[j] = y1n[j]; }
        const float w0 = w0n, w1 = w1n;
        ld(m + NGW < MTOK ? m + NGW : m);
        f32x4 v[4]; float s = 0.f;
#pragma unroll
        for (int j = 0; j < 4; ++j) { f32x4 t;
            t.x = xv[j].x + w0 * __builtin_bit_cast(float, a0[j].x << 16) + w1 * __builtin_bit_cast(float, a1[j].x << 16);
            t.y = xv[j].y + w0 * __builtin_bit_cast(float, a0[j].x & 0xffff0000u) + w1 * __builtin_bit_cast(float, a1[j].x & 0xffff0000u);
            t.z = xv[j].z + w0 * __builtin_bit_cast(float, a0[j].y << 16) + w1 * __builtin_bit_cast(float, a1[j].y << 16);
            t.w = xv[j].w + w0 * __builtin_bit_cast(float, a0[j].y & 0xffff0000u) + w1 * __builtin_bit_cast(float, a1[j].y & 0xffff0000u);
            v[j] = t; s += (t.x * t.x + t.y * t.y) + (t.z * t.z + t.w * t.w); }
        s = wave_sum(s);
        const float rstd = 1.0f / sqrtf(s * (1.0f / DM) + EPS);
        f32x4* o = (f32x4*)(out + (size_t)m * DM) + lane;
#pragma unroll
        for (int j = 0; j < 4; ++j) { if (!DUMMY || rstd == 123.4567f) o[64 * j] = v[j] * rstd * gv[j]; }
    }
}

#define XB_TMO      128
#define XB_XCNT(j)  (256  + 64 * (j))
#define XB_XSUB(j)  (1280 + 64 * (j))
#define XB_XGEN(j)  (2304 + 64 * (j))
#define XB_TOP      3328
#define XB_TOPGEN   3392
#define XCD_BAR_WORDS 3456
#define XB_SPIN_CAP (1u << 22)
__device__ __forceinline__ unsigned xb_ld(unsigned* p)              { return __hip_atomic_load(p, __ATOMIC_RELAXED, __HIP_MEMORY_SCOPE_AGENT); }
__device__ __forceinline__ unsigned xb_add(unsigned* p, unsigned v) { return __hip_atomic_fetch_add(p, v, __ATOMIC_RELAXED, __HIP_MEMORY_SCOPE_AGENT); }
__device__ __forceinline__ unsigned xb_xcc_id() { return (unsigned)__builtin_amdgcn_s_getreg((3 << 11) | 20) & 0xFu; }
#define XB_SPIN(cond, bar) do { unsigned _sp = 0; while (cond) { __builtin_amdgcn_s_sleep(1); \
    if ((++_sp & 255u) == 0u) { if (xb_ld(&(bar)[XB_TMO])) break; if (_sp > XB_SPIN_CAP) { atomicAdd(&(bar)[XB_TMO], 1u); break; } } } } while (0)
struct XcdBarrier { unsigned* bar; unsigned x; volatile LAS unsigned* st; };
__device__ __forceinline__ XcdBarrier xcd_barrier_post(unsigned* bar, volatile LAS unsigned* st) {
    XcdBarrier b; b.bar = bar; b.x = xb_xcc_id(); b.st = st;
    if (threadIdx.x == 0) (void)xb_add(&bar[XB_XCNT(b.x)], 1u);
    return b;
}
__device__ __forceinline__ void xcd_barrier_complete(unsigned* bar, unsigned x, unsigned& nloc, unsigned& nx) {
    const unsigned G = gridDim.x * gridDim.y * gridDim.z;
    unsigned sum, cnt, mine, sp = 0u;
    for (;;) {
        sum = 0u; cnt = 0u; mine = 0u;
#pragma unroll
        for (unsigned j = 0; j < 16; ++j) { const unsigned c = xb_ld(&bar[XB_XCNT(j)]); sum += c; cnt += (c > 0u) ? 1u : 0u; mine = (j == x) ? c : mine; }
        if (sum == G) break;
        __builtin_amdgcn_s_sleep(1);
        if ((++sp & 255u) == 0u) { if (xb_ld(&bar[XB_TMO])) break; if (sp > XB_SPIN_CAP) { atomicAdd(&bar[XB_TMO], 1u); break; } }
    }
    nloc = mine > 0u ? mine : 1u; nx = cnt > 0u ? cnt : 1u;
}
__device__ __forceinline__ void xcd_barrier(const XcdBarrier& b) {
    asm volatile("s_waitcnt vmcnt(0)" ::: "memory");
    __syncthreads();
    if (threadIdx.x == 0) {
        unsigned* bar = b.bar;
        __builtin_amdgcn_s_waitcnt(0);
        unsigned nloc = b.st[0], nx = b.st[1];
        if (nloc == 0u) { xcd_barrier_complete(bar, b.x, nloc, nx); b.st[0] = nloc; b.st[1] = nx; }
        const unsigned old = xb_add(&bar[XB_XSUB(b.x)], 1u);
        const unsigned gen = old / nloc;
        if (old + 1u == (gen + 1u) * nloc) {
            __builtin_amdgcn_fence(__ATOMIC_RELEASE, "agent");
            asm volatile("s_waitcnt vmcnt(0)" ::: "memory");
            const unsigned og = xb_add(&bar[XB_TOP], 1u);
            const unsigned tg = og / nx;
            if (og + 1u == (tg + 1u) * nx) xb_add(&bar[XB_TOPGEN], 1u);
            else XB_SPIN(xb_ld(&bar[XB_TOPGEN]) == tg, bar);
            __builtin_amdgcn_fence(__ATOMIC_ACQUIRE, "agent");
            xb_add(&bar[XB_XGEN(b.x)], 1u);
            asm volatile("s_waitcnt vmcnt(0)" ::: "memory");
        } else {
            XB_SPIN(xb_ld(&bar[XB_XGEN(b.x)]) == gen, bar);
            __builtin_amdgcn_fence(__ATOMIC_ACQUIRE, "agent");
            asm volatile("s_waitcnt vmcnt(0)" ::: "memory");
        }
    }
    __syncthreads();
}

__global__ void __launch_bounds__(NTHREADS, 2) mega_fwd(Args args) {
    extern __shared__ __attribute__((aligned(16))) unsigned char lds[];
    const int tid = threadIdx.x, lane = tid & 63, wave = __builtin_amdgcn_readfirstlane(tid >> 6);
    const int nblk = gridDim.x, blk = blockIdx.x;
    const int gw = blk * NWAVES + wave, NGW = nblk * NWAVES;
    const int lo = args.ph_lo, hi = args.ph_hi;
#define IN(k) (lo <= (k) && (k) < hi)
#if MK_CG_SYNC
#define SEAM(k) do { if (IN(k) && IN((k) + 1)) { cg::this_grid().sync(); } } while (0)
#else
    volatile LAS unsigned* bst = (volatile LAS unsigned*)((LAS unsigned char*)lds + LDS_BYTES - 64);
    if (tid == 0) { bst[0] = 0u; bst[1] = 0u; }
    __syncthreads();
    const XcdBarrier gbar = xcd_barrier_post((unsigned*)(args.ws + WS_CTL) + 4096, bst);
#define SEAM(k) do { if (IN(k) && IN((k) + 1)) { xcd_barrier(gbar); } } while (0)
#endif
    if (IN(0)) { phase0(args, (LAS unsigned char*)lds, tid, wave, lane, gw, NGW); if (PROBE_DUP == 0) phase0(args, (LAS unsigned char*)lds, tid, wave, lane, gw, NGW); }
    SEAM(0);
    if (IN(1)) { phase1(args, (LAS unsigned char*)lds, nblk, blk, 6, 1024); if (PROBE_DUP == 1) phase1(args, (LAS unsigned char*)lds, nblk, blk, 6, 1024); }
    SEAM(1);
    if (IN(2)) { const int nl = (nblk >= 256) ? 128 : nblk / 2, ng = nblk - nl;
        const bool probe_ = (hi != NPHASES);
        if (blk < ng) { if (!(probe_ && PROBE_P2_MODE == 1)) phase1(args, (LAS unsigned char*)lds, ng, blk, 0, 1536); }
        else { if (!(probe_ && PROBE_P2_MODE == 2)) phase2_lru(args, (LAS unsigned char*)lds, nl, blk - ng); } }
    SEAM(2);
    if (IN(3)) { phase2_attn<0>(args, (char*)lds, nblk, blk); if (PROBE_DUP == 3) phase2_attn<0>(args, (char*)lds, nblk, blk); }
    SEAM(3);
    if (IN(4)) { phase3(args, (LAS unsigned char*)lds, nblk, blk); if (PROBE_DUP == 4) phase3(args, (LAS unsigned char*)lds, nblk, blk); }
    SEAM(4);
    if (IN(5)) { phase4<false>(args, (LAS unsigned char*)lds, nblk, blk); if (PROBE_DUP == 5) phase4<true>(args, (LAS unsigned char*)lds, nblk, blk); }
    SEAM(5);
    if (IN(6)) { phase5(args, (LAS unsigned char*)lds, nblk, blk); if (PROBE_DUP == 6) phase5(args, (LAS unsigned char*)lds, nblk, blk); }
    SEAM(6);
    if (IN(7)) { phase6(args, (LAS unsigned char*)lds, nblk, blk); if (PROBE_DUP == 7) phase6(args, (LAS unsigned char*)lds, nblk, blk); }
    SEAM(7);
    if (IN(8)) { if (PROBE_DUP == 8) phase7<true>(args, lane, gw, NGW); phase7<false>(args, lane, gw, NGW); }
#undef IN
#undef SEAM
}

#if PROBE_ATT_VAR > 0
__global__ void __launch_bounds__(NTHREADS, 2) probe_attn(Args args) {
    extern __shared__ __attribute__((aligned(16))) unsigned char lds[];
    phase2_attn<PROBE_ATT_VAR>(args, (char*)lds, gridDim.x, blockIdx.x);
}
#endif
#if PROBE_VALU > 0
__global__ void __launch_bounds__(NTHREADS, 2) probe_valu(float* out, float seed) {
    float v[16];
#pragma unroll
    for (int i = 0; i < 16; ++i) v[i] = seed + (float)(threadIdx.x + i);
    f32x16 macc0 = f32x16{}, macc1 = f32x16{}; bf16x8 ma, mb;
#pragma unroll
    for (int i = 0; i < 8; ++i) { ma[i] = (short)(0x3F80 + threadIdx.x + i); mb[i] = (short)(0x3F00 + threadIdx.x * 3 + i); }
    for (int it = 0; it < 4096; ++it) {
#pragma unroll
        for (int i = 0; i < 16; ++i) {
#if PROBE_VALU == 1
            v[i] = fmaf(v[i], 1.0001f, 0.5f);
#elif PROBE_VALU == 2
            v[i] = __builtin_amdgcn_exp2f(v[i]);
#elif PROBE_VALU == 3
            v[i] = fmaxf(fmaxf(v[i], v[(i + 1) & 15]), seed);
#endif
        }
#if PROBE_VALU == 4 || PROBE_VALU == 5
        macc0 = __builtin_amdgcn_mfma_f32_32x32x16_bf16(ma, mb, macc0, 0, 0, 0);
#if PROBE_VALU == 4
        v[0] = fmaf(v[0], 1.0001f, 0.5f); v[1] = fmaf(v[1], 1.0001f, 0.5f); v[2] = fmaf(v[2], 1.0001f, 0.5f); v[3] = fmaf(v[3], 1.0001f, 0.5f); v[4] = fmaf(v[4], 1.0001f, 0.5f); v[5] = fmaf(v[5], 1.0001f, 0.5f);
#endif
        macc1 = __builtin_amdgcn_mfma_f32_32x32x16_bf16(ma, mb, macc1, 0, 0, 0);
#if PROBE_VALU == 4
        v[6] = fmaf(v[6], 1.0001f, 0.5f); v[7] = fmaf(v[7], 1.0001f, 0.5f); v[8] = fmaf(v[8], 1.0001f, 0.5f); v[9] = fmaf(v[9], 1.0001f, 0.5f); v[10] = fmaf(v[10], 1.0001f, 0.5f); v[11] = fmaf(v[11], 1.0001f, 0.5f);
#endif
#endif
        asm volatile("" : "+v"(v[0]), "+v"(v[1]), "+v"(v[2]), "+v"(v[3]), "+v"(v[4]), "+v"(v[5]), "+v"(v[6]), "+v"(v[7]));
    }
    float s = 0.f;
#pragma unroll
    for (int i = 0; i < 16; ++i) s += v[i] + macc0[i] + macc1[i];
    if (s == 123.456f) out[threadIdx.x] = s;
}
#endif
extern "C" void kernel_launch(void* const* d_in, const int* in_sizes, int n_in, void* d_out, int out_size, void* d_ws, size_t ws_size, hipStream_t stream) {
    static int grid = 0;
    if (grid == 0) {
        if (n_in != 23 || out_size != MTOK * DM || ws_size < WS_END) { fprintf(stderr, "kernel_launch: unexpected shapes (n_in %d out %d ws %zu)\n", n_in, out_size, ws_size); grid = -1; return; }
        int dev = 0, cus = 0, per_cu = 0;
        hipGetDevice(&dev);
        hipDeviceGetAttribute(&cus, hipDeviceAttributeMultiprocessorCount, dev);
        hipFuncSetAttribute((const void*)mega_fwd, hipFuncAttributeMaxDynamicSharedMemorySize, LDS_BYTES);
        hipOccupancyMaxActiveBlocksPerMultiprocessor(&per_cu, (const void*)mega_fwd, NTHREADS, LDS_BYTES);
        if (per_cu < 1) per_cu = 1;
        if (per_cu > 1) per_cu = 1;
        grid = cus * per_cu;
        (void)hipGetLastError();
    }
    if (grid < 0) return;
    (void)hipMemsetAsync((char*)d_ws + WS_CTL, 0, 65536, stream);
    Args a{};
    for (int i = 0; i < 23; ++i) a.in[i] = (const float*)d_in[i];
    a.out = (float*)d_out; a.ws = (unsigned char*)d_ws;
#if MK_N_LAUNCHES == 1
#if PROBE_VALU > 0
    hipLaunchKernelGGL(probe_valu, dim3(grid), dim3(NTHREADS), 0, stream, (float*)((char*)d_ws + WS_O0), 1.0f);
#endif
#if PROBE_PREFIX > 0
    { a.ph_lo = 0; a.ph_hi = PROBE_PREFIX; void* kargs0[] = {&a};
      (void)hipLaunchCooperativeKernel((const void*)mega_fwd, dim3(grid), dim3(NTHREADS), kargs0, LDS_BYTES, stream);
      (void)hipMemsetAsync((char*)d_ws + WS_CTL, 0, 65536, stream); }
#if PROBE_ATT_VAR > 0
    { (void)hipFuncSetAttribute((const void*)probe_attn, hipFuncAttributeMaxDynamicSharedMemorySize, LDS_BYTES); hipLaunchKernelGGL(probe_attn, dim3(grid), dim3(PROBE_ATT_THREADS), LDS_BYTES, stream, a); }
#endif
#endif
    a.ph_lo = 0; a.ph_hi = NPHASES;
    void* kargs[] = {&a};
    hipError_t e = hipLaunchCooperativeKernel((const void*)mega_fwd, dim3(grid), dim3(NTHREADS), kargs, LDS_BYTES, stream);
    if (e != hipSuccess) fprintf(stderr, "cooperative launch failed: %s (grid %d)\n", hipGetErrorString(e), grid);
#else
    for (int p = 0; p < NPHASES; ++p) {
        a.ph_lo = p; a.ph_hi = p + 1;
        hipLaunchKernelGGL(mega_fwd, dim3(grid), dim3(NTHREADS), LDS_BYTES, stream, a);
    }
#endif
}
```

```cpp
#include <hip/hip_runtime.h>
#include <hip/hip_cooperative_groups.h>
#include <hip/hip_bf16.h>
#include <cstdint>
#include <cstdio>
namespace cg = cooperative_groups;

#ifndef PROBE_DUP
#define PROBE_DUP -1
#endif
#ifndef PROBE_PREFIX
#define PROBE_PREFIX 0
#endif
#ifndef PROBE_P2_MODE
#define PROBE_P2_MODE 0
#endif
#ifndef PROBE_LRU_ABL
#define PROBE_LRU_ABL 0
#endif
#ifndef PROBE_VALU
#define PROBE_VALU 0
#endif
#ifndef PROBE_ATT_THREADS
#define PROBE_ATT_THREADS 512
#endif
#ifndef PROBE_ATT_VAR
#define PROBE_ATT_VAR 0
#endif
#ifndef MK_CG_SYNC
#define MK_CG_SYNC 0
#endif
#ifndef MK_N_LAUNCHES
#define MK_N_LAUNCHES 1
#endif

#define LAS __attribute__((address_space(3)))
typedef unsigned short bf16_t;
typedef __hip_bfloat16 bf16;
typedef short bf16x8 __attribute__((ext_vector_type(8)));
typedef short s16x4 __attribute__((ext_vector_type(4)));
typedef float f32x4 __attribute__((ext_vector_type(4)));
typedef float f32x16 __attribute__((ext_vector_type(16)));
typedef unsigned u32x4 __attribute__((ext_vector_type(4)));
typedef unsigned u32x2 __attribute__((ext_vector_type(2)));
typedef float f32x2 __attribute__((ext_vector_type(2)));

constexpr int NBATCH = 8, SEQ = 4096, DM = 1024, MTOK = NBATCH * SEQ;
constexpr int NIN = 2560;
constexpr int NEXP = 32, DEXP = 256;
constexpr float EPS = 1e-6f;
constexpr float QSCALE = 0.125f * 1.4426950408889634f;
constexpr int NWAVES = 8, NTHREADS = 512;
constexpr int NPHASES = 9;

constexpr size_t MiB = 1u << 20;
constexpr size_t WS_CTL = 0;
constexpr size_t WS_RT = 1 * MiB;
constexpr size_t WS_WRH = 1 * MiB + 512 * 1024;
constexpr size_t WS_WRL = 1 * MiB + 768 * 1024;
constexpr size_t WS_WIN = 2 * MiB;
constexpr size_t WS_WOUT = 7 * MiB;
constexpr size_t WS_WGU = 9 * MiB;
constexpr size_t WS_WD = 41 * MiB;
constexpr size_t WS_EW = 58 * MiB;
constexpr size_t WS_LIST = 59 * MiB;
constexpr size_t WS_XN = 64 * MiB;
constexpr size_t WS_Q = 128 * MiB, WS_K = 160 * MiB, WS_V = 192 * MiB, WS_XR = 224 * MiB, WS_GG = 256 * MiB;
constexpr size_t WS_X1 = 128 * MiB;
constexpr size_t WS_Y = 352 * MiB;
constexpr size_t WS_O0 = 288 * MiB;
constexpr size_t WS_HID = 288 * MiB;
constexpr size_t WS_HF = 352 * MiB;
constexpr size_t WS_MIX = 416 * MiB;
constexpr size_t WS_END = 480 * MiB;

constexpr int LDS_BYTES = 136 * 1024;

struct Args { const float* in[23]; float* out; unsigned char* ws; int ph_lo, ph_hi; };

#define LDS_WAIT() asm volatile("s_waitcnt lgkmcnt(0)" ::: "memory")
__device__ __forceinline__ unsigned f2bf(float f) { unsigned u = __builtin_bit_cast(unsigned, f); return (u + 0x7fffu + ((u >> 16) & 1u)) >> 16; }
__device__ __forceinline__ unsigned pk2(float lo, float hi) { unsigned r; asm("v_cvt_pk_bf16_f32 %0, %1, %2" : "=v"(r) : "v"(lo), "v"(hi)); return r; }
__device__ __forceinline__ float bf2f(bf16_t b) { return __builtin_bit_cast(float, (unsigned)b << 16); }
__device__ __forceinline__ float wave_sum(float v) {
#pragma unroll
    for (int o = 1; o < 64; o <<= 1) v += __shfl_xor(v, o);
    return v;
}
__device__ __forceinline__ float gelu_tanh(float x) {
    const float y = 0.7978845608028654f * (x + 0.044715f * x * x * x);
    const float t = 1.0f - 2.0f * __builtin_amdgcn_rcpf(1.0f + __builtin_amdgcn_exp2f(2.885390081777927f * y));
    return 0.5f * x * (1.0f + t);
}
__device__ __forceinline__ float sigmoidf_(float x) { return __builtin_amdgcn_rcpf(1.0f + __builtin_amdgcn_exp2f(-1.4426950408889634f * x)); }

__device__ __forceinline__ void tr_item(const float* W, int N, int k0, int n0, bf16_t* WT, int ldt, int dst_row0, LAS float* scr, int lane) {
#pragma unroll 8
    for (int i = 0; i < 32; ++i) { const int kk = 2 * i + (lane >> 5); scr[kk * 33 + (lane & 31)] = W[(size_t)(k0 + kk) * N + n0 + (lane & 31)]; }
    LDS_WAIT(); asm volatile("" ::: "memory");
    const int c = lane & 7;
#pragma unroll
    for (int j = 0; j < 4; ++j) { const int n = (lane >> 3) + 8 * j; const LAS float* s = scr + (8 * c) * 33 + n;
        u32x4 o; o.x = pk2(s[0 * 33], s[1 * 33]); o.y = pk2(s[2 * 33], s[3 * 33]); o.z = pk2(s[4 * 33], s[5 * 33]); o.w = pk2(s[6 * 33], s[7 * 33]);
        *(u32x4*)(WT + (size_t)(dst_row0 + n) * ldt + k0 + 8 * c) = o; }
    LDS_WAIT(); asm volatile("" ::: "memory");
}
__device__ __forceinline__ int gu_row(int c, int is_up) { return 256 * (c >> 7) + 128 * is_up + (c & 127); }

__device__ __forceinline__ void rms_row_bf16(const float* xrow, const float* g, bf16_t* orow, int lane) {
    const f32x4* xr = (const f32x4*)xrow + lane; const f32x4* gr = (const f32x4*)g + lane;
    f32x4 v[4]; float s = 0.f;
#pragma unroll
    for (int j = 0; j < 4; ++j) { v[j] = xr[64 * j]; s += (v[j].x * v[j].x + v[j].y * v[j].y) + (v[j].z * v[j].z + v[j].w * v[j].w); }
    s = wave_sum(s);
    const float rstd = 1.0f / sqrtf(s * (1.0f / DM) + EPS);
    u32x2* o8 = (u32x2*)orow + lane;
#pragma unroll
    for (int j = 0; j < 4; ++j) { const f32x4 gv = gr[64 * j]; u32x2 w; w.x = pk2(v[j].x * rstd * gv.x, v[j].y * rstd * gv.y); w.y = pk2(v[j].z * rstd * gv.z, v[j].w * rstd * gv.w); o8[64 * j] = w; }
}

__device__ __forceinline__ void phase0(const Args& a, LAS unsigned char* lds, int tid, int wave, int lane, int gw, int NGW) {
    unsigned char* ws = a.ws;
    LAS float* scr = (LAS float*)(lds + wave * 8704);
    bf16_t* WinT = (bf16_t*)(ws + WS_WIN); bf16_t* WoutT = (bf16_t*)(ws + WS_WOUT); bf16_t* WguT = (bf16_t*)(ws + WS_WGU); bf16_t* WdT = (bf16_t*)(ws + WS_WD);
    constexpr int I_IN = 16 * 80, I_OUT = 16 * 32, I_G = 32 * 128, I_U = 32 * 128, I_D = 32 * 128, NITEMS = I_IN + I_OUT + I_G + I_U + I_D;
    for (int it = gw; it < NITEMS; it += NGW) {
        int r = it;
        if (r < I_IN) { const int kb = r / 80, nb = r % 80; tr_item(a.in[2], NIN, 64 * kb, 32 * nb, WinT, DM, 32 * nb, scr, lane); continue; } r -= I_IN;
        if (r < I_OUT) { const int kb = r / 32, nb = r % 32; tr_item(a.in[15], DM, 64 * kb, 32 * nb, WoutT, DM, 32 * nb, scr, lane); continue; } r -= I_OUT;
        if (r < I_G) { const int e = r / 128, rr = r % 128, kb = rr / 8, nb = rr % 8; tr_item(a.in[19] + (size_t)e * DM * DEXP, DEXP, 64 * kb, 32 * nb, WguT + (size_t)e * 512 * DM, DM, gu_row(32 * nb, 0), scr, lane); continue; } r -= I_G;
        if (r < I_U) { const int e = r / 128, rr = r % 128, kb = rr / 8, nb = rr % 8; tr_item(a.in[20] + (size_t)e * DM * DEXP, DEXP, 64 * kb, 32 * nb, WguT + (size_t)e * 512 * DM, DM, gu_row(32 * nb, 1), scr, lane); continue; } r -= I_U;
        { const int e = r / 128, rr = r % 128, kb = rr / 32, nb = rr % 32; tr_item(a.in[21] + (size_t)e * DEXP * DM, DM, 64 * kb, 32 * nb, WdT + (size_t)e * DM * DEXP, DEXP, 32 * nb, scr, lane); }
    }
    { bf16_t* WRH = (bf16_t*)(ws + WS_WRH); bf16_t* WRL = (bf16_t*)(ws + WS_WRL); const int gt = gw * 64 + lane, NGT = NGW * 64;
      for (int idx = gt; idx < 48 * DM; idx += NGT) { const int j = idx / DM, k = idx % DM;
          const float w = (j < 4) ? a.in[17][k * 4 + j] : (j < 36) ? a.in[18][k * 32 + (j - 4)] : 0.f; const float wg = w * a.in[16][k];
          const unsigned hi = f2bf(wg); const float hif = __builtin_bit_cast(float, hi << 16);
          WRH[idx] = (bf16_t)hi; WRL[idx] = (bf16_t)f2bf(wg - hif); }
      if (gt < 2048) ((int*)(ws + WS_CTL))[gt] = 0;
      float2* RT = (float2*)(ws + WS_RT);
      for (int idx = gt; idx < SEQ * 8; idx += NGT) { const int pos = idx >> 3, i = idx & 7;
          const float invf = __builtin_amdgcn_exp2f(-(float)i * (18.931568569324174f / 8.0f));
          const float ang = (float)pos * invf;
          const double rev = (double)ang * 0.15915494309189535; const double fr = rev - __builtin_rint(rev);
          const float frf = (float)fr;
          RT[idx] = make_float2(__builtin_amdgcn_cosf(frf), __builtin_amdgcn_sinf(frf)); }
    }
    { bf16_t* XN = (bf16_t*)(ws + WS_XN); const float* x = a.in[0];
      f32x4 gv[4];
#pragma unroll
      for (int j = 0; j < 4; ++j) gv[j] = ((const f32x4*)a.in[1])[lane + 64 * j];
      f32x4 xn[4];
      if (gw < MTOK) {
#pragma unroll
          for (int j = 0; j < 4; ++j) xn[j] = ((const f32x4*)(x + (size_t)gw * DM))[lane + 64 * j]; }
      for (int m = gw; m < MTOK; m += NGW) {
          f32x4 v[4]; float s = 0.f;
#pragma unroll
          for (int j = 0; j < 4; ++j) { v[j] = xn[j]; s += (v[j].x * v[j].x + v[j].y * v[j].y) + (v[j].z * v[j].z + v[j].w * v[j].w); }
          { const int mn = (m + NGW < MTOK) ? m + NGW : m;
#pragma unroll
            for (int j = 0; j < 4; ++j) xn[j] = ((const f32x4*)(x + (size_t)mn * DM))[lane + 64 * j]; }
          s = wave_sum(s);
          const float rstd = 1.0f / sqrtf(s * (1.0f / DM) + EPS);
          u32x2* o8 = (u32x2*)(XN + (size_t)m * DM) + lane;
#pragma unroll
          for (int j = 0; j < 4; ++j) { u32x2 w; w.x = pk2(v[j].x * rstd * gv[j].x, v[j].y * rstd * gv[j].y); w.y = pk2(v[j].z * rstd * gv[j].z, v[j].w * rstd * gv[j].w); o8[64 * j] = w; } } }
}

template <class ARow>
__device__ __forceinline__ void wave_gemm_64x64(f32x4 (&acc)[4][4], const ARow& arow, const bf16_t* __restrict__ Bt, int ldb, int K, int m0, int n0, int lane) {
    const int fr = lane & 15, fq = lane >> 4;
#pragma unroll
    for (int mi = 0; mi < 4; ++mi)
#pragma unroll
        for (int ni = 0; ni < 4; ++ni) acc[mi][ni] = (f32x4){0.f, 0.f, 0.f, 0.f};
    const bf16_t* ap[4];
#pragma unroll
    for (int mi = 0; mi < 4; ++mi) ap[mi] = arow(m0 + 16 * mi + fr) + 8 * fq;
    const bf16_t* bp = Bt + (size_t)(n0 + fr) * ldb + 8 * fq;
    for (int k0 = 0; k0 < K; k0 += 32) {
        bf16x8 av[4], bv[4];
#pragma unroll
        for (int mi = 0; mi < 4; ++mi) av[mi] = *(const bf16x8*)(ap[mi] + k0);
#pragma unroll
        for (int ni = 0; ni < 4; ++ni) bv[ni] = *(const bf16x8*)(bp + (size_t)(16 * ni) * ldb + k0);
#pragma unroll
        for (int mi = 0; mi < 4; ++mi)
#pragma unroll
            for (int ni = 0; ni < 4; ++ni) acc[mi][ni] = __builtin_amdgcn_mfma_f32_16x16x32_bf16(bv[ni], av[mi], acc[mi][ni], 0, 0, 0);
    }
}
struct RowsContig { const bf16_t* base; int ld; __device__ __forceinline__ const bf16_t* operator()(int r) const { return base + (size_t)r * ld; } };

__device__ __forceinline__ void store_bf16x4(bf16_t* p, f32x4 v) { u32x2 w; w.x = pk2(v.x, v.y); w.y = pk2(v.z, v.w); *(u32x2*)p = w; }


namespace pg8 {
constexpr int BM = 256, BK = 64, HALF = 128, HTB = HALF * BK * 2, STAGE_BYTES = 8 * HTB, NXCD = 8, WGM = 8;
__host__ __device__ __forceinline__ int lds_byte(int r, int c) { const int st = (r >> 4) * 2 + (c >> 5), rr = r & 15, cc = c & 31, ob = rr * 64 + cc * 2; return st * 1024 + (ob ^ (((ob >> 9) & 1) << 5)); }
__host__ __device__ __forceinline__ void stage_rc(int b, int& R, int& C) { const int st = b / 1024, sb = b % 1024, swz = sb ^ (((sb >> 9) & 1) << 5); R = (st >> 1) * 16 + swz / 64; C = (st & 1) * 32 + (swz % 64) / 2; }
__host__ __device__ __forceinline__ int perm32(int rho) { const int n = rho >> 4, i = rho & 15; return 8 * (i >> 2) + 4 * n + (i & 3); }

struct Unit { const char* A; const char* B; int pm, pn, e, nrows, seg; };

template <class Epi, class Sched>
__device__ __forceinline__ void gemm_phase(LAS unsigned char* lds, const int K, const Sched& S, const Epi& E) {
    const int tid = threadIdx.x, wid = __builtin_amdgcn_readfirstlane(tid >> 6), lane = tid & 63, wr = wid >> 2, wc = wid & 3, fr = lane & 15, fq = lane >> 4;
    const int nt = K / BK;
    int Rl[2], Cl[2]; unsigned voffB[2];
#pragma unroll
    for (int i = 0; i < 2; ++i) { int R, C; stage_rc(tid * 16 + i * 8192, R, C); const int Rb = Epi::PERM ? ((R & ~31) + perm32(R & 31)) : R;
        Rl[i] = R; Cl[i] = C; voffB[i] = (unsigned)(Rb * K + C) * 2u; }
    const size_t kstep = (size_t)(BK * 2);
    const size_t hstep = (size_t)HALF * K * 2;
    const unsigned ldsw = (unsigned)wid * 1024u;
    const int aoff = lds_byte(wr * 64 + fr, fq * 8), boff = lds_byte(wc * 32 + fr, fq * 8);
#define PG8_SA(b, h) (((b) * 2 + (h)) * HTB)
#define PG8_SB(b, h) ((4 + (b) * 2 + (h)) * HTB)
#define PG8_STAGE(bufoff, gbase, voff) do { _Pragma("unroll") for (int _i = 0; _i < 2; ++_i) \
        __builtin_amdgcn_global_load_lds((const unsigned*)((const char*)(gbase) + (voff)[_i]), (LAS unsigned*)(lds + (bufoff) + ldsw + _i * 8192), 16, 0, 0); } while (0)
#define PG8_LDA(dst, b, h) do { _Pragma("unroll") for (int m = 0; m < 4; ++m) _Pragma("unroll") for (int k = 0; k < 2; ++k) dst[m][k] = *(const LAS bf16x8*)(lds + PG8_SA(b, h) + aoff + m * 2048 + k * 1024); } while (0)
#define PG8_LDB(dst, b, h) do { _Pragma("unroll") for (int n = 0; n < 2; ++n) _Pragma("unroll") for (int k = 0; k < 2; ++k) dst[n][k] = *(const LAS bf16x8*)(lds + PG8_SB(b, h) + boff + n * 2048 + k * 1024); } while (0)
#define PG8_MMA(ai, bj, At, Bt) do { __builtin_amdgcn_s_setprio(1); _Pragma("unroll") for (int m = 0; m < 4; ++m) _Pragma("unroll") for (int n = 0; n < 2; ++n) _Pragma("unroll") for (int k = 0; k < 2; ++k) \
        acc[ai][bj][m][n] = __builtin_amdgcn_mfma_f32_16x16x32_bf16(Bt[n][k], At[m][k], acc[ai][bj][m][n], 0, 0, 0); __builtin_amdgcn_s_setprio(0); } while (0)
#define PG8_WAIT_V(n) asm volatile("s_waitcnt vmcnt(" #n ")" ::: "memory")
#define PG8_WAIT_L(n) asm volatile("s_waitcnt lgkmcnt(" #n ")" ::: "memory")
#define PG8_BAR __builtin_amdgcn_s_barrier()
#define PG8_SCHED __builtin_amdgcn_sched_barrier(0)
    Unit cur, nxt; int ui = 0;
    if (!S.next(0, cur)) return;
    f32x4 acc[2][2][4][2];
#pragma unroll
    for (int a = 0; a < 2; ++a)
#pragma unroll
        for (int b = 0; b < 2; ++b)
#pragma unroll
            for (int m = 0; m < 4; ++m)
#pragma unroll
                for (int n = 0; n < 2; ++n) acc[a][b][m][n] = (f32x4){0.f, 0.f, 0.f, 0.f};
    bf16x8 At[4][2], B0[2][2], B1[2][2];
    const char* cA = cur.A; const char* cB = cur.B;
    unsigned vA0[2], vA1[2], nA0[2], nA1[2];
#pragma unroll
    for (int i = 0; i < 2; ++i) { vA0[i] = S.a_row(cur, Rl[i], K) + (unsigned)Cl[i] * 2u; vA1[i] = S.a_row(cur, HALF + Rl[i], K) + (unsigned)Cl[i] * 2u; nA0[i] = vA0[i]; nA1[i] = vA1[i]; }
    PG8_STAGE(PG8_SB(0, 0), cB, voffB); PG8_STAGE(PG8_SB(0, 1), cB + hstep, voffB); PG8_STAGE(PG8_SA(0, 0), cA, vA0); PG8_STAGE(PG8_SA(0, 1), cA, vA1);
    if (wr == 1) PG8_BAR;
    PG8_WAIT_V(2); PG8_BAR;
    PG8_STAGE(PG8_SB(1, 0), cB + kstep, voffB); PG8_STAGE(PG8_SA(1, 0), cA + kstep, vA0); PG8_STAGE(PG8_SB(1, 1), cB + hstep + kstep, voffB);
    PG8_WAIT_V(6); PG8_BAR;
    for (;;) {
        const bool has_next = S.next(ui + 1, nxt);
        const char* nA = has_next ? nxt.A : cA; const char* nB = has_next ? nxt.B : cB;
        if (has_next) {
#pragma unroll
            for (int i = 0; i < 2; ++i) { nA0[i] = S.a_row(nxt, Rl[i], K) + (unsigned)Cl[i] * 2u; nA1[i] = S.a_row(nxt, HALF + Rl[i], K) + (unsigned)Cl[i] * 2u; }
        }
#pragma nounroll
        for (int t = 0; t < nt; t += 2) {
            const bool last = (t == nt - 2);
            const char* a1 = cA + (size_t)(t + 1) * kstep;
            const char* a2 = last ? nA : cA + (size_t)(t + 2) * kstep; const char* b2 = last ? nB : cB + (size_t)(t + 2) * kstep;
            const char* a3 = a2 + kstep; const char* b3 = b2 + kstep;
            unsigned w0[2], w1[2];
#pragma unroll
            for (int i = 0; i < 2; ++i) { w0[i] = last ? nA0[i] : vA0[i]; w1[i] = last ? nA1[i] : vA1[i]; }
            PG8_LDB(B0, 0, 0); PG8_LDB(B1, 0, 1); PG8_SCHED; PG8_LDA(At, 0, 0); PG8_STAGE(PG8_SA(1, 1), a1, vA1);
            PG8_WAIT_V(8); PG8_WAIT_L(0); PG8_BAR; PG8_MMA(0, 0, At, B0); PG8_MMA(0, 1, At, B1); PG8_BAR; PG8_SCHED;
            PG8_LDA(At, 0, 1); PG8_STAGE(PG8_SB(0, 0), b2, voffB); PG8_STAGE(PG8_SB(0, 1), b2 + hstep, voffB); PG8_STAGE(PG8_SA(0, 0), a2, w0);
            PG8_WAIT_V(8); PG8_WAIT_L(0); PG8_BAR; PG8_MMA(1, 0, At, B0); PG8_MMA(1, 1, At, B1); PG8_BAR; PG8_SCHED;
            PG8_LDB(B0, 1, 0); PG8_LDB(B1, 1, 1); PG8_SCHED; PG8_LDA(At, 1, 0); PG8_STAGE(PG8_SA(0, 1), a2, w1);
            PG8_WAIT_V(8); PG8_WAIT_L(0); PG8_BAR; PG8_MMA(0, 0, At, B0); PG8_MMA(0, 1, At, B1); PG8_BAR; PG8_SCHED;
            PG8_LDA(At, 1, 1); PG8_STAGE(PG8_SB(1, 0), b3, voffB); PG8_STAGE(PG8_SB(1, 1), b3 + hstep, voffB); PG8_STAGE(PG8_SA(1, 0), a3, w0);
            PG8_WAIT_V(8); PG8_WAIT_L(0); PG8_BAR; PG8_MMA(1, 0, At, B0); PG8_MMA(1, 1, At, B1); PG8_BAR; PG8_SCHED;
        }
        if (wr == 0) PG8_BAR;
        E(acc, cur, wr, wc, fr, fq);
        if (!has_next) break;
#pragma unroll
        for (int a = 0; a < 2; ++a)
#pragma unroll
            for (int b = 0; b < 2; ++b)
#pragma unroll
                for (int m = 0; m < 4; ++m)
#pragma unroll
                    for (int n = 0; n < 2; ++n) acc[a][b][m][n] = (f32x4){0.f, 0.f, 0.f, 0.f};
        cur = nxt; cA = nA; cB = nB; ++ui;
#pragma unroll
        for (int i = 0; i < 2; ++i) { vA0[i] = nA0[i]; vA1[i] = nA1[i]; }
        if (wr == 1) PG8_BAR;
    }
    PG8_WAIT_V(0);
    PG8_BAR;
#undef PG8_SA
#undef PG8_SB
#undef PG8_STAGE
#undef PG8_LDA
#undef PG8_LDB
#undef PG8_MMA
#undef PG8_WAIT_V
#undef PG8_WAIT_L
#undef PG8_BAR
#undef PG8_SCHED
}

struct DenseOrder {
    const char* A; const char* Bt; int K, nM, nN, nwg, G, c, pn0;
    __device__ void init(const void* A_, const void* Bt_, int M, int N, int K_, int G_, int c_, int pn0_ = 0) { A = (const char*)A_; Bt = (const char*)Bt_; K = K_; nM = M / BM; nN = N / BM; nwg = nM * nN; G = G_; c = c_; pn0 = pn0_; }
    __device__ __forceinline__ bool next(int i, Unit& u) const {
        const long L = (long)i * G + c; if (L >= nwg) return false;
        int wgid = (int)L; { const int q = nwg / NXCD, r = nwg % NXCD, xcd = wgid % NXCD, off = wgid / NXCD; wgid = (xcd < r ? xcd * (q + 1) : r * (q + 1) + (xcd - r) * q) + off; }
        const int nig = WGM * nN, gid = wgid / nig, fm = gid * WGM, gsz = (nM - fm) < WGM ? (nM - fm) : WGM;
        u.pm = fm + ((wgid % nig) % gsz); u.pn = pn0 + (wgid % nig) / gsz; u.e = 0; u.nrows = BM; u.seg = 0;
        u.A = A + (size_t)u.pm * BM * K * 2; u.B = Bt + (size_t)u.pn * BM * K * 2; return true;
    }
    __device__ __forceinline__ unsigned a_row(const Unit&, int r, int K_) const { return (unsigned)(r * K_) * 2u; }
};
}

struct EpiInProj {
    static constexpr bool PERM = true;
    unsigned char* ws; const float2* RT;
    __device__ __forceinline__ void operator()(const f32x4 (&acc)[2][2][4][2], const pg8::Unit& u, int wr, int wc, int fr, int fq) const {
        const int seg = u.pn >> 1;
        bf16_t* dst = (bf16_t*)(ws + (seg == 0 ? WS_Q : seg == 1 ? WS_K : seg == 2 ? WS_V : seg == 3 ? WS_XR : WS_GG));
        const int row0 = u.pm * 256 + wr * 64 + fr, col0 = (u.pn & 1) * 256 + wc * 32 + 8 * fq;
        const bool rope = (seg <= 1) && ((wc & 1) == 0);
#pragma unroll
        for (int ai = 0; ai < 2; ++ai)
#pragma unroll
            for (int m = 0; m < 4; ++m) { const int row = row0 + ai * 128 + m * 16, pos = row & (SEQ - 1);
#pragma unroll
                for (int bj = 0; bj < 2; ++bj) { f32x4 v0 = acc[ai][bj][m][0], v1 = acc[ai][bj][m][1];
                    if (rope) {
                        f32x4 p0, p1;
                        p0.x = __shfl_xor(v0.x, 16); p0.y = __shfl_xor(v0.y, 16); p0.z = __shfl_xor(v0.z, 16); p0.w = __shfl_xor(v0.w, 16);
                        p1.x = __shfl_xor(v1.x, 16); p1.y = __shfl_xor(v1.y, 16); p1.z = __shfl_xor(v1.z, 16); p1.w = __shfl_xor(v1.w, 16);
                        if (fq < 2) { const float2* cs = RT + pos * 8; const float sg = (fq == 0) ? -1.f : 1.f;
                            const float2 c0 = cs[0], c1 = cs[1], c2 = cs[2], c3 = cs[3], c4 = cs[4], c5 = cs[5], c6 = cs[6], c7 = cs[7];
                            v0.x = v0.x * c0.x + sg * p0.x * c0.y; v0.y = v0.y * c1.x + sg * p0.y * c1.y; v0.z = v0.z * c2.x + sg * p0.z * c2.y; v0.w = v0.w * c3.x + sg * p0.w * c3.y;
                            v1.x = v1.x * c4.x + sg * p1.x * c4.y; v1.y = v1.y * c5.x + sg * p1.y * c5.y; v1.z = v1.z * c6.x + sg * p1.z * c6.y; v1.w = v1.w * c7.x + sg * p1.w * c7.y; }
                    }
                    if (seg == 0) { v0 = v0 * QSCALE; v1 = v1 * QSCALE; }
                    if (seg == 4) { v0.x = gelu_tanh(v0.x); v0.y = gelu_tanh(v0.y); v0.z = gelu_tanh(v0.z); v0.w = gelu_tanh(v0.w); v1.x = gelu_tanh(v1.x); v1.y = gelu_tanh(v1.y); v1.z = gelu_tanh(v1.z); v1.w = gelu_tanh(v1.w); }
                    u32x4 w; w.x = pk2(v0.x, v0.y); w.y = pk2(v0.z, v0.w); w.z = pk2(v1.x, v1.y); w.w = pk2(v1.z, v1.w);
                    *(u32x4*)(dst + (size_t)row * 512 + col0 + bj * 128) = w; } }
    }
};
__device__ __forceinline__ void phase1(const Args& a, LAS unsigned char* lds, int G, int c, int pn0, int ncols) {
    unsigned char* ws = a.ws;
    pg8::DenseOrder S; S.init(ws + WS_XN, ws + WS_WIN, MTOK, ncols, DM, G, c, pn0);
    EpiInProj E{ws, (const float2*)(ws + WS_RT)};
    pg8::gemm_phase(lds, DM, S, E);
}

namespace att {
constexpr int DQK = 64, DV = 128, QBLK = 32, KVBLK = 64, LD = 512;
constexpr float SCALE = 0.125f, THR = 8.f;
constexpr int SHM_V = KVBLK * DV * 2, SHM_K = KVBLK * DQK * 2, SHM_ATTN = 2 * SHM_V + 2 * SHM_K + NWAVES * 64 * 4;
#define KSWZ(row, colB) ((row) * 128 + ((colB) ^ ((((row) >> 1) & 7) << 4)))
#define SBAR() __builtin_amdgcn_sched_barrier(0)
__device__ __forceinline__ int crow(int r, int hi) { return (r & 3) + 8 * (r >> 2) + 4 * hi; }
__device__ __forceinline__ float max3f(float a, float b, float c) { float r; asm("v_max3_f32 %0, %1, %2, %3" : "=v"(r) : "v"(a), "v"(b), "v"(c)); return r; }
__device__ __forceinline__ unsigned cvtpk(float lo, float hi) { unsigned r; asm volatile("v_cvt_pk_bf16_f32 %0, %1, %2" : "=v"(r) : "v"(lo), "v"(hi)); return r; }

constexpr float THRL = 11.0f;
__device__ __forceinline__ float rowmax_a(const f32x16& p0) {
    float pmax = p0[0];
#pragma unroll
    for (int r = 1; r < 16; ++r) pmax = fmaxf(pmax, p0[r]);
    return pmax;
}
__device__ __forceinline__ float rowmax_b(const f32x16& p1, float pmax) {
#pragma unroll
    for (int r = 0; r < 16; ++r) pmax = fmaxf(pmax, p1[r]);
    auto rr = __builtin_amdgcn_permlane32_swap(__float_as_uint(pmax), __float_as_uint(pmax), false, false);
    return fmaxf(__uint_as_float(rr[0]), __uint_as_float(rr[1]));
}
template <bool FIRST> __device__ __forceinline__ void decide(float rm, f32x16& p0, f32x16& p1, float& mhat, f32x16& negm, float& alpha) {
    alpha = 1.f;
    if (FIRST || __builtin_expect(__any(rm > THRL), 0)) {
        const float dl = FIRST ? rm : fmaxf(rm, 0.f);
        mhat += dl;
#pragma unroll
        for (int r = 0; r < 16; ++r) { p0[r] -= dl; p1[r] -= dl; }
#pragma unroll
        for (int r = 0; r < 16; ++r) negm[r] = -mhat;
        alpha = __builtin_amdgcn_exp2f(-dl);
    }
}
template <int VAR> __device__ __forceinline__ void exp16(f32x16& p) {
#pragma unroll
    for (int r = 0; r < 16; ++r) p[r] = (VAR & 2) ? p[r] * 0.001f : __builtin_amdgcn_exp2f(p[r]);
}
template <int VAR> __device__ __forceinline__ float expsum16(f32x16& p) {
    exp16<VAR>(p);
    float ps = 0;
#pragma unroll
    for (int r = 0; r < 16; ++r) ps += p[r];
    return ps;
}
__device__ __forceinline__ float halves_sum(float ps) {
    auto rr = __builtin_amdgcn_permlane32_swap(__float_as_uint(ps), __float_as_uint(ps), false, false);
    return __uint_as_float(rr[0]) + __uint_as_float(rr[1]);
}
__device__ __forceinline__ void pack4(const f32x16& p0, const f32x16& p1, bf16x8& pa0, bf16x8& pa1, bf16x8& pa2, bf16x8& pa3) {
#define PK4(P, BASE, OUT) do { u32x4 w = {cvtpk(P[BASE + 0], P[BASE + 1]), cvtpk(P[BASE + 2], P[BASE + 3]), cvtpk(P[BASE + 4], P[BASE + 5]), cvtpk(P[BASE + 6], P[BASE + 7])}; OUT = *reinterpret_cast<bf16x8*>(&w); } while (0)
    PK4(p0, 0, pa0); PK4(p0, 8, pa1); PK4(p1, 0, pa2); PK4(p1, 8, pa3);
#undef PK4
}
typedef short v4i16_t __attribute__((ext_vector_type(4)));
__device__ __forceinline__ s16x4 vtr(const LAS char* p) { return __builtin_bit_cast(s16x4, __builtin_amdgcn_ds_read_tr16_b64_v4i16((LAS v4i16_t*)p)); }
__device__ __forceinline__ void glds16(const void* gsrc, unsigned lds_dst) { unsigned keep;
    asm volatile("s_mov_b32 %0, m0\n\ts_mov_b32 m0, %2\n\ts_nop 0\n\tglobal_load_lds_dwordx4 %1, off\n\ts_mov_b32 m0, %0" : "=&s"(keep) : "v"(gsrc), "s"(lds_dst) : "memory"); }
#define WAIT_BAR(N) asm volatile("s_waitcnt vmcnt(" #N ") lgkmcnt(0)\n\ts_barrier" ::: "memory")

constexpr int NKS = 4, NVS = 5, SHM_VR = NVS * SHM_V, SHM_KR = NKS * SHM_K, SHM_ATTN2 = SHM_VR + SHM_KR + NWAVES * 64 * 4;
template <int VAR> __device__ __forceinline__ void attn_pass(const bf16_t* __restrict__ Qb, const bf16_t* __restrict__ Kh, const bf16_t* __restrict__ Vh, int seq, char* lds,
                                          f32x16 (&o)[4], float (&rli)[16], bool prefetched, const bf16_t* nKh, const bf16_t* nVh) {
    int tid_ = threadIdx.x; asm volatile("" : "+v"(tid_));
    const int tid = tid_, lane = tid & 63, r32 = lane & 31, hi = lane >> 5; const int wid = __builtin_amdgcn_readfirstlane(tid >> 6);
    char* V_lds = lds; char* K_lds = lds + SHM_VR;
    float* wsf = (float*)(lds + SHM_VR + SHM_KR) + wid * 64; float* li_l = wsf; float* al_l = wsf + 32;
    const unsigned ldsV = (unsigned)(uintptr_t)V_lds, ldsK = (unsigned)(uintptr_t)K_lds;
    float mhat = 0.f, l_reg = 0.f; f32x16 negm = f32x16{};
#pragma unroll
    for (int d = 0; d < 4; ++d) o[d] = f32x16{};
    bf16x8 qr[4];
    const bf16_t* Qw = Qb + (long)(wid * QBLK + r32) * LD + hi * 8;
#pragma unroll
    for (int d0 = 0; d0 < 4; ++d0) qr[d0] = *reinterpret_cast<const bf16x8*>(Qw + d0 * 16);
    const bf16_t* ksrc = Kh + (long)lane * LD + wid * 8;
    const bf16_t* vsrc0 = Vh + (long)(16 * (wid & 3) + (lane >> 2)) * LD + (wid >> 2) * 32 + (lane & 3) * 8;
    const bf16_t* vsrc1 = vsrc0 + 64;
    const unsigned kdst = ldsK + wid * 1024, vdst0 = ldsV + wid * 1024, vdst1 = ldsV + (wid + 8) * 1024;
#define DMA(t, ko, vo) do { const long go_ = (long)(t) * KVBLK * LD; \
        glds16(ksrc + go_, (unsigned)__builtin_amdgcn_readfirstlane(kdst + (ko))); \
        glds16(vsrc0 + go_, (unsigned)__builtin_amdgcn_readfirstlane(vdst0 + (vo))); \
        glds16(vsrc1 + go_, (unsigned)__builtin_amdgcn_readfirstlane(vdst1 + (vo))); } while (0)
#define RESC(al) do { if (__any((al) < 1.f)) { if (hi == 0) al_l[r32] = (al); asm volatile("s_waitcnt lgkmcnt(0)" ::: "memory"); \
    _Pragma("unroll") for (int d = 0; d < 4; ++d) _Pragma("unroll") for (int r = 0; r < 16; ++r) o[d][r] *= al_l[crow(r, hi)]; } } while (0)
    f32x16 pA0, pA1, pB0, pB1; const int NT = seq / KVBLK;
    int kr_ = 0, kw_ = 3 * SHM_K, vr_ = 4 * SHM_V, vw_ = 3 * SHM_V;
#define ROT() do { kr_ = (kr_ == 3 * SHM_K) ? 0 : kr_ + SHM_K; kw_ = (kw_ == 3 * SHM_K) ? 0 : kw_ + SHM_K; vr_ = (vr_ == 4 * SHM_V) ? 0 : vr_ + SHM_V; vw_ = (vw_ == 4 * SHM_V) ? 0 : vw_ + SHM_V; } while (0)
    const LAS char* K3 = (const LAS char*)K_lds + hi * 1024 + r32 * 16;
    const LAS char* V3 = (const LAS char*)V_lds + ((lane >> 4) & 1) * 32 + (lane & 3) * 8 + (4 * hi + ((lane & 15) >> 2)) * 64;
    bf16x8 kf[4]; s16x4 vlo[8], vhi[8]; bf16x8 pa[4];
#define KRD(i) do { if (VAR & 64) kf[(i) & 3] = qr[(i) & 3]; else kf[(i) & 3] = *(const LAS bf16x8*)(kp_ + ((i) >> 1) * 2048 + ((i) & 1) * 512); } while (0)
#define VRD(i) do { if (VAR & 32) { vlo[(i) & 7] = (s16x4){qr[0][0], qr[1][1], qr[2][2], qr[3][3]}; vhi[(i) & 7] = (s16x4){qr[0][4], qr[1][5], qr[2][6], qr[3][7]}; } \
                    else { vlo[(i) & 7] = vtr(vp_ + ((i) & 3) * 4096 + ((i) >> 2) * 1024); vhi[(i) & 7] = vtr(vp_ + ((i) & 3) * 4096 + ((i) >> 2) * 1024 + 512); } } while (0)
#define VFR(s) (bf16x8){vlo[s][0], vlo[s][1], vlo[s][2], vlo[s][3], vhi[s][0], vhi[s][1], vhi[s][2], vhi[s][3]}
#define QKM(PC0, PC1, i) do { if (VAR & 16) { if (((i) >> 1) == 0) { if (((i) & 1) == 0) PC0 = negm; else PC1 = negm; } if (((i) & 1) == 0) PC0[(i)] += __builtin_bit_cast(float, (int)kf[(i) & 3][0]); else PC1[(i)] += __builtin_bit_cast(float, (int)kf[(i) & 3][1]); } \
        else if (((i) & 1) == 0) PC0 = __builtin_amdgcn_mfma_f32_32x32x16_bf16(kf[(i) & 3], qr[(i) >> 1], ((i) >> 1) == 0 ? negm : PC0, 0, 0, 0); \
        else PC1 = __builtin_amdgcn_mfma_f32_32x32x16_bf16(kf[(i) & 3], qr[(i) >> 1], ((i) >> 1) == 0 ? negm : PC1, 0, 0, 0); } while (0)
#define PVM(i) do { if (VAR & 8) o[(i) & 3][(i)] += __builtin_bit_cast(float, (int)(pa[(i) >> 2][0] + vlo[(i) & 7][0] + vhi[(i) & 7][1])); else o[(i) & 3] = __builtin_amdgcn_mfma_f32_32x32x16_bf16(pa[(i) >> 2], VFR((i) & 7), o[(i) & 3], 0, 0, 0); } while (0)
#define PKA(P, B) do { ca0_ = cvtpk(P[B + 0], P[B + 1]); ca1_ = cvtpk(P[B + 2], P[B + 3]); cb0_ = cvtpk(P[B + 4], P[B + 5]); cb1_ = cvtpk(P[B + 6], P[B + 7]); } while (0)
#define PKB(k) do { u32x4 w_ = {ca0_, ca1_, cb0_, cb1_}; pa[k] = __builtin_bit_cast(bf16x8, w_); } while (0)
#define MAX8(acc, P, B) if (!(VAR & 256)) { acc = max3f(acc, P[B], P[B + 1]); pmb_ = max3f(pmb_, P[B + 2], P[B + 3]); acc = max3f(acc, P[B + 4], P[B + 5]); pmb_ = max3f(pmb_, P[B + 6], P[B + 7]); }
#define EX4(P, B) do { P[B] = (VAR & 2) ? P[B] * 0.001f : __builtin_amdgcn_exp2f(P[B]); P[B + 1] = (VAR & 2) ? P[B + 1] * 0.001f : __builtin_amdgcn_exp2f(P[B + 1]); \
                       P[B + 2] = (VAR & 2) ? P[B + 2] * 0.001f : __builtin_amdgcn_exp2f(P[B + 2]); P[B + 3] = (VAR & 2) ? P[B + 3] * 0.001f : __builtin_amdgcn_exp2f(P[B + 3]); \
                       ps2_ += (f32x2){P[B], P[B + 1]}; ps2_ += (f32x2){P[B + 2], P[B + 3]}; } while (0)
#define ENDW(j) do { if (VAR & 2048) { asm volatile("s_waitcnt lgkmcnt(0)" ::: "memory"); } else if ((j) + 3 < NT) WAIT_BAR(6); else if ((j) + 2 < NT) WAIT_BAR(3); else WAIT_BAR(0); } while (0)
    if (!prefetched) { __syncthreads();
        DMA(0, 0, 0); DMA(1, SHM_K, SHM_V); DMA(2, 2 * SHM_K, 2 * SHM_V);
        WAIT_BAR(6); }
    else WAIT_BAR(0);
    { DMA(3, kw_, vw_); SBAR();
      const LAS char* kp_ = K3 + kr_;
      KRD(0); KRD(1); KRD(2); KRD(3);
      QKM(pA0, pA1, 0); KRD(4); QKM(pA0, pA1, 1); KRD(5); QKM(pA0, pA1, 2); KRD(6); QKM(pA0, pA1, 3); KRD(7);
      QKM(pA0, pA1, 4); QKM(pA0, pA1, 5); QKM(pA0, pA1, 6); QKM(pA0, pA1, 7);
      const float rm = rowmax_b(pA1, rowmax_a(pA0)); float al_; decide<true>(rm, pA0, pA1, mhat, negm, al_); float ps = expsum16<VAR>(pA0); ps += expsum16<VAR>(pA1); l_reg = halves_sum(ps); }
    ENDW(0); ROT();
#define STEP(PC0, PC1, PP0, PP1, j) do { \
        if (!(VAR & 4096)) { if ((j) + 3 < NT) DMA((j) + 3, kw_, vw_); } SBAR(); \
        const LAS char* kp_ = K3 + kr_; const LAS char* vp_ = V3 + vr_; \
        unsigned ca0_, ca1_, cb0_, cb1_; float pmx_, pmb_, al_; f32x2 ps2_ = (f32x2){0.f, 0.f}; \
        KRD(0); KRD(1); KRD(2); KRD(3); VRD(0); VRD(1); PKA(PP0, 0); PKB(0); PKA(PP0, 8); PKB(1); SBAR(); \
        QKM(PC0, PC1, 0); KRD(4); VRD(2); PKA(PP1, 0); SBAR(); \
        QKM(PC0, PC1, 1); KRD(5); VRD(3); PKB(2); SBAR(); \
        QKM(PC0, PC1, 2); KRD(6); VRD(4); PKA(PP1, 8); SBAR(); \
        QKM(PC0, PC1, 3); KRD(7); VRD(5); PKB(3); SBAR(); \
        QKM(PC0, PC1, 4); VRD(6); SBAR(); \
        QKM(PC0, PC1, 5); VRD(7); SBAR(); \
        QKM(PC0, PC1, 6); SBAR(); \
        QKM(PC0, PC1, 7); SBAR(); \
        PVM(0); VRD(8); pmx_ = PC0[0]; pmb_ = PC0[2]; MAX8(pmx_, PC0, 0); SBAR(); \
        PVM(1); VRD(9); MAX8(pmx_, PC0, 8); SBAR(); \
        PVM(2); VRD(10); MAX8(pmx_, PC1, 0); SBAR(); \
        PVM(3); VRD(11); MAX8(pmx_, PC1, 8); pmx_ = fmaxf(pmx_, pmb_); { auto rr_ = __builtin_amdgcn_permlane32_swap(__float_as_uint(pmx_), __float_as_uint(pmx_), false, false); pmx_ = fmaxf(__uint_as_float(rr_[0]), __uint_as_float(rr_[1])); } SBAR(); \
        PVM(4); VRD(12); decide<false>(pmx_, PC0, PC1, mhat, negm, al_); SBAR(); \
        PVM(5); VRD(13); EX4(PC0, 0); SBAR(); \
        PVM(6); VRD(14); EX4(PC0, 4); SBAR(); \
        PVM(7); VRD(15); EX4(PC0, 8); SBAR(); \
        PVM(8); EX4(PC0, 12); SBAR(); \
        PVM(9); EX4(PC1, 0); SBAR(); \
        PVM(10); EX4(PC1, 4); SBAR(); \
        PVM(11); EX4(PC1, 8); SBAR(); \
        PVM(12); EX4(PC1, 12); SBAR(); \
        PVM(13); l_reg = l_reg * al_ + halves_sum(ps2_.x + ps2_.y); SBAR(); \
        PVM(14); PVM(15); SBAR(); \
        ENDW(j); RESC(al_); ROT(); } while (0)
    for (int j = 1; j + 1 < NT; j += 2) {
        STEP(pB0, pB1, pA0, pA1, j);
        STEP(pA0, pA1, pB0, pB1, j + 1);
    }
    STEP(pB0, pB1, pA0, pA1, NT - 1);
    if (nKh) {
        const bf16_t* ksrcn = nKh + (long)lane * LD + wid * 8; const bf16_t* vsrcn = nVh + (long)(16 * (wid & 3) + (lane >> 2)) * LD + (wid >> 2) * 32 + (lane & 3) * 8;
#pragma unroll
        for (int t = 0; t < 3; ++t) { const long go_ = (long)t * KVBLK * LD;
            glds16(ksrcn + go_, (unsigned)__builtin_amdgcn_readfirstlane(kdst + t * SHM_K));
            glds16(vsrcn + go_, (unsigned)__builtin_amdgcn_readfirstlane(vdst0 + t * SHM_V));
            glds16(vsrcn + 64 + go_, (unsigned)__builtin_amdgcn_readfirstlane(vdst1 + t * SHM_V)); } }
    { const LAS char* vp_ = V3 + vr_; unsigned ca0_, ca1_, cb0_, cb1_;
      PKA(pB0, 0); PKB(0); PKA(pB0, 8); PKB(1); PKA(pB1, 0); PKB(2); PKA(pB1, 8); PKB(3);
      VRD(0); VRD(1); VRD(2); VRD(3); VRD(4); VRD(5); VRD(6); VRD(7);
      PVM(0); VRD(8); PVM(1); VRD(9); PVM(2); VRD(10); PVM(3); VRD(11); PVM(4); VRD(12); PVM(5); VRD(13); PVM(6); VRD(14); PVM(7); VRD(15);
      PVM(8); PVM(9); PVM(10); PVM(11); PVM(12); PVM(13); PVM(14); PVM(15); }
    if (hi == 0) li_l[r32] = l_reg; asm volatile("s_waitcnt lgkmcnt(0)" ::: "memory");
#pragma unroll
    for (int r = 0; r < 16; ++r) rli[r] = __builtin_amdgcn_rcpf(li_l[crow(r, hi)]);
#undef DMA
#undef RESC
#undef ROT
#undef KRD
#undef VRD
#undef VFR
#undef QKM
#undef PVM
#undef PKA
#undef PKB
#undef MAX8
#undef EX4
#undef ENDW
#undef STEP
}
#undef WAIT_BAR
#undef KSWZ
#undef SBAR
}

template <int VAR> __device__ __forceinline__ void phase2_attn(const Args& a, char* lds, int nblk, int blk) {
    unsigned char* ws = a.ws;
    const bf16_t* Qb = (const bf16_t*)(ws + WS_Q); const bf16_t* Kb = (const bf16_t*)(ws + WS_K); const bf16_t* Vb = (const bf16_t*)(ws + WS_V);
    float* OS = (float*)(ws + WS_O0) + (size_t)blk * 32768;
    bf16_t* MIX = (bf16_t*)(ws + WS_MIX);
    const float lambda_init = 0.2f;
    float lam;
    { const int l0 = threadIdx.x & 63; const float d1 = wave_sum(a.in[3][l0] * a.in[4][l0]), d2 = wave_sum(a.in[5][l0] * a.in[6][l0]); lam = expf(d1) - expf(d2) + lambda_init; }
    const int seq = (VAR & 16384) ? SEQ / 2 : SEQ;
    bool pref = false;
    auto unit_of = [&](int i) -> int { if (nblk != 256) return blk + i * nblk; const int x = blk & 7, j = blk >> 3; return (i * 16 + 2 * x + (j >> 4)) * 16 + (j & 15); };
    const int nui = (nblk == 256) ? 2 : (NBATCH * 4 * 16 - 1 - blk + nblk) / nblk;
    for (int ui = 0; ui < nui; ++ui) {
        const int u = unit_of(ui);
        const int b = u >> 6, h = (u >> 4) & 3, qb = u & 15;
        const long row0 = (long)b * SEQ + qb * 256;
        const bf16_t* Kbh = Kb + (long)b * SEQ * 512 + h * 128; const bf16_t* Vbh = Vb + (long)b * SEQ * 512 + h * 128;
        const bool hasn = ui + 1 < nui; const int un = hasn ? unit_of(ui + 1) : 0;
        const bf16_t* Kn = hasn ? Kb + (long)(un >> 6) * SEQ * 512 + ((un >> 4) & 3) * 128 : nullptr; const bf16_t* Vn = hasn ? Vb + (long)(un >> 6) * SEQ * 512 + ((un >> 4) & 3) * 128 : nullptr;
        for (int m = 0; m < 2; ++m) {
            f32x16 o[4]; float rli[16];
            att::attn_pass<VAR>(Qb + row0 * 512 + (h * 2 + m) * 64, Kbh + m * 64, Vbh, seq, lds, o, rli, pref, m == 0 ? Kbh + 64 : Kn, m == 0 ? Vbh : Vn);
            pref = (m == 0) || hasn;
            int tid_ = threadIdx.x; asm volatile("" : "+v"(tid_));
            const int wid = tid_ >> 6, r32 = tid_ & 31, hi = (tid_ >> 5) & 1;
            float* od = OS + (wid * 32) * 128 + r32;
            if (m == 0) {
#pragma unroll
                for (int r = 0; r < 16; ++r) { const int orow = att::crow(r, hi);
#pragma unroll
                    for (int d0 = 0; d0 < 4; ++d0) od[orow * 128 + d0 * 32] = o[d0][r] * rli[r]; }
            } else {
                float ss[16];
#pragma unroll
                for (int r = 0; r < 16; ++r) ss[r] = 0.f;
#pragma unroll
                for (int d0 = 0; d0 < 4; ++d0) {
#pragma unroll
                    for (int r = 0; r < 16; ++r) { const float v = od[att::crow(r, hi) * 128 + d0 * 32] - lam * (o[d0][r] * rli[r]); o[d0][r] = v; ss[r] = fmaf(v, v, ss[r]); }
                    asm volatile("" ::: "memory"); }
                float gs[4];
#pragma unroll
                for (int d0 = 0; d0 < 4; ++d0) gs[d0] = a.in[7][d0 * 32 + r32] * (1.0f - lambda_init);
                bf16_t* dst = MIX + (size_t)(row0 + wid * 32) * 1024 + h * 128 + r32;
#pragma unroll
                for (int r = 0; r < 16; ++r) { float s = ss[r];
                    s += __shfl_xor(s, 1); s += __shfl_xor(s, 2); s += __shfl_xor(s, 4); s += __shfl_xor(s, 8); s += __shfl_xor(s, 16);
                    const float rstd = __builtin_amdgcn_rsqf(s * (1.0f / 128.f) + EPS);
                    if (VAR == 0) {
#pragma unroll
                        for (int d0 = 0; d0 < 4; ++d0) dst[att::crow(r, hi) * 1024 + d0 * 32] = (bf16_t)pk2(o[d0][r] * rstd * gs[d0], 0.f); }
                    else if (rstd == 123.456f) dst[0] = 1; }
            }
        }
    }
}

constexpr int LRU_XS = 68;
constexpr int LRU_HS = 36;
__device__ __forceinline__ void phase2_lru(const Args& a, LAS unsigned char* lds, int nblk, int blk) {
    unsigned char* ws = a.ws;
    const bf16_t* XR = (const bf16_t*)(ws + WS_XR); const bf16_t* GG = (const bf16_t*)(ws + WS_GG);
    float* H1 = (float*)(ws + WS_HF); bf16_t* MIX = (bf16_t*)(ws + WS_MIX);
    LAS float* xcf = (LAS float*)lds;
    LAS float* hsm = xcf + 2 * 2 * 64 * LRU_XS;
    const int tid = threadIdx.x, lane = tid & 63, wave = __builtin_amdgcn_readfirstlane(tid >> 6);
    const int c16 = lane & 15, fq = lane >> 4;
    const int sch = tid & 63, sdir = wave >> 2, sp0 = 16 * (wave & 3);
    const int dir = wave >> 1, cth = wave & 1;
    const int io = tid & 255, ic4 = io & 7, iorow = io >> 3;
    for (int u = blk; u < NBATCH * 16; u += nblk) {
        const int b = u >> 4, kb = (u >> 1) & 7, chalf = u & 1;
        const bf16_t* XRb = XR + (size_t)b * SEQ * 512; const bf16_t* GGb = GG + (size_t)b * SEQ * 512; float* H1b = H1 + (size_t)b * SEQ * 512; bf16_t* MIXb = MIX + (size_t)b * SEQ * 1024;
        const int schg = kb * 64 + sch;
        float k0, k1, k2, k3; const float cbias = a.in[9][schg];
        { const float w0 = a.in[8][0 * 512 + schg], w1 = a.in[8][1 * 512 + schg], w2 = a.in[8][2 * 512 + schg], w3 = a.in[8][3 * 512 + schg];
          if (sdir == 0) { k0 = w0; k1 = w1; k2 = w2; k3 = w3; } else { k0 = w3; k1 = w2; k2 = w1; k3 = w0; } }
        const int chl = chalf * 32 + cth * 16 + c16, chg = kb * 64 + chl;
        bf16x8 wrf[2], wif[2]; float brs = 0.f, bis = 0.f, kA2 = 0.f;
        if (wave < 4) {
            const float* wrp = a.in[10] + (size_t)(dir * 8 + kb) * 4096 + chl; const float* wip = a.in[12] + (size_t)(dir * 8 + kb) * 4096 + chl;
            constexpr float NL2E = -1.4426950408889634f;
#pragma unroll
            for (int ks = 0; ks < 2; ++ks) { u32x4 pr, pi;
                const int kk = 32 * ks + 8 * fq;
                pr.x = pk2(wrp[(kk + 0) * 64] * NL2E, wrp[(kk + 1) * 64] * NL2E); pr.y = pk2(wrp[(kk + 2) * 64] * NL2E, wrp[(kk + 3) * 64] * NL2E);
                pr.z = pk2(wrp[(kk + 4) * 64] * NL2E, wrp[(kk + 5) * 64] * NL2E); pr.w = pk2(wrp[(kk + 6) * 64] * NL2E, wrp[(kk + 7) * 64] * NL2E);
                pi.x = pk2(wip[(kk + 0) * 64] * NL2E, wip[(kk + 1) * 64] * NL2E); pi.y = pk2(wip[(kk + 2) * 64] * NL2E, wip[(kk + 3) * 64] * NL2E);
                pi.z = pk2(wip[(kk + 4) * 64] * NL2E, wip[(kk + 5) * 64] * NL2E); pi.w = pk2(wip[(kk + 6) * 64] * NL2E, wip[(kk + 7) * 64] * NL2E);
                wrf[ks] = __builtin_bit_cast(bf16x8, pr); wif[ks] = __builtin_bit_cast(bf16x8, pi); }
            brs = a.in[11][dir * 512 + chg] * NL2E; bis = a.in[13][dir * 512 + chg] * NL2E;
            const float nl = -a.in[14][dir * 512 + chg];
            const float sp = (nl > 15.f) ? nl : log1pf(expf(nl));
            kA2 = -8.0f * sp * 1.4426950408889634f;
        }
        float carry = 0.f;
        unsigned short er0[19], er1[19];
        auto stage_ld = [&](int st, unsigned short (&er)[19]) {
            const int t0 = (sdir == 0) ? 64 * st : 64 * (63 - st);
            const int tk0 = (sdir == 0) ? (t0 + sp0) : (t0 + 63 - sp0);
            const int sgn = (sdir == 0) ? 1 : -1, tbase = (sdir == 0) ? tk0 - 2 : tk0 + 1;
#pragma unroll
            for (int i = 0; i < 19; ++i) { const int t = tbase + sgn * i; er[i] = XRb[(long)(t * 512 + schg)]; }
        };
        auto stage_wr = [&](int st, const unsigned short (&er)[19]) {
            const int stc = st < 64 ? st : 63;
            const int t0 = (sdir == 0) ? 64 * stc : 64 * (63 - stc);
            const int tk0 = (sdir == 0) ? (t0 + sp0) : (t0 + 63 - sp0);
            const int sgn = (sdir == 0) ? 1 : -1, tbase = (sdir == 0) ? tk0 - 2 : tk0 + 1;
            float e[19];
            if (stc == 0 || stc == 63) {
#pragma unroll
                for (int i = 0; i < 19; ++i) { const int t = tbase + sgn * i; e[i] = (t >= 0 && t < SEQ) ? bf2f(er[i]) : 0.f; }
            } else {
#pragma unroll
                for (int i = 0; i < 19; ++i) e[i] = bf2f(er[i]);
            }
            LAS float* xd = xcf + ((st & 1) * 2 + sdir) * 64 * LRU_XS + sp0 * LRU_XS + sch;
#pragma unroll
            for (int q = 0; q < 16; ++q) xd[q * LRU_XS] = cbias + k0 * e[q] + k1 * e[q + 1] + k2 * e[q + 2] + k3 * e[q + 3];
        };
        const int ichg = kb * 64 + chalf * 32 + 4 * ic4;
        f32x4 hoth0[4], hoth1[4]; u32x2 ggv0[4], ggv1[4];
        auto io_ld = [&](int st, f32x4 (&hoth)[4], u32x2 (&ggv)[4]) {
#pragma unroll
            for (int k = 0; k < 4; ++k) { const int r = iorow + 32 * k, d = r >> 6, p = r & 63; const int tok = (d == 0) ? 64 * st + p : 64 * (63 - st) + 63 - p;
                hoth[k] = *(const f32x4*)(H1b + (unsigned)(tok * 512 + ichg)); ggv[k] = *(const u32x2*)(GGb + (unsigned)(tok * 512 + ichg)); }
        };
        auto io_out = [&](int st, const f32x4 (&hoth)[4], const u32x2 (&ggv)[4]) {
#pragma unroll
            for (int k = 0; k < 4; ++k) { const int r = iorow + 32 * k, d = r >> 6, p = r & 63; const int tok = (d == 0) ? 64 * st + p : 64 * (63 - st) + 63 - p;
                const f32x4 h = *(const LAS f32x4*)(hsm + ((st & 1) * 2 + d) * 64 * LRU_HS + p * LRU_HS + 4 * ic4);
                if (st < 32) *(f32x4*)(H1b + (unsigned)(tok * 512 + ichg)) = h;
                else { f32x4 g; g.x = __builtin_bit_cast(float, ggv[k].x << 16); g.y = __builtin_bit_cast(float, ggv[k].x & 0xffff0000u); g.z = __builtin_bit_cast(float, ggv[k].y << 16); g.w = __builtin_bit_cast(float, ggv[k].y & 0xffff0000u);
                    store_bf16x4(MIXb + (unsigned)(tok * 1024 + 512 + ichg), (h + hoth[k]) * g); } }
        };
        auto body = [&](int s, bool second, unsigned short (&er)[19], f32x4 (&hoth)[4], u32x2 (&ggv)[4]) {
            stage_wr(s + 1, er);
            stage_ld(s + 3 < 64 ? s + 3 : 63, er);
            if (wave < 4) {
                if (s < 64) {
                const LAS float* xb = xcf + ((s & 1) * 2 + dir) * 64 * LRU_XS;
                LAS float* hb = hsm + ((s & 1) * 2 + dir) * 64 * LRU_HS + cth * 16 + c16;
#pragma unroll
                for (int tt = 0; tt < 4; ++tt) {
                    f32x4 ra = (f32x4){0.f, 0.f, 0.f, 0.f}, ia = (f32x4){0.f, 0.f, 0.f, 0.f};
#pragma unroll
                    for (int ks = 0; ks < 2; ++ks) { const LAS f32x4* xp = (const LAS f32x4*)(xb + (16 * tt + c16) * LRU_XS + 32 * ks + 8 * fq);
                        const f32x4 x0 = xp[0], x1 = xp[1]; u32x4 pa; pa.x = att::cvtpk(x0.x, x0.y); pa.y = att::cvtpk(x0.z, x0.w); pa.z = att::cvtpk(x1.x, x1.y); pa.w = att::cvtpk(x1.z, x1.w);
                        const bf16x8 af = __builtin_bit_cast(bf16x8, pa);
                        ra = __builtin_amdgcn_mfma_f32_16x16x32_bf16(af, wrf[ks], ra, 0, 0, 0);
                        ia = __builtin_amdgcn_mfma_f32_16x16x32_bf16(af, wif[ks], ia, 0, 0, 0); }
                    float Ap[4], Hp[4];
#pragma unroll
                    for (int j = 0; j < 4; ++j) { const float xv = xb[(16 * tt + 4 * fq + j) * LRU_XS + chl];
                        const float r = __builtin_amdgcn_rcpf(1.0f + __builtin_amdgcn_exp2f(ra[j] + brs));
                        const float ig = __builtin_amdgcn_rcpf(1.0f + __builtin_amdgcn_exp2f(ia[j] + bis));
                        const float aa = __builtin_amdgcn_exp2f(kA2 * r);
                        const float uv = __builtin_amdgcn_sqrtf(fmaxf(1.0f - aa * aa, 0.f)) * (ig * xv);
                        if (j == 0) { Ap[0] = aa; Hp[0] = uv; } else { Ap[j] = aa * Ap[j - 1]; Hp[j] = fmaf(aa, Hp[j - 1], uv); } }
                    float Ag = Ap[3], Hg = Hp[3];
                    { const float A1 = __shfl_up(Ag, 16), Hs1 = __shfl_up(Hg, 16); if (fq >= 1) { Hg = fmaf(Ag, Hs1, Hg); Ag = Ag * A1; } }
                    { const float A2 = __shfl_up(Ag, 32), Hs2 = __shfl_up(Hg, 32); if (fq >= 2) { Hg = fmaf(Ag, Hs2, Hg); Ag = Ag * A2; } }
                    float EA = __shfl_up(Ag, 16), EH = __shfl_up(Hg, 16); if (fq == 0) { EA = 1.f; EH = 0.f; }
                    const float TA = __shfl(Ag, 48 + c16), TH = __shfl(Hg, 48 + c16);
                    const float gin = fmaf(EA, carry, EH);
#pragma unroll
                    for (int j = 0; j < 4; ++j) hb[(16 * tt + 4 * fq + j) * LRU_HS] = fmaf(Ap[j], gin, Hp[j]);
                    carry = fmaf(TA, carry, TH);
                }
                }
            } else {
                if (s >= 1) io_out(s - 1, hoth, ggv);
                if (second) io_ld(s + 1 < 64 ? s + 1 : 63, hoth, ggv);
            }
            __syncthreads();
        };
        __syncthreads();
        stage_ld(0, er0); stage_wr(0, er0); stage_ld(1, er1); stage_ld(2, er0);
        __syncthreads();
        body(0, false, er1, hoth1, ggv1);
        for (int s = 1; s <= 31; s += 2) { body(s, false, er0, hoth0, ggv0); body(s + 1, false, er1, hoth1, ggv1); }
        if (wave >= 4) { io_ld(32, hoth0, ggv0); io_ld(33, hoth1, ggv1); }
        for (int s = 33; s <= 63; s += 2) { body(s, true, er0, hoth0, ggv0); body(s + 1, true, er1, hoth1, ggv1); }
    }
}

struct EpiOutProj {
    static constexpr bool PERM = true;
    const float* x; bf16_t* X1;
    __device__ __forceinline__ void operator()(const f32x4 (&acc)[2][2][4][2], const pg8::Unit& u, int wr, int wc, int fr, int fq) const {
        const int row0 = u.pm * 256 + wr * 64 + fr, col0 = u.pn * 256 + wc * 32 + 8 * fq;
#pragma unroll
        for (int ai = 0; ai < 2; ++ai)
#pragma unroll
            for (int m = 0; m < 4; ++m) { const size_t rowoff = (size_t)(row0 + ai * 128 + m * 16) * DM + col0;
#pragma unroll
                for (int bj = 0; bj < 2; ++bj) { const size_t off = rowoff + bj * 128;
                    const f32x4 v0 = *(const f32x4*)(x + off) + acc[ai][bj][m][0], v1 = *(const f32x4*)(x + off + 4) + acc[ai][bj][m][1];
                    u32x4 w; w.x = pk2(v0.x, v0.y); w.y = pk2(v0.z, v0.w); w.z = pk2(v1.x, v1.y); w.w = pk2(v1.z, v1.w);
                    *(u32x4*)(X1 + off) = w; } }
    }
};
__device__ __forceinline__ void phase3(const Args& a, LAS unsigned char* lds, int nblk, int blk) {
    unsigned char* ws = a.ws;
    pg8::DenseOrder S; S.init(ws + WS_MIX, ws + WS_WOUT, MTOK, DM, DM, nblk, blk);
    EpiOutProj E{a.in[0], (bf16_t*)(ws + WS_X1)};
    pg8::gemm_phase(lds, DM, S, E);
}

template <bool DUMMY> __device__ __forceinline__ void phase4(const Args& a, LAS unsigned char* lds, int nblk, int blk) {
    unsigned char* ws = a.ws;
    const bf16_t* X1 = (const bf16_t*)(ws + WS_X1); const float* g2 = a.in[16]; bf16_t* H2 = (bf16_t*)(ws + WS_XN);
    const bf16_t* WRH = (const bf16_t*)(ws + WS_WRH); const bf16_t* WRL = (const bf16_t*)(ws + WS_WRL);
    int* cnt = (int*)(ws + WS_CTL); int* LIST = (int*)(ws + WS_LIST); float* EW = (float*)(ws + WS_EW);
    LAS float* part = (LAS float*)lds;
    LAS float* tot = part + 8 * 16 * 52;
    LAS float* rs = tot + 16 * 52;
    const int tid = threadIdx.x, lane = tid & 63, wave = __builtin_amdgcn_readfirstlane(tid >> 6), r16 = lane & 15, kg = lane >> 4;
    const int kbase = 128 * wave + 8 * kg;
    bf16x8 bh[4][3], bl[4][3];
#pragma unroll
    for (int ks = 0; ks < 4; ++ks)
#pragma unroll
        for (int nt = 0; nt < 3; ++nt) { bh[ks][nt] = *(const bf16x8*)(WRH + (size_t)(16 * nt + r16) * DM + kbase + 32 * ks); bl[ks][nt] = *(const bf16x8*)(WRL + (size_t)(16 * nt + r16) * DM + kbase + 32 * ks); }
    constexpr int NTILE = MTOK / 16;
    LAS float* lg = rs + 16;
    LAS int* lcnt = (LAS int*)(lg + 8 * 16 * 36); LAS int* lbase = lcnt + 32;
    if (tid < NEXP) lcnt[tid] = 0;
    u32x4 xn[4];
    { const int t0 = blk; if (t0 < NTILE) {
#pragma unroll
        for (int ks = 0; ks < 4; ++ks) xn[ks] = *(const u32x4*)(X1 + (size_t)(t0 * 16 + r16) * DM + kbase + 32 * ks); } }
    int ti = 0;
    for (int t = blk; t < NTILE; t += nblk, ++ti) {
        u32x4 xv[4];
#pragma unroll
        for (int ks = 0; ks < 4; ++ks) xv[ks] = xn[ks];
        { const int tn = (t + nblk < NTILE) ? t + nblk : t;
#pragma unroll
          for (int ks = 0; ks < 4; ++ks) xn[ks] = *(const u32x4*)(X1 + (size_t)(tn * 16 + r16) * DM + kbase + 32 * ks); }
        f32x4 acc[3]; acc[0] = (f32x4){0.f, 0.f, 0.f, 0.f}; acc[1] = acc[0]; acc[2] = acc[0];
        float ss = 0.f;
#pragma unroll
        for (int ks = 0; ks < 4; ++ks) { const u32x4 xw = xv[ks];
            const float f0 = __builtin_bit_cast(float, xw.x << 16), f1 = __builtin_bit_cast(float, xw.x & 0xffff0000u), f2 = __builtin_bit_cast(float, xw.y << 16), f3 = __builtin_bit_cast(float, xw.y & 0xffff0000u);
            const float f4 = __builtin_bit_cast(float, xw.z << 16), f5 = __builtin_bit_cast(float, xw.z & 0xffff0000u), f6 = __builtin_bit_cast(float, xw.w << 16), f7 = __builtin_bit_cast(float, xw.w & 0xffff0000u);
            ss += (f0 * f0 + f1 * f1) + (f2 * f2 + f3 * f3) + (f4 * f4 + f5 * f5) + (f6 * f6 + f7 * f7);
            const bf16x8 ah = __builtin_bit_cast(bf16x8, xw);
#pragma unroll
            for (int nt = 0; nt < 3; ++nt) {
                acc[nt] = __builtin_amdgcn_mfma_f32_16x16x32_bf16(ah, bh[ks][nt], acc[nt], 0, 0, 0);
                acc[nt] = __builtin_amdgcn_mfma_f32_16x16x32_bf16(ah, bl[ks][nt], acc[nt], 0, 0, 0); } }
        ss += __shfl_xor(ss, 16); ss += __shfl_xor(ss, 32);
#pragma unroll
        for (int nt = 0; nt < 3; ++nt)
#pragma unroll
            for (int j = 0; j < 4; ++j) part[(wave * 16 + 4 * kg + j) * 52 + 16 * nt + r16] = acc[nt][j];
        if (kg == 0) part[(wave * 16 + r16) * 52 + 48] = ss;
        __syncthreads();
        for (int idx = tid; idx < 16 * 49; idx += NTHREADS) { const int row = idx / 49, o = idx % 49; float s = 0.f;
#pragma unroll
            for (int w = 0; w < 8; ++w) s += part[(w * 16 + row) * 52 + o];
            tot[row * 52 + o] = s; }
        __syncthreads();
        { const float rstd = 1.0f / sqrtf(tot[r16 * 52 + 48] * (1.0f / DM) + EPS);
#pragma unroll
          for (int ks = 0; ks < 4; ++ks) { const f32x4* gp4 = (const f32x4*)(g2 + kbase + 32 * ks); const f32x4 ga = gp4[0], gb = gp4[1]; const u32x4 xw = xv[ks];
              u32x4 w;
              w.x = pk2(__builtin_bit_cast(float, xw.x << 16) * rstd * ga.x, __builtin_bit_cast(float, xw.x & 0xffff0000u) * rstd * ga.y);
              w.y = pk2(__builtin_bit_cast(float, xw.y << 16) * rstd * ga.z, __builtin_bit_cast(float, xw.y & 0xffff0000u) * rstd * ga.w);
              w.z = pk2(__builtin_bit_cast(float, xw.z << 16) * rstd * gb.x, __builtin_bit_cast(float, xw.z & 0xffff0000u) * rstd * gb.y);
              w.w = pk2(__builtin_bit_cast(float, xw.w << 16) * rstd * gb.z, __builtin_bit_cast(float, xw.w & 0xffff0000u) * rstd * gb.w);
              *(u32x4*)(H2 + (size_t)(t * 16 + r16) * DM + kbase + 32 * ks) = w; } }
        for (int idx = tid; idx < 16 * 36; idx += NTHREADS) { const int row = idx / 36, o = idx % 36;
            const float rstd = 1.0f / sqrtf(tot[row * 52 + 48] * (1.0f / DM) + EPS);
            lg[((ti & 7) * 16 + row) * 36 + o] = tot[row * 52 + o] * rstd; }
        const bool lastt = (t + nblk >= NTILE);
        if ((ti & 7) == 7 || lastt) {
            __syncthreads();
            const int nch = (ti & 7) + 1;
            int ea = 0, eb = 0, ra = 0, rb = 0, rowg = 0; float w1 = 0.f, w2 = 0.f;
            const bool act = !DUMMY && tid < nch * 16;
            if (act) {
                const int ci = tid >> 4, row16 = tid & 15;
                const LAS float* tr = lg + (ci * 16 + row16) * 36;
                const float g0 = tr[0], g1 = tr[1], g2l = tr[2], g3 = tr[3];
                int gi = 0; float gm = g0;
                if (g1 > gm) { gm = g1; gi = 1; } if (g2l > gm) { gm = g2l; gi = 2; } if (g3 > gm) { gm = g3; gi = 3; }
                const float gp = 1.0f / (expf(g0 - gm) + expf(g1 - gm) + expf(g2l - gm) + expf(g3 - gm));
                const LAS float* ep = tr + 4 + gi * 8;
                int i1 = 0; float l1 = ep[0];
                for (int j = 1; j < 8; ++j) { const float v = ep[j]; if (v > l1) { l1 = v; i1 = j; } }
                int i2 = -1; float l2 = -3.0e38f;
                for (int j = 0; j < 8; ++j) { const float v = ep[j]; if (j != i1 && v > l2) { l2 = v; i2 = j; } }
                const float e2 = expf(l2 - l1); w1 = gp / (1.0f + e2); w2 = gp * e2 / (1.0f + e2);
                const int tile = t - (nch - 1 - ci) * nblk;
                rowg = tile * 16 + row16; ea = gi * 8 + i1; eb = gi * 8 + i2;
                ra = __hip_atomic_fetch_add((int*)(lcnt + ea), 1, __ATOMIC_RELAXED, __HIP_MEMORY_SCOPE_WORKGROUP); rb = __hip_atomic_fetch_add((int*)(lcnt + eb), 1, __ATOMIC_RELAXED, __HIP_MEMORY_SCOPE_WORKGROUP);
            }
            __syncthreads();
            if (tid < NEXP) { const int n = lcnt[tid]; lbase[tid] = (n > 0) ? atomicAdd(&cnt[tid * 64], n) : 0; lcnt[tid] = 0; }
            __syncthreads();
            if (act) {
                LIST[(size_t)ea * MTOK + lbase[ea] + ra] = rowg * 2 + 0; EW[rowg * 2 + 0] = w1;
                LIST[(size_t)eb * MTOK + lbase[eb] + rb] = rowg * 2 + 1; EW[rowg * 2 + 1] = w2;
            }
            __syncthreads();
        }
    }
}

constexpr int MOE_TAB_OFF = 131072;
constexpr int MOE_MAXT = 320;
__device__ __forceinline__ int moe_build_table(const int* cnt, LAS int* tab) {
    __syncthreads();
    if (threadIdx.x == 0) { int nt = 0, seg = 0;
        for (int e = 0; e < NEXP; ++e) { const int n = cnt[e * 64], mt = (n + 255) >> 8;
            for (int m = 0; m < mt; ++m) { tab[3 * nt] = e | (m << 8); tab[3 * nt + 1] = seg + m * 256; tab[3 * nt + 2] = (n - m * 256) < 256 ? (n - m * 256) : 256; ++nt; }
            seg += mt * 256; }
        tab[3 * MOE_MAXT] = nt; }
    __syncthreads();
    return tab[3 * MOE_MAXT];
}
struct MoeOrder1 {
    const char* H2; const char* W; const int* LIST; LAS const int* tab; int nunits, G, c;
    __device__ __forceinline__ bool next(int i, pg8::Unit& u) const {
        const int L = i * G + c; if (L >= nunits) return false;
        const int t = L >> 1; const int em = tab[3 * t]; u.e = em & 255; u.pm = em >> 8; u.pn = L & 1; u.seg = tab[3 * t + 1]; u.nrows = tab[3 * t + 2];
        u.A = H2; u.B = W + ((size_t)(u.e * 512 + u.pn * 256) * DM) * 2; return true;
    }
    __device__ __forceinline__ unsigned a_row(const pg8::Unit& u, int r, int K_) const { const int tok = (r < u.nrows) ? (LIST[(size_t)u.e * MTOK + u.pm * 256 + r] >> 1) : 0; return (unsigned)(tok * K_) * 2u; }
};
struct EpiMoe1 {
    static constexpr bool PERM = true;
    bf16_t* HID;
    __device__ __forceinline__ void operator()(const f32x4 (&acc)[2][2][4][2], const pg8::Unit& u, int wr, int wc, int fr, int fq) const {
        const int col0 = u.pn * 128 + wc * 32 + 8 * fq;
#pragma unroll
        for (int ai = 0; ai < 2; ++ai)
#pragma unroll
            for (int m = 0; m < 4; ++m) { const int r = ai * 128 + wr * 64 + m * 16 + fr;
                const f32x4 g0 = acc[ai][0][m][0], g1 = acc[ai][0][m][1], u0 = acc[ai][1][m][0], u1 = acc[ai][1][m][1];
                f32x4 h0, h1;
                h0.x = g0.x * sigmoidf_(g0.x) * u0.x; h0.y = g0.y * sigmoidf_(g0.y) * u0.y; h0.z = g0.z * sigmoidf_(g0.z) * u0.z; h0.w = g0.w * sigmoidf_(g0.w) * u0.w;
                h1.x = g1.x * sigmoidf_(g1.x) * u1.x; h1.y = g1.y * sigmoidf_(g1.y) * u1.y; h1.z = g1.z * sigmoidf_(g1.z) * u1.z; h1.w = g1.w * sigmoidf_(g1.w) * u1.w;
                u32x4 w; w.x = pk2(h0.x, h0.y); w.y = pk2(h0.z, h0.w); w.z = pk2(h1.x, h1.y); w.w = pk2(h1.z, h1.w);
                *(u32x4*)(HID + (size_t)(u.seg + r) * DEXP + col0) = w; }
    }
};
struct MoeOrder2 {
    const char* HID; const char* W; LAS const int* tab; int nunits, G, c;
    __device__ __forceinline__ bool next(int i, pg8::Unit& u) const {
        const int L = i * G + c; if (L >= nunits) return false;
        const int t = L >> 2; const int em = tab[3 * t]; u.e = em & 255; u.pm = em >> 8; u.pn = L & 3; u.seg = tab[3 * t + 1]; u.nrows = tab[3 * t + 2];
        u.A = HID + (size_t)u.seg * DEXP * 2; u.B = W + ((size_t)(u.e * DM + u.pn * 256) * DEXP) * 2; return true;
    }
    __device__ __forceinline__ unsigned a_row(const pg8::Unit&, int r, int K_) const { return (unsigned)(r * K_) * 2u; }
};
struct EpiMoe2 {
    static constexpr bool PERM = true;
    bf16_t* Y; const int* LIST;
    __device__ __forceinline__ void operator()(const f32x4 (&acc)[2][2][4][2], const pg8::Unit& u, int wr, int wc, int fr, int fq) const {
        const int col0 = u.pn * 256 + wc * 32 + 8 * fq;
        const int* lp = LIST + (size_t)u.e * MTOK + u.pm * 256;
        int dst[2][4];
#pragma unroll
        for (int ai = 0; ai < 2; ++ai)
#pragma unroll
            for (int m = 0; m < 4; ++m) { const int r = ai * 128 + wr * 64 + m * 16 + fr; dst[ai][m] = (r < u.nrows) ? lp[r] : -1; }
#pragma unroll
        for (int ai = 0; ai < 2; ++ai)
#pragma unroll
            for (int m = 0; m < 4; ++m) {
                if (dst[ai][m] >= 0) {
#pragma unroll
                    for (int bj = 0; bj < 2; ++bj) { const f32x4 v0 = acc[ai][bj][m][0], v1 = acc[ai][bj][m][1];
                        u32x4 w; w.x = pk2(v0.x, v0.y); w.y = pk2(v0.z, v0.w); w.z = pk2(v1.x, v1.y); w.w = pk2(v1.z, v1.w);
                        *(u32x4*)(Y + ((unsigned)dst[ai][m] * (unsigned)DM + (unsigned)(col0 + bj * 128))) = w; } } }
    }
};
__device__ __forceinline__ void phase5(const Args& a, LAS unsigned char* lds, int nblk, int blk) {
    unsigned char* ws = a.ws;
    LAS int* tab = (LAS int*)(lds + MOE_TAB_OFF);
    const int nt = moe_build_table((const int*)(ws + WS_CTL), tab);
    const int vcu = (nblk % 8 == 0) ? (blk % 8) * (nblk / 8) + blk / 8 : blk;
    MoeOrder1 S{(const char*)(ws + WS_XN), (const char*)(ws + WS_WGU), (const int*)(ws + WS_LIST), tab, nt * 2, nblk, vcu};
    EpiMoe1 E{(bf16_t*)(ws + WS_HID)};
    pg8::gemm_phase(lds, DM, S, E);
}
__device__ __forceinline__ void phase6(const Args& a, LAS unsigned char* lds, int nblk, int blk) {
    unsigned char* ws = a.ws;
    LAS int* tab = (LAS int*)(lds + MOE_TAB_OFF);
    const int nt = moe_build_table((const int*)(ws + WS_CTL), tab);
    const int vcu = (nblk % 8 == 0) ? (blk % 8) * (nblk / 8) + blk / 8 : blk;
    MoeOrder2 S{(const char*)(ws + WS_HID), (const char*)(ws + WS_WD), tab, nt * 4, nblk, vcu};
    EpiMoe2 E{(bf16_t*)(ws + WS_Y), (const int*)(ws + WS_LIST)};
    pg8::gemm_phase(lds, DEXP, S, E);
}

template <bool DUMMY> __device__ __forceinline__ void phase7(const Args& a, int lane, int gw, int NGW) {
    unsigned char* ws = a.ws;
    float* out = a.out; const bf16_t* X1 = (const bf16_t*)(ws + WS_X1); const bf16_t* Y = (const bf16_t*)(ws + WS_Y); const float* EW = (const float*)(ws + WS_EW); const float* gf = a.in[22];
    f32x4 gv[4];
#pragma unroll
    for (int j = 0; j < 4; ++j) gv[j] = ((const f32x4*)gf)[lane + 64 * j];
    u32x2 xn[4]; u32x2 y0n[4], y1n[4]; float w0n, w1n;
    auto ld = [&](int m) {
        const u32x2* xr = (const u32x2*)(X1 + (size_t)m * DM) + lane;
        const u32x2* y0 = (const u32x2*)(Y + (size_t)(2 * m) * DM) + lane; const u32x2* y1 = (const u32x2*)(Y + (size_t)(2 * m + 1) * DM) + lane;
#pragma unroll
        for (int j = 0; j < 4; ++j) { xn[j] = xr[64 * j]; y0n[j] = y0[64 * j]; y1n[j] = y1[64 * j]; }
        w0n = EW[2 * m]; w1n = EW[2 * m + 1];
    };
    if (gw < MTOK) ld(gw);
    for (int m = gw; m < MTOK; m += NGW) {
        f32x4 xv[4]; u32x2 a0[4], a1[4];
#pragma unroll
        for (int j = 0; j < 4; ++j) { xv[j].x = __builtin_bit_cast(float, xn[j].x << 16); xv[j].y = __builtin_bit_cast(float, xn[j].x & 0xffff0000u); xv[j].z = __builtin_bit_cast(float, xn[j].y << 16); xv[j].w = __builtin_bit_cast(float, xn[j].y & 0xffff0000u); a0[j] = y0n[j]; a1[j] = y1n[j]; }
        const float w0 = w0n, w1 = w1n;
        ld(m + NGW < MTOK ? m + NGW : m);
        f32x4 v[4]; float s = 0.f;
#pragma unroll
        for (int j = 0; j < 4; ++j) { f32x4 t;
            t.x = xv[j].x + w0 * __builtin_bit_cast(float, a0[j].x << 16) + w1 * __builtin_bit_cast(float, a1[j].x << 16);
            t.y = xv[j].y + w0 * __builtin_bit_cast(float, a0[j].x & 0xffff0000u) + w1 * __builtin_bit_cast(float, a1[j].x & 0xffff0000u);
            t.z = xv[j].z + w0 * __builtin_bit_cast(float, a0[j].y << 16) + w1 * __builtin_bit_cast(float, a1[j].y << 16);
            t.w = xv[j].w + w0 * __builtin_bit_cast(float, a0[j].y & 0xffff0000u) + w1 * __builtin_bit_cast(float, a1[j].y & 0xffff0000u);
            v[j] = t; s += (t.x * t.x + t.y * t.y) + (t.z * t.z + t.w * t.w); }
        s = wave_sum(s);
        const float rstd = 1.0f / sqrtf(s * (1.0f / DM) + EPS);
        f32x4* o = (f32x4*)(out + (size_t)m * DM) + lane;
#pragma unroll
        for (int j = 0; j < 4; ++j) { if (!DUMMY || rstd == 123.4567f) o[64 * j] = v[j] * rstd * gv[j]; }
    }
}

#define XB_TMO      128
#define XB_XCNT(j)  (256  + 64 * (j))
#define XB_XSUB(j)  (1280 + 64 * (j))
#define XB_XGEN(j)  (2304 + 64 * (j))
#define XB_TOP      3328
#define XB_TOPGEN   3392
#define XCD_BAR_WORDS 3456
#define XB_SPIN_CAP (1u << 22)
__device__ __forceinline__ unsigned xb_ld(unsigned* p)              { return __hip_atomic_load(p, __ATOMIC_RELAXED, __HIP_MEMORY_SCOPE_AGENT); }
__device__ __forceinline__ unsigned xb_add(unsigned* p, unsigned v) { return __hip_atomic_fetch_add(p, v, __ATOMIC_RELAXED, __HIP_MEMORY_SCOPE_AGENT); }
__device__ __forceinline__ unsigned xb_xcc_id() { return (unsigned)__builtin_amdgcn_s_getreg((3 << 11) | 20) & 0xFu; }
#define XB_SPIN(cond, bar) do { unsigned _sp = 0; while (cond) { __builtin_amdgcn_s_sleep(1); \
    if ((++_sp & 255u) == 0u) { if (xb_ld(&(bar)[XB_TMO])) break; if (_sp > XB_SPIN_CAP) { atomicAdd(&(bar)[XB_TMO], 1u); break; } } } } while (0)
struct XcdBarrier { unsigned* bar; unsigned x; volatile LAS unsigned* st; };
__device__ __forceinline__ XcdBarrier xcd_barrier_post(unsigned* bar, volatile LAS unsigned* st) {
    XcdBarrier b; b.bar = bar; b.x = xb_xcc_id(); b.st = st;
    if (threadIdx.x == 0) (void)xb_add(&bar[XB_XCNT(b.x)], 1u);
    return b;
}
__device__ __forceinline__ void xcd_barrier_complete(unsigned* bar, unsigned x, unsigned& nloc, unsigned& nx) {
    const unsigned G = gridDim.x * gridDim.y * gridDim.z;
    unsigned sum, cnt, mine, sp = 0u;
    for (;;) {
        sum = 0u; cnt = 0u; mine = 0u;
#pragma unroll
        for (unsigned j = 0; j < 16; ++j) { const unsigned c = xb_ld(&bar[XB_XCNT(j)]); sum += c; cnt += (c > 0u) ? 1u : 0u; mine = (j == x) ? c : mine; }
        if (sum == G) break;
        __builtin_amdgcn_s_sleep(1);
        if ((++sp & 255u) == 0u) { if (xb_ld(&bar[XB_TMO])) break; if (sp > XB_SPIN_CAP) { atomicAdd(&bar[XB_TMO], 1u); break; } }
    }
    nloc = mine > 0u ? mine : 1u; nx = cnt > 0u ? cnt : 1u;
}
__device__ __forceinline__ void xcd_barrier(const XcdBarrier& b) {
    asm volatile("s_waitcnt vmcnt(0)" ::: "memory");
    __syncthreads();
    if (threadIdx.x == 0) {
        unsigned* bar = b.bar;
        __builtin_amdgcn_s_waitcnt(0);
        unsigned nloc = b.st[0], nx = b.st[1];
        if (nloc == 0u) { xcd_barrier_complete(bar, b.x, nloc, nx); b.st[0] = nloc; b.st[1] = nx; }
        const unsigned old = xb_add(&bar[XB_XSUB(b.x)], 1u);
        const unsigned gen = old / nloc;
        if (old + 1u == (gen + 1u) * nloc) {
            __builtin_amdgcn_fence(__ATOMIC_RELEASE, "agent");
            asm volatile("s_waitcnt vmcnt(0)" ::: "memory");
            const unsigned og = xb_add(&bar[XB_TOP], 1u);
            const unsigned tg = og / nx;
            if (og + 1u == (tg + 1u) * nx) xb_add(&bar[XB_TOPGEN], 1u);
            else XB_SPIN(xb_ld(&bar[XB_TOPGEN]) == tg, bar);
            __builtin_amdgcn_fence(__ATOMIC_ACQUIRE, "agent");
            xb_add(&bar[XB_XGEN(b.x)], 1u);
            asm volatile("s_waitcnt vmcnt(0)" ::: "memory");
        } else {
            XB_SPIN(xb_ld(&bar[XB_XGEN(b.x)]) == gen, bar);
            __builtin_amdgcn_fence(__ATOMIC_ACQUIRE, "agent");
            asm volatile("s_waitcnt vmcnt(0)" ::: "memory");
        }
    }
    __syncthreads();
}

__global__ void __launch_bounds__(NTHREADS, 2) mega_fwd(Args args) {
    extern __shared__ __attribute__((aligned(16))) unsigned char lds[];
    const int tid = threadIdx.x, lane = tid & 63, wave = __builtin_amdgcn_readfirstlane(tid >> 6);
    const int nblk = gridDim.x, blk = blockIdx.x;
    const int gw = blk * NWAVES + wave, NGW = nblk * NWAVES;
    const int lo = args.ph_lo, hi = args.ph_hi;
#define IN(k) (lo <= (k) && (k) < hi)
#if MK_CG_SYNC
#define SEAM(k) do { if (IN(k) && IN((k) + 1)) { cg::this_grid().sync(); } } while (0)
#else
    volatile LAS unsigned* bst = (volatile LAS unsigned*)((LAS unsigned char*)lds + LDS_BYTES - 64);
    if (tid == 0) { bst[0] = 0u; bst[1] = 0u; }
    __syncthreads();
    const XcdBarrier gbar = xcd_barrier_post((unsigned*)(args.ws + WS_CTL) + 4096, bst);
#define SEAM(k) do { if (IN(k) && IN((k) + 1)) { xcd_barrier(gbar); } } while (0)
#endif
    if (IN(0)) { phase0(args, (LAS unsigned char*)lds, tid, wave, lane, gw, NGW); if (PROBE_DUP == 0) phase0(args, (LAS unsigned char*)lds, tid, wave, lane, gw, NGW); }
    SEAM(0);
    if (IN(1)) { phase1(args, (LAS unsigned char*)lds, nblk, blk, 6, 1024); if (PROBE_DUP == 1) phase1(args, (LAS unsigned char*)lds, nblk, blk, 6, 1024); }
    SEAM(1);
    if (IN(2)) { const int nl = (nblk >= 256) ? 128 : nblk / 2, ng = nblk - nl;
        const bool probe_ = (hi != NPHASES);
        if (blk < ng) { if (!(probe_ && PROBE_P2_MODE == 1)) phase1(args, (LAS unsigned char*)lds, ng, blk, 0, 1536); }
        else { if (!(probe_ && PROBE_P2_MODE == 2)) phase2_lru(args, (LAS unsigned char*)lds, nl, blk - ng); } }
    SEAM(2);
    if (IN(3)) { phase2_attn<0>(args, (char*)lds, nblk, blk); if (PROBE_DUP == 3) phase2_attn<0>(args, (char*)lds, nblk, blk); }
    SEAM(3);
    if (IN(4)) { phase3(args, (LAS unsigned char*)lds, nblk, blk); if (PROBE_DUP == 4) phase3(args, (LAS unsigned char*)lds, nblk, blk); }
    SEAM(4);
    if (IN(5)) { phase4<false>(args, (LAS unsigned char*)lds, nblk, blk); if (PROBE_DUP == 5) phase4<true>(args, (LAS unsigned char*)lds, nblk, blk); }
    SEAM(5);
    if (IN(6)) { phase5(args, (LAS unsigned char*)lds, nblk, blk); if (PROBE_DUP == 6) phase5(args, (LAS unsigned char*)lds, nblk, blk); }
    SEAM(6);
    if (IN(7)) { phase6(args, (LAS unsigned char*)lds, nblk, blk); if (PROBE_DUP == 7) phase6(args, (LAS unsigned char*)lds, nblk, blk); }
    SEAM(7);
    if (IN(8)) { if (PROBE_DUP == 8) phase7<true>(args, lane, gw, NGW); phase7<false>(args, lane, gw, NGW); }
#undef IN
#undef SEAM
}

#if PROBE_ATT_VAR > 0
__global__ void __launch_bounds__(NTHREADS, 2) probe_attn(Args args) {
    extern __shared__ __attribute__((aligned(16))) unsigned char lds[];
    phase2_attn<PROBE_ATT_VAR>(args, (char*)lds, gridDim.x, blockIdx.x);
}
#endif
#if PROBE_VALU > 0
__global__ void __launch_bounds__(NTHREADS, 2) probe_valu(float* out, float seed) {
    float v[16];
#pragma unroll
    for (int i = 0; i < 16; ++i) v[i] = seed + (float)(threadIdx.x + i);
    f32x16 macc0 = f32x16{}, macc1 = f32x16{}; bf16x8 ma, mb;
#pragma unroll
    for (int i = 0; i < 8; ++i) { ma[i] = (short)(0x3F80 + threadIdx.x + i); mb[i] = (short)(0x3F00 + threadIdx.x * 3 + i); }
    for (int it = 0; it < 4096; ++it) {
#pragma unroll
        for (int i = 0; i < 16; ++i) {
#if PROBE_VALU == 1
            v[i] = fmaf(v[i], 1.0001f, 0.5f);
#elif PROBE_VALU == 2
            v[i] = __builtin_amdgcn_exp2f(v[i]);
#elif PROBE_VALU == 3
            v[i] = fmaxf(fmaxf(v[i], v[(i + 1) & 15]), seed);
#endif
        }
#if PROBE_VALU == 4 || PROBE_VALU == 5
        macc0 = __builtin_amdgcn_mfma_f32_32x32x16_bf16(ma, mb, macc0, 0, 0, 0);
#if PROBE_VALU == 4
        v[0] = fmaf(v[0], 1.0001f, 0.5f); v[1] = fmaf(v[1], 1.0001f, 0.5f); v[2] = fmaf(v[2], 1.0001f, 0.5f); v[3] = fmaf(v[3], 1.0001f, 0.5f); v[4] = fmaf(v[4], 1.0001f, 0.5f); v[5] = fmaf(v[5], 1.0001f, 0.5f);
#endif
        macc1 = __builtin_amdgcn_mfma_f32_32x32x16_bf16(ma, mb, macc1, 0, 0, 0);
#if PROBE_VALU == 4
        v[6] = fmaf(v[6], 1.0001f, 0.5f); v[7] = fmaf(v[7], 1.0001f, 0.5f); v[8] = fmaf(v[8], 1.0001f, 0.5f); v[9] = fmaf(v[9], 1.0001f, 0.5f); v[10] = fmaf(v[10], 1.0001f, 0.5f); v[11] = fmaf(v[11], 1.0001f, 0.5f);
#endif
#endif
        asm volatile("" : "+v"(v[0]), "+v"(v[1]), "+v"(v[2]), "+v"(v[3]), "+v"(v[4]), "+v"(v[5]), "+v"(v[6]), "+v"(v[7]));
    }
    float s = 0.f;
#pragma unroll
    for (int i = 0; i < 16; ++i) s += v[i] + macc0[i] + macc1[i];
    if (s == 123.456f) out[threadIdx.x] = s;
}
#endif
extern "C" void kernel_launch(void* const* d_in, const int* in_sizes, int n_in, void* d_out, int out_size, void* d_ws, size_t ws_size, hipStream_t stream) {
    static int grid = 0;
    if (grid == 0) {
        if (n_in != 23 || out_size != MTOK * DM || ws_size < WS_END) { fprintf(stderr, "kernel_launch: unexpected shapes (n_in %d out %d ws %zu)\n", n_in, out_size, ws_size); grid = -1; return; }
        int dev = 0, cus = 0, per_cu = 0;
        hipGetDevice(&dev);
        hipDeviceGetAttribute(&cus, hipDeviceAttributeMultiprocessorCount, dev);
        hipFuncSetAttribute((const void*)mega_fwd, hipFuncAttributeMaxDynamicSharedMemorySize, LDS_BYTES);
        hipOccupancyMaxActiveBlocksPerMultiprocessor(&per_cu, (const void*)mega_fwd, NTHREADS, LDS_BYTES);
        if (per_cu < 1) per_cu = 1;
        if (per_cu > 1) per_cu = 1;
        grid = cus * per_cu;
        (void)hipGetLastError();
    }
    if (grid < 0) return;
    (void)hipMemsetAsync((char*)d_ws + WS_CTL, 0, 65536, stream);
    Args a{};
    for (int i = 0; i < 23; ++i) a.in[i] = (const float*)d_in[i];
    a.out = (float*)d_out; a.ws = (unsigned char*)d_ws;
#if MK_N_LAUNCHES == 1
#if PROBE_VALU > 0
    hipLaunchKernelGGL(probe_valu, dim3(grid), dim3(NTHREADS), 0, stream, (float*)((char*)d_ws + WS_O0), 1.0f);
#endif
#if PROBE_PREFIX > 0
    { a.ph_lo = 0; a.ph_hi = PROBE_PREFIX; void* kargs0[] = {&a};
      (void)hipLaunchCooperativeKernel((const void*)mega_fwd, dim3(grid), dim3(NTHREADS), kargs0, LDS_BYTES, stream);
      (void)hipMemsetAsync((char*)d_ws + WS_CTL, 0, 65536, stream); }
#if PROBE_ATT_VAR > 0
    { (void)hipFuncSetAttribute((const void*)probe_attn, hipFuncAttributeMaxDynamicSharedMemorySize, LDS_BYTES); hipLaunchKernelGGL(probe_attn, dim3(grid), dim3(PROBE_ATT_THREADS), LDS_BYTES, stream, a); }
#endif
#endif
    a.ph_lo = 0; a.ph_hi = NPHASES;
    void* kargs[] = {&a};
    hipError_t e = hipLaunchCooperativeKernel((const void*)mega_fwd, dim3(grid), dim3(NTHREADS), kargs, LDS_BYTES, stream);
    if (e != hipSuccess) fprintf(stderr, "cooperative launch failed: %s (grid %d)\n", hipGetErrorString(e), grid);
#else
    for (int p = 0; p < NPHASES; ++p) {
        a.ph_lo = p; a.ph_hi = p + 1;
        hipLaunchKernelGGL(mega_fwd, dim3(grid), dim3(NTHREADS), LDS_BYTES, stream, a);
    }
#endif
}
```

```cpp
#include <hip/hip_runtime.h>
#include <hip/hip_cooperative_groups.h>
#include <hip/hip_bf16.h>
#include <cstdint>
#include <cstdio>
namespace cg = cooperative_groups;

#ifndef PROBE_DUP
#define PROBE_DUP -1
#endif
#ifndef PROBE_PREFIX
#define PROBE_PREFIX 0
#endif
#ifndef PROBE_P2_MODE
#define PROBE_P2_MODE 0
#endif
#ifndef PROBE_LRU_ABL
#define PROBE_LRU_ABL 0
#endif
#ifndef PROBE_VALU
#define PROBE_VALU 0
#endif
#ifndef PROBE_ATT_THREADS
#define PROBE_ATT_THREADS 512
#endif
#ifndef PROBE_ATT_VAR
#define PROBE_ATT_VAR 0
#endif
#ifndef MK_CG_SYNC
#define MK_CG_SYNC 0
#endif
#ifndef MK_N_LAUNCHES
#define MK_N_LAUNCHES 1
#endif

#define LAS __attribute__((address_space(3)))
typedef unsigned short bf16_t;
typedef __hip_bfloat16 bf16;
typedef short bf16x8 __attribute__((ext_vector_type(8)));
typedef short s16x4 __attribute__((ext_vector_type(4)));
typedef float f32x4 __attribute__((ext_vector_type(4)));
typedef float f32x16 __attribute__((ext_vector_type(16)));
typedef unsigned u32x4 __attribute__((ext_vector_type(4)));
typedef unsigned u32x2 __attribute__((ext_vector_type(2)));
typedef float f32x2 __attribute__((ext_vector_type(2)));

constexpr int NBATCH = 8, SEQ = 4096, DM = 1024, MTOK = NBATCH * SEQ;
constexpr int NIN = 2560;
constexpr int NEXP = 32, DEXP = 256;
constexpr float EPS = 1e-6f;
constexpr float QSCALE = 0.125f * 1.4426950408889634f;
constexpr int NWAVES = 8, NTHREADS = 512;
constexpr int NPHASES = 9;

constexpr size_t MiB = 1u << 20;
constexpr size_t WS_CTL = 0;
constexpr size_t WS_RT = 1 * MiB;
constexpr size_t WS_WRH = 1 * MiB + 512 * 1024;
constexpr size_t WS_WRL = 1 * MiB + 768 * 1024;
constexpr size_t WS_WIN = 2 * MiB;
constexpr size_t WS_WOUT = 7 * MiB;
constexpr size_t WS_WGU = 9 * MiB;
constexpr size_t WS_WD = 41 * MiB;
constexpr size_t WS_EW = 58 * MiB;
constexpr size_t WS_LIST = 59 * MiB;
constexpr size_t WS_XN = 64 * MiB;
constexpr size_t WS_Q = 128 * MiB, WS_K = 160 * MiB, WS_V = 192 * MiB, WS_XR = 224 * MiB, WS_GG = 256 * MiB;
constexpr size_t WS_X1 = 128 * MiB;
constexpr size_t WS_Y = 352 * MiB;
constexpr size_t WS_O0 = 288 * MiB;
constexpr size_t WS_HID = 288 * MiB;
constexpr size_t WS_HF = 352 * MiB;
constexpr size_t WS_MIX = 416 * MiB;
constexpr size_t WS_END = 480 * MiB;

constexpr int LDS_BYTES = 136 * 1024;

struct Args { const float* in[23]; float* out; unsigned char* ws; int ph_lo, ph_hi; };

#define LDS_WAIT() asm volatile("s_waitcnt lgkmcnt(0)" ::: "memory")
__device__ __forceinline__ unsigned f2bf(float f) { unsigned u = __builtin_bit_cast(unsigned, f); return (u + 0x7fffu + ((u >> 16) & 1u)) >> 16; }
__device__ __forceinline__ unsigned pk2(float lo, float hi) { unsigned r; asm("v_cvt_pk_bf16_f32 %0, %1, %2" : "=v"(r) : "v"(lo), "v"(hi)); return r; }
__device__ __forceinline__ float bf2f(bf16_t b) { return __builtin_bit_cast(float, (unsigned)b << 16); }
__device__ __forceinline__ float wave_sum(float v) {
#pragma unroll
    for (int o = 1; o < 64; o <<= 1) v += __shfl_xor(v, o);
    return v;
}
__device__ __forceinline__ float gelu_tanh(float x) {
    const float y = 0.7978845608028654f * (x + 0.044715f * x * x * x);
    const float t = 1.0f - 2.0f * __builtin_amdgcn_rcpf(1.0f + __builtin_amdgcn_exp2f(2.885390081777927f * y));
    return 0.5f * x * (1.0f + t);
}
__device__ __forceinline__ float sigmoidf_(float x) { return __builtin_amdgcn_rcpf(1.0f + __builtin_amdgcn_exp2f(-1.4426950408889634f * x)); }

__device__ __forceinline__ void tr_item(const float* W, int N, int k0, int n0, bf16_t* WT, int ldt, int dst_row0, LAS float* scr, int lane) {
#pragma unroll 8
    for (int i = 0; i < 32; ++i) { const int kk = 2 * i + (lane >> 5); scr[kk * 33 + (lane & 31)] = W[(size_t)(k0 + kk) * N + n0 + (lane & 31)]; }
    LDS_WAIT(); asm volatile("" ::: "memory");
    const int c = lane & 7;
#pragma unroll
    for (int j = 0; j < 4; ++j) { const int n = (lane >> 3) + 8 * j; const LAS float* s = scr + (8 * c) * 33 + n;
        u32x4 o; o.x = pk2(s[0 * 33], s[1 * 33]); o.y = pk2(s[2 * 33], s[3 * 33]); o.z = pk2(s[4 * 33], s[5 * 33]); o.w = pk2(s[6 * 33], s[7 * 33]);
        *(u32x4*)(WT + (size_t)(dst_row0 + n) * ldt + k0 + 8 * c) = o; }
    LDS_WAIT(); asm volatile("" ::: "memory");
}
__device__ __forceinline__ int gu_row(int c, int is_up) { return 256 * (c >> 7) + 128 * is_up + (c & 127); }

__device__ __forceinline__ void rms_row_bf16(const float* xrow, const float* g, bf16_t* orow, int lane) {
    const f32x4* xr = (const f32x4*)xrow + lane; const f32x4* gr = (const f32x4*)g + lane;
    f32x4 v[4]; float s = 0.f;
#pragma unroll
    for (int j = 0; j < 4; ++j) { v[j] = xr[64 * j]; s += (v[j].x * v[j].x + v[j].y * v[j].y) + (v[j].z * v[j].z + v[j].w * v[j].w); }
    s = wave_sum(s);
    const float rstd = 1.0f / sqrtf(s * (1.0f / DM) + EPS);
    u32x2* o8 = (u32x2*)orow + lane;
#pragma unroll
    for (int j = 0; j < 4; ++j) { const f32x4 gv = gr[64 * j]; u32x2 w; w.x = pk2(v[j].x * rstd * gv.x, v[j].y * rstd * gv.y); w.y = pk2(v[j].z * rstd * gv.z, v[j].w * rstd * gv.w); o8[64 * j] = w; }
}

__device__ __forceinline__ void phase0(const Args& a, LAS unsigned char* lds, int tid, int wave, int lane, int gw, int NGW) {
    unsigned char* ws = a.ws;
    LAS float* scr = (LAS float*)(lds + wave * 8704);
    bf16_t* WinT = (bf16_t*)(ws + WS_WIN); bf16_t* WoutT = (bf16_t*)(ws + WS_WOUT); bf16_t* WguT = (bf16_t*)(ws + WS_WGU); bf16_t* WdT = (bf16_t*)(ws + WS_WD);
    constexpr int I_IN = 16 * 80, I_OUT = 16 * 32, I_G = 32 * 128, I_U = 32 * 128, I_D = 32 * 128, NITEMS = I_IN + I_OUT + I_G + I_U + I_D;
    for (int it = gw; it < NITEMS; it += NGW) {
        int r = it;
        if (r < I_IN) { const int kb = r / 80, nb = r % 80; tr_item(a.in[2], NIN, 64 * kb, 32 * nb, WinT, DM, 32 * nb, scr, lane); continue; } r -= I_IN;
        if (r < I_OUT) { const int kb = r / 32, nb = r % 32; tr_item(a.in[15], DM, 64 * kb, 32 * nb, WoutT, DM, 32 * nb, scr, lane); continue; } r -= I_OUT;
        if (r < I_G) { const int e = r / 128, rr = r % 128, kb = rr / 8, nb = rr % 8; tr_item(a.in[19] + (size_t)e * DM * DEXP, DEXP, 64 * kb, 32 * nb, WguT + (size_t)e * 512 * DM, DM, gu_row(32 * nb, 0), scr, lane); continue; } r -= I_G;
        if (r < I_U) { const int e = r / 128, rr = r % 128, kb = rr / 8, nb = rr % 8; tr_item(a.in[20] + (size_t)e * DM * DEXP, DEXP, 64 * kb, 32 * nb, WguT + (size_t)e * 512 * DM, DM, gu_row(32 * nb, 1), scr, lane); continue; } r -= I_U;
        { const int e = r / 128, rr = r % 128, kb = rr / 32, nb = rr % 32; tr_item(a.in[21] + (size_t)e * DEXP * DM, DM, 64 * kb, 32 * nb, WdT + (size_t)e * DM * DEXP, DEXP, 32 * nb, scr, lane); }
    }
    { bf16_t* WRH = (bf16_t*)(ws + WS_WRH); bf16_t* WRL = (bf16_t*)(ws + WS_WRL); const int gt = gw * 64 + lane, NGT = NGW * 64;
      for (int idx = gt; idx < 48 * DM; idx += NGT) { const int j = idx / DM, k = idx % DM;
          const float w = (j < 4) ? a.in[17][k * 4 + j] : (j < 36) ? a.in[18][k * 32 + (j - 4)] : 0.f; const float wg = w * a.in[16][k];
          const unsigned hi = f2bf(wg); const float hif = __builtin_bit_cast(float, hi << 16);
          WRH[idx] = (bf16_t)hi; WRL[idx] = (bf16_t)f2bf(wg - hif); }
      if (gt < 2048) ((int*)(ws + WS_CTL))[gt] = 0;
      float2* RT = (float2*)(ws + WS_RT);
      for (int idx = gt; idx < SEQ * 8; idx += NGT) { const int pos = idx >> 3, i = idx & 7;
          const float invf = __builtin_amdgcn_exp2f(-(float)i * (18.931568569324174f / 8.0f));
          const float ang = (float)pos * invf;
          const double rev = (double)ang * 0.15915494309189535; const double fr = rev - __builtin_rint(rev);
          const float frf = (float)fr;
          RT[idx] = make_float2(__builtin_amdgcn_cosf(frf), __builtin_amdgcn_sinf(frf)); }
    }
    { bf16_t* XN = (bf16_t*)(ws + WS_XN); const float* x = a.in[0];
      f32x4 gv[4];
#pragma unroll
      for (int j = 0; j < 4; ++j) gv[j] = ((const f32x4*)a.in[1])[lane + 64 * j];
      f32x4 xn[4];
      if (gw < MTOK) {
#pragma unroll
          for (int j = 0; j < 4; ++j) xn[j] = ((const f32x4*)(x + (size_t)gw * DM))[lane + 64 * j]; }
      for (int m = gw; m < MTOK; m += NGW) {
          f32x4 v[4]; float s = 0.f;
#pragma unroll
          for (int j = 0; j < 4; ++j) { v[j] = xn[j]; s += (v[j].x * v[j].x + v[j].y * v[j].y) + (v[j].z * v[j].z + v[j].w * v[j].w); }
          { const int mn = (m + NGW < MTOK) ? m + NGW : m;
#pragma unroll
            for (int j = 0; j < 4; ++j) xn[j] = ((const f32x4*)(x + (size_t)mn * DM))[lane + 64 * j]; }
          s = wave_sum(s);
          const float rstd = 1.0f / sqrtf(s * (1.0f / DM) + EPS);
          u32x2* o8 = (u32x2*)(XN + (size_t)m * DM) + lane;
#pragma unroll
          for (int j = 0; j < 4; ++j) { u32x2 w; w.x = pk2(v[j].x * rstd * gv[j].x, v[j].y * rstd * gv[j].y); w.y = pk2(v[j].z * rstd * gv[j].z, v[j].w * rstd * gv[j].w); o8[64 * j] = w; } } }
}

template <class ARow>
__device__ __forceinline__ void wave_gemm_64x64(f32x4 (&acc)[4][4], const ARow& arow, const bf16_t* __restrict__ Bt, int ldb, int K, int m0, int n0, int lane) {
    const int fr = lane & 15, fq = lane >> 4;
#pragma unroll
    for (int mi = 0; mi < 4; ++mi)
#pragma unroll
        for (int ni = 0; ni < 4; ++ni) acc[mi][ni] = (f32x4){0.f, 0.f, 0.f, 0.f};
    const bf16_t* ap[4];
#pragma unroll
    for (int mi = 0; mi < 4; ++mi) ap[mi] = arow(m0 + 16 * mi + fr) + 8 * fq;
    const bf16_t* bp = Bt + (size_t)(n0 + fr) * ldb + 8 * fq;
    for (int k0 = 0; k0 < K; k0 += 32) {
        bf16x8 av[4], bv[4];
#pragma unroll
        for (int mi = 0; mi < 4; ++mi) av[mi] = *(const bf16x8*)(ap[mi] + k0);
#pragma unroll
        for (int ni = 0; ni < 4; ++ni) bv[ni] = *(const bf16x8*)(bp + (size_t)(16 * ni) * ldb + k0);
#pragma unroll
        for (int mi = 0; mi < 4; ++mi)
#pragma unroll
            for (int ni = 0; ni < 4; ++ni) acc[mi][ni] = __builtin_amdgcn_mfma_f32_16x16x32_bf16(bv[ni], av[mi], acc[mi][ni], 0, 0, 0);
    }
}
struct RowsContig { const bf16_t* base; int ld; __device__ __forceinline__ const bf16_t* operator()(int r) const { return base + (size_t)r * ld; } };

__device__ __forceinline__ void store_bf16x4(bf16_t* p, f32x4 v) { u32x2 w; w.x = pk2(v.x, v.y); w.y = pk2(v.z, v.w); *(u32x2*)p = w; }


namespace pg8 {
constexpr int BM = 256, BK = 64, HALF = 128, HTB = HALF * BK * 2, STAGE_BYTES = 8 * HTB, NXCD = 8, WGM = 8;
__host__ __device__ __forceinline__ int lds_byte(int r, int c) { const int st = (r >> 4) * 2 + (c >> 5), rr = r & 15, cc = c & 31, ob = rr * 64 + cc * 2; return st * 1024 + (ob ^ (((ob >> 9) & 1) << 5)); }
__host__ __device__ __forceinline__ void stage_rc(int b, int& R, int& C) { const int st = b / 1024, sb = b % 1024, swz = sb ^ (((sb >> 9) & 1) << 5); R = (st >> 1) * 16 + swz / 64; C = (st & 1) * 32 + (swz % 64) / 2; }
__host__ __device__ __forceinline__ int perm32(int rho) { const int n = rho >> 4, i = rho & 15; return 8 * (i >> 2) + 4 * n + (i & 3); }

struct Unit { const char* A; const char* B; int pm, pn, e, nrows, seg; };

template <class Epi, class Sched>
__device__ __forceinline__ void gemm_phase(LAS unsigned char* lds, const int K, const Sched& S, const Epi& E) {
    const int tid = threadIdx.x, wid = __builtin_amdgcn_readfirstlane(tid >> 6), lane = tid & 63, wr = wid >> 2, wc = wid & 3, fr = lane & 15, fq = lane >> 4;
    const int nt = K / BK;
    int Rl[2], Cl[2]; unsigned voffB[2];
#pragma unroll
    for (int i = 0; i < 2; ++i) { int R, C; stage_rc(tid * 16 + i * 8192, R, C); const int Rb = Epi::PERM ? ((R & ~31) + perm32(R & 31)) : R;
        Rl[i] = R; Cl[i] = C; voffB[i] = (unsigned)(Rb * K + C) * 2u; }
    const size_t kstep = (size_t)(BK * 2);
    const size_t hstep = (size_t)HALF * K * 2;
    const unsigned ldsw = (unsigned)wid * 1024u;
    const int aoff = lds_byte(wr * 64 + fr, fq * 8), boff = lds_byte(wc * 32 + fr, fq * 8);
#define PG8_SA(b, h) (((b) * 2 + (h)) * HTB)
#define PG8_SB(b, h) ((4 + (b) * 2 + (h)) * HTB)
#define PG8_STAGE(bufoff, gbase, voff) do { _Pragma("unroll") for (int _i = 0; _i < 2; ++_i) \
        __builtin_amdgcn_global_load_lds((const unsigned*)((const char*)(gbase) + (voff)[_i]), (LAS unsigned*)(lds + (bufoff) + ldsw + _i * 8192), 16, 0, 0); } while (0)
#define PG8_LDA(dst, b, h) do { _Pragma("unroll") for (int m = 0; m < 4; ++m) _Pragma("unroll") for (int k = 0; k < 2; ++k) dst[m][k] = *(const LAS bf16x8*)(lds + PG8_SA(b, h) + aoff + m * 2048 + k * 1024); } while (0)
#define PG8_LDB(dst, b, h) do { _Pragma("unroll") for (int n = 0; n < 2; ++n) _Pragma("unroll") for (int k = 0; k < 2; ++k) dst[n][k] = *(const LAS bf16x8*)(lds + PG8_SB(b, h) + boff + n * 2048 + k * 1024); } while (0)
#define PG8_MMA(ai, bj, At, Bt) do { __builtin_amdgcn_s_setprio(1); _Pragma("unroll") for (int m = 0; m < 4; ++m) _Pragma("unroll") for (int n = 0; n < 2; ++n) _Pragma("unroll") for (int k = 0; k < 2; ++k) \
        acc[ai][bj][m][n] = __builtin_amdgcn_mfma_f32_16x16x32_bf16(Bt[n][k], At[m][k], acc[ai][bj][m][n], 0, 0, 0); __builtin_amdgcn_s_setprio(0); } while (0)
#define PG8_WAIT_V(n) asm volatile("s_waitcnt vmcnt(" #n ")" ::: "memory")
#define PG8_WAIT_L(n) asm volatile("s_waitcnt lgkmcnt(" #n ")" ::: "memory")
#define PG8_BAR __builtin_amdgcn_s_barrier()
#define PG8_SCHED __builtin_amdgcn_sched_barrier(0)
    Unit cur, nxt; int ui = 0;
    if (!S.next(0, cur)) return;
    f32x4 acc[2][2][4][2];
#pragma unroll
    for (int a = 0; a < 2; ++a)
#pragma unroll
        for (int b = 0; b < 2; ++b)
#pragma unroll
            for (int m = 0; m < 4; ++m)
#pragma unroll
                for (int n = 0; n < 2; ++n) acc[a][b][m][n] = (f32x4){0.f, 0.f, 0.f, 0.f};
    bf16x8 At[4][2], B0[2][2], B1[2][2];
    const char* cA = cur.A; const char* cB = cur.B;
    unsigned vA0[2], vA1[2], nA0[2], nA1[2];
#pragma unroll
    for (int i = 0; i < 2; ++i) { vA0[i] = S.a_row(cur, Rl[i], K) + (unsigned)Cl[i] * 2u; vA1[i] = S.a_row(cur, HALF + Rl[i], K) + (unsigned)Cl[i] * 2u; nA0[i] = vA0[i]; nA1[i] = vA1[i]; }
    PG8_STAGE(PG8_SB(0, 0), cB, voffB); PG8_STAGE(PG8_SB(0, 1), cB + hstep, voffB); PG8_STAGE(PG8_SA(0, 0), cA, vA0); PG8_STAGE(PG8_SA(0, 1), cA, vA1);
    if (wr == 1) PG8_BAR;
    PG8_WAIT_V(2); PG8_BAR;
    PG8_STAGE(PG8_SB(1, 0), cB + kstep, voffB); PG8_STAGE(PG8_SA(1, 0), cA + kstep, vA0); PG8_STAGE(PG8_SB(1, 1), cB + hstep + kstep, voffB);
    PG8_WAIT_V(6); PG8_BAR;
    for (;;) {
        const bool has_next = S.next(ui + 1, nxt);
        const char* nA = has_next ? nxt.A : cA; const char* nB = has_next ? nxt.B : cB;
        if (has_next) {
#pragma unroll
            for (int i = 0; i < 2; ++i) { nA0[i] = S.a_row(nxt, Rl[i], K) + (unsigned)Cl[i] * 2u; nA1[i] = S.a_row(nxt, HALF + Rl[i], K) + (unsigned)Cl[i] * 2u; }
        }
#pragma nounroll
        for (int t = 0; t < nt; t += 2) {
            const bool last = (t == nt - 2);
            const char* a1 = cA + (size_t)(t + 1) * kstep;
            const char* a2 = last ? nA : cA + (size_t)(t + 2) * kstep; const char* b2 = last ? nB : cB + (size_t)(t + 2) * kstep;
            const char* a3 = a2 + kstep; const char* b3 = b2 + kstep;
            unsigned w0[2], w1[2];
#pragma unroll
            for (int i = 0; i < 2; ++i) { w0[i] = last ? nA0[i] : vA0[i]; w1[i] = last ? nA1[i] : vA1[i]; }
            PG8_LDB(B0, 0, 0); PG8_LDB(B1, 0, 1); PG8_SCHED; PG8_LDA(At, 0, 0); PG8_STAGE(PG8_SA(1, 1), a1, vA1);
            PG8_WAIT_V(8); PG8_WAIT_L(0); PG8_BAR; PG8_MMA(0, 0, At, B0); PG8_MMA(0, 1, At, B1); PG8_BAR; PG8_SCHED;
            PG8_LDA(At, 0, 1); PG8_STAGE(PG8_SB(0, 0), b2, voffB); PG8_STAGE(PG8_SB(0, 1), b2 + hstep, voffB); PG8_STAGE(PG8_SA(0, 0), a2, w0);
            PG8_WAIT_V(8); PG8_WAIT_L(0); PG8_BAR; PG8_MMA(1, 0, At, B0); PG8_MMA(1, 1, At, B1); PG8_BAR; PG8_SCHED;
            PG8_LDB(B0, 1, 0); PG8_LDB(B1, 1, 1); PG8_SCHED; PG8_LDA(At, 1, 0); PG8_STAGE(PG8_SA(0, 1), a2, w1);
            PG8_WAIT_V(8); PG8_WAIT_L(0); PG8_BAR; PG8_MMA(0, 0, At, B0); PG8_MMA(0, 1, At, B1); PG8_BAR; PG8_SCHED;
            PG8_LDA(At, 1, 1); PG8_STAGE(PG8_SB(1, 0), b3, voffB); PG8_STAGE(PG8_SB(1, 1), b3 + hstep, voffB); PG8_STAGE(PG8_SA(1, 0), a3, w0);
            PG8_WAIT_V(8); PG8_WAIT_L(0); PG8_BAR; PG8_MMA(1, 0, At, B0); PG8_MMA(1, 1, At, B1); PG8_BAR; PG8_SCHED;
        }
        if (wr == 0) PG8_BAR;
        E(acc, cur, wr, wc, fr, fq);
        if (!has_next) break;
#pragma unroll
        for (int a = 0; a < 2; ++a)
#pragma unroll
            for (int b = 0; b < 2; ++b)
#pragma unroll
                for (int m = 0; m < 4; ++m)
#pragma unroll
                    for (int n = 0; n < 2; ++n) acc[a][b][m][n] = (f32x4){0.f, 0.f, 0.f, 0.f};
        cur = nxt; cA = nA; cB = nB; ++ui;
#pragma unroll
        for (int i = 0; i < 2; ++i) { vA0[i] = nA0[i]; vA1[i] = nA1[i]; }
        if (wr == 1) PG8_BAR;
    }
    PG8_WAIT_V(0);
    PG8_BAR;
#undef PG8_SA
#undef PG8_SB
#undef PG8_STAGE
#undef PG8_LDA
#undef PG8_LDB
#undef PG8_MMA
#undef PG8_WAIT_V
#undef PG8_WAIT_L
#undef PG8_BAR
#undef PG8_SCHED
}

struct DenseOrder {
    const char* A; const char* Bt; int K, nM, nN, nwg, G, c, pn0;
    __device__ void init(const void* A_, const void* Bt_, int M, int N, int K_, int G_, int c_, int pn0_ = 0) { A = (const char*)A_; Bt = (const char*)Bt_; K = K_; nM = M / BM; nN = N / BM; nwg = nM * nN; G = G_; c = c_; pn0 = pn0_; }
    __device__ __forceinline__ bool next(int i, Unit& u) const {
        const long L = (long)i * G + c; if (L >= nwg) return false;
        int wgid = (int)L; { const int q = nwg / NXCD, r = nwg % NXCD, xcd = wgid % NXCD, off = wgid / NXCD; wgid = (xcd < r ? xcd * (q + 1) : r * (q + 1) + (xcd - r) * q) + off; }
        const int nig = WGM * nN, gid = wgid / nig, fm = gid * WGM, gsz = (nM - fm) < WGM ? (nM - fm) : WGM;
        u.pm = fm + ((wgid % nig) % gsz); u.pn = pn0 + (wgid % nig) / gsz; u.e = 0; u.nrows = BM; u.seg = 0;
        u.A = A + (size_t)u.pm * BM * K * 2; u.B = Bt + (size_t)u.pn * BM * K * 2; return true;
    }
    __device__ __forceinline__ unsigned a_row(const Unit&, int r, int K_) const { return (unsigned)(r * K_) * 2u; }
};
}

struct EpiInProj {
    static constexpr bool PERM = true;
    unsigned char* ws; const float2* RT;
    __device__ __forceinline__ void operator()(const f32x4 (&acc)[2][2][4][2], const pg8::Unit& u, int wr, int wc, int fr, int fq) const {
        const int seg = u.pn >> 1;
        bf16_t* dst = (bf16_t*)(ws + (seg == 0 ? WS_Q : seg == 1 ? WS_K : seg == 2 ? WS_V : seg == 3 ? WS_XR : WS_GG));
        const int row0 = u.pm * 256 + wr * 64 + fr, col0 = (u.pn & 1) * 256 + wc * 32 + 8 * fq;
        const bool rope = (seg <= 1) && ((wc & 1) == 0);
#pragma unroll
        for (int ai = 0; ai < 2; ++ai)
#pragma unroll
            for (int m = 0; m < 4; ++m) { const int row = row0 + ai * 128 + m * 16, pos = row & (SEQ - 1);
#pragma unroll
                for (int bj = 0; bj < 2; ++bj) { f32x4 v0 = acc[ai][bj][m][0], v1 = acc[ai][bj][m][1];
                    if (rope) {
                        f32x4 p0, p1;
                        p0.x = __shfl_xor(v0.x, 16); p0.y = __shfl_xor(v0.y, 16); p0.z = __shfl_xor(v0.z, 16); p0.w = __shfl_xor(v0.w, 16);
                        p1.x = __shfl_xor(v1.x, 16); p1.y = __shfl_xor(v1.y, 16); p1.z = __shfl_xor(v1.z, 16); p1.w = __shfl_xor(v1.w, 16);
                        if (fq < 2) { const float2* cs = RT + pos * 8; const float sg = (fq == 0) ? -1.f : 1.f;
                            const float2 c0 = cs[0], c1 = cs[1], c2 = cs[2], c3 = cs[3], c4 = cs[4], c5 = cs[5], c6 = cs[6], c7 = cs[7];
                            v0.x = v0.x * c0.x + sg * p0.x * c0.y; v0.y = v0.y * c1.x + sg * p0.y * c1.y; v0.z = v0.z * c2.x + sg * p0.z * c2.y; v0.w = v0.w * c3.x + sg * p0.w * c3.y;
                            v1.x = v1.x * c4.x + sg * p1.x * c4.y; v1.y = v1.y * c5.x + sg * p1.y * c5.y; v1.z = v1.z * c6.x + sg * p1.z * c6.y; v1.w = v1.w * c7.x + sg * p1.w * c7.y; }
                    }
                    if (seg == 0) { v0 = v0 * QSCALE; v1 = v1 * QSCALE; }
                    if (seg == 4) { v0.x = gelu_tanh(v0.x); v0.y = gelu_tanh(v0.y); v0.z = gelu_tanh(v0.z); v0.w = gelu_tanh(v0.w); v1.x = gelu_tanh(v1.x); v1.y = gelu_tanh(v1.y); v1.z = gelu_tanh(v1.z); v1.w = gelu_tanh(v1.w); }
                    u32x4 w; w.x = pk2(v0.x, v0.y); w.y = pk2(v0.z, v0.w); w.z = pk2(v1.x, v1.y); w.w = pk2(v1.z, v1.w);
                    *(u32x4*)(dst + (size_t)row * 512 + col0 + bj * 128) = w; } }
    }
};
__device__ __forceinline__ void phase1(const Args& a, LAS unsigned char* lds, int G, int c, int pn0, int ncols) {
    unsigned char* ws = a.ws;
    pg8::DenseOrder S; S.init(ws + WS_XN, ws + WS_WIN, MTOK, ncols, DM, G, c, pn0);
    EpiInProj E{ws, (const float2*)(ws + WS_RT)};
    pg8::gemm_phase(lds, DM, S, E);
}

namespace att {
constexpr int DQK = 64, DV = 128, QBLK = 32, KVBLK = 64, LD = 512;
constexpr float SCALE = 0.125f, THR = 8.f;
constexpr int SHM_V = KVBLK * DV * 2, SHM_K = KVBLK * DQK * 2, SHM_ATTN = 2 * SHM_V + 2 * SHM_K + NWAVES * 64 * 4;
#define KSWZ(row, colB) ((row) * 128 + ((colB) ^ ((((row) >> 1) & 7) << 4)))
#define SBAR() __builtin_amdgcn_sched_barrier(0)
__device__ __forceinline__ int crow(int r, int hi) { return (r & 3) + 8 * (r >> 2) + 4 * hi; }
__device__ __forceinline__ float max3f(float a, float b, float c) { float r; asm("v_max3_f32 %0, %1, %2, %3" : "=v"(r) : "v"(a), "v"(b), "v"(c)); return r; }
__device__ __forceinline__ unsigned cvtpk(float lo, float hi) { unsigned r; asm volatile("v_cvt_pk_bf16_f32 %0, %1, %2" : "=v"(r) : "v"(lo), "v"(hi)); return r; }

constexpr float THRL = 11.0f;
__device__ __forceinline__ float rowmax_a(const f32x16& p0) {
    float pmax = p0[0];
#pragma unroll
    for (int r = 1; r < 16; ++r) pmax = fmaxf(pmax, p0[r]);
    return pmax;
}
__device__ __forceinline__ float rowmax_b(const f32x16& p1, float pmax) {
#pragma unroll
    for (int r = 0; r < 16; ++r) pmax = fmaxf(pmax, p1[r]);
    auto rr = __builtin_amdgcn_permlane32_swap(__float_as_uint(pmax), __float_as_uint(pmax), false, false);
    return fmaxf(__uint_as_float(rr[0]), __uint_as_float(rr[1]));
}
template <bool FIRST> __device__ __forceinline__ void decide(float rm, f32x16& p0, f32x16& p1, float& mhat, f32x16& negm, float& alpha) {
    alpha = 1.f;
    if (FIRST || __builtin_expect(__any(rm > THRL), 0)) {
        const float dl = FIRST ? rm : fmaxf(rm, 0.f);
        mhat += dl;
#pragma unroll
        for (int r = 0; r < 16; ++r) { p0[r] -= dl; p1[r] -= dl; }
#pragma unroll
        for (int r = 0; r < 16; ++r) negm[r] = -mhat;
        alpha = __builtin_amdgcn_exp2f(-dl);
    }
}
template <int VAR> __device__ __forceinline__ void exp16(f32x16& p) {
#pragma unroll
    for (int r = 0; r < 16; ++r) p[r] = (VAR & 2) ? p[r] * 0.001f : __builtin_amdgcn_exp2f(p[r]);
}
template <int VAR> __device__ __forceinline__ float expsum16(f32x16& p) {
    exp16<VAR>(p);
    float ps = 0;
#pragma unroll
    for (int r = 0; r < 16; ++r) ps += p[r];
    return ps;
}
__device__ __forceinline__ float halves_sum(float ps) {
    auto rr = __builtin_amdgcn_permlane32_swap(__float_as_uint(ps), __float_as_uint(ps), false, false);
    return __uint_as_float(rr[0]) + __uint_as_float(rr[1]);
}
__device__ __forceinline__ void pack4(const f32x16& p0, const f32x16& p1, bf16x8& pa0, bf16x8& pa1, bf16x8& pa2, bf16x8& pa3) {
#define PK4(P, BASE, OUT) do { u32x4 w = {cvtpk(P[BASE + 0], P[BASE + 1]), cvtpk(P[BASE + 2], P[BASE + 3]), cvtpk(P[BASE + 4], P[BASE + 5]), cvtpk(P[BASE + 6], P[BASE + 7])}; OUT = *reinterpret_cast<bf16x8*>(&w); } while (0)
    PK4(p0, 0, pa0); PK4(p0, 8, pa1); PK4(p1, 0, pa2); PK4(p1, 8, pa3);
#undef PK4
}
typedef short v4i16_t __attribute__((ext_vector_type(4)));
__device__ __forceinline__ s16x4 vtr(const LAS char* p) { return __builtin_bit_cast(s16x4, __builtin_amdgcn_ds_read_tr16_b64_v4i16((LAS v4i16_t*)p)); }
__device__ __forceinline__ void glds16(const void* gsrc, unsigned lds_dst) { unsigned keep;
    asm volatile("s_mov_b32 %0, m0\n\ts_mov_b32 m0, %2\n\ts_nop 0\n\tglobal_load_lds_dwordx4 %1, off\n\ts_mov_b32 m0, %0" : "=&s"(keep) : "v"(gsrc), "s"(lds_dst) : "memory"); }
#define WAIT_BAR(N) asm volatile("s_waitcnt vmcnt(" #N ") lgkmcnt(0)\n\ts_barrier" ::: "memory")

constexpr int NKS = 4, NVS = 5, SHM_VR = NVS * SHM_V, SHM_KR = NKS * SHM_K, SHM_ATTN2 = SHM_VR + SHM_KR + NWAVES * 64 * 4;
template <int VAR> __device__ __forceinline__ void attn_pass(const bf16_t* __restrict__ Qb, const bf16_t* __restrict__ Kh, const bf16_t* __restrict__ Vh, int seq, char* lds,
                                          f32x16 (&o)[4], float (&rli)[16], bool prefetched, const bf16_t* nKh, const bf16_t* nVh) {
    int tid_ = threadIdx.x; asm volatile("" : "+v"(tid_));
    const int tid = tid_, lane = tid & 63, r32 = lane & 31, hi = lane >> 5; const int wid = __builtin_amdgcn_readfirstlane(tid >> 6);
    char* V_lds = lds; char* K_lds = lds + SHM_VR;
    float* wsf = (float*)(lds + SHM_VR + SHM_KR) + wid * 64; float* li_l = wsf; float* al_l = wsf + 32;
    const unsigned ldsV = (unsigned)(uintptr_t)V_lds, ldsK = (unsigned)(uintptr_t)K_lds;
    float mhat = 0.f, l_reg = 0.f; f32x16 negm = f32x16{};
#pragma unroll
    for (int d = 0; d < 4; ++d) o[d] = f32x16{};
    bf16x8 qr[4];
    const bf16_t* Qw = Qb + (long)(wid * QBLK + r32) * LD + hi * 8;
#pragma unroll
    for (int d0 = 0; d0 < 4; ++d0) qr[d0] = *reinterpret_cast<const bf16x8*>(Qw + d0 * 16);
    const bf16_t* ksrc = Kh + (long)lane * LD + wid * 8;
    const bf16_t* vsrc0 = Vh + (long)(16 * (wid & 3) + (lane >> 2)) * LD + (wid >> 2) * 32 + (lane & 3) * 8;
    const bf16_t* vsrc1 = vsrc0 + 64;
    const unsigned kdst = ldsK + wid * 1024, vdst0 = ldsV + wid * 1024, vdst1 = ldsV + (wid + 8) * 1024;
#define DMA(t, ko, vo) do { const long go_ = (long)(t) * KVBLK * LD; \
        glds16(ksrc + go_, (unsigned)__builtin_amdgcn_readfirstlane(kdst + (ko))); \
        glds16(vsrc0 + go_, (unsigned)__builtin_amdgcn_readfirstlane(vdst0 + (vo))); \
        glds16(vsrc1 + go_, (unsigned)__builtin_amdgcn_readfirstlane(vdst1 + (vo))); } while (0)
#define RESC(al) do { if (__any((al) < 1.f)) { if (hi == 0) al_l[r32] = (al); asm volatile("s_waitcnt lgkmcnt(0)" ::: "memory"); \
    _Pragma("unroll") for (int d = 0; d < 4; ++d) _Pragma("unroll") for (int r = 0; r < 16; ++r) o[d][r] *= al_l[crow(r, hi)]; } } while (0)
    f32x16 pA0, pA1, pB0, pB1; const int NT = seq / KVBLK;
    int kr_ = 0, kw_ = 3 * SHM_K, vr_ = 4 * SHM_V, vw_ = 3 * SHM_V;
#define ROT() do { kr_ = (kr_ == 3 * SHM_K) ? 0 : kr_ + SHM_K; kw_ = (kw_ == 3 * SHM_K) ? 0 : kw_ + SHM_K; vr_ = (vr_ == 4 * SHM_V) ? 0 : vr_ + SHM_V; vw_ = (vw_ == 4 * SHM_V) ? 0 : vw_ + SHM_V; } while (0)
    const LAS char* K3 = (const LAS char*)K_lds + hi * 1024 + r32 * 16;
    const LAS char* V3 = (const LAS char*)V_lds + ((lane >> 4) & 1) * 32 + (lane & 3) * 8 + (4 * hi + ((lane & 15) >> 2)) * 64;
    bf16x8 kf[4]; s16x4 vlo[8], vhi[8]; bf16x8 pa[4];
#define KRD(i) do { if (VAR & 64) kf[(i) & 3] = qr[(i) & 3]; else kf[(i) & 3] = *(const LAS bf16x8*)(kp_ + ((i) >> 1) * 2048 + ((i) & 1) * 512); } while (0)
#define VRD(i) do { if (VAR & 32) { vlo[(i) & 7] = (s16x4){qr[0][0], qr[1][1], qr[2][2], qr[3][3]}; vhi[(i) & 7] = (s16x4){qr[0][4], qr[1][5], qr[2][6], qr[3][7]}; } \
                    else { vlo[(i) & 7] = vtr(vp_ + ((i) & 3) * 4096 + ((i) >> 2) * 1024); vhi[(i) & 7] = vtr(vp_ + ((i) & 3) * 4096 + ((i) >> 2) * 1024 + 512); } } while (0)
#define VFR(s) (bf16x8){vlo[s][0], vlo[s][1], vlo[s][2], vlo[s][3], vhi[s][0], vhi[s][1], vhi[s][2], vhi[s][3]}
#define QKM(PC0, PC1, i) do { if (VAR & 16) { if (((i) >> 1) == 0) { if (((i) & 1) == 0) PC0 = negm; else PC1 = negm; } if (((i) & 1) == 0) PC0[(i)] += __builtin_bit_cast(float, (int)kf[(i) & 3][0]); else PC1[(i)] += __builtin_bit_cast(float, (int)kf[(i) & 3][1]); } \
        else if (((i) & 1) == 0) PC0 = __builtin_amdgcn_mfma_f32_32x32x16_bf16(kf[(i) & 3], qr[(i) >> 1], ((i) >> 1) == 0 ? negm : PC0, 0, 0, 0); \
        else PC1 = __builtin_amdgcn_mfma_f32_32x32x16_bf16(kf[(i) & 3], qr[(i) >> 1], ((i) >> 1) == 0 ? negm : PC1, 0, 0, 0); } while (0)
#define PVM(i) do { if (VAR & 8) o[(i) & 3][(i)] += __builtin_bit_cast(float, (int)(pa[(i) >> 2][0] + vlo[(i) & 7][0] + vhi[(i) & 7][1])); else o[(i) & 3] = __builtin_amdgcn_mfma_f32_32x32x16_bf16(pa[(i) >> 2], VFR((i) & 7), o[(i) & 3], 0, 0, 0); } while (0)
#define PKA(P, B) do { ca0_ = cvtpk(P[B + 0], P[B + 1]); ca1_ = cvtpk(P[B + 2], P[B + 3]); cb0_ = cvtpk(P[B + 4], P[B + 5]); cb1_ = cvtpk(P[B + 6], P[B + 7]); } while (0)
#define PKB(k) do { u32x4 w_ = {ca0_, ca1_, cb0_, cb1_}; pa[k] = __builtin_bit_cast(bf16x8, w_); } while (0)
#define MAX8(acc, P, B) if (!(VAR & 256)) { acc = max3f(acc, P[B], P[B + 1]); pmb_ = max3f(pmb_, P[B + 2], P[B + 3]); acc = max3f(acc, P[B + 4], P[B + 5]); pmb_ = max3f(pmb_, P[B + 6], P[B + 7]); }
#define EX4(P, B) do { P[B] = (VAR & 2) ? P[B] * 0.001f : __builtin_amdgcn_exp2f(P[B]); P[B + 1] = (VAR & 2) ? P[B + 1] * 0.001f : __builtin_amdgcn_exp2f(P[B + 1]); \
                       P[B + 2] = (VAR & 2) ? P[B + 2] * 0.001f : __builtin_amdgcn_exp2f(P[B + 2]); P[B + 3] = (VAR & 2) ? P[B + 3] * 0.001f : __builtin_amdgcn_exp2f(P[B + 3]); \
                       ps2_ += (f32x2){P[B], P[B + 1]}; ps2_ += (f32x2){P[B + 2], P[B + 3]}; } while (0)
#define ENDW(j) do { if (VAR & 2048) { asm volatile("s_waitcnt lgkmcnt(0)" ::: "memory"); } else if ((j) + 3 < NT) WAIT_BAR(6); else if ((j) + 2 < NT) WAIT_BAR(3); else WAIT_BAR(0); } while (0)
    if (!prefetched) { __syncthreads();
        DMA(0, 0, 0); DMA(1, SHM_K, SHM_V); DMA(2, 2 * SHM_K, 2 * SHM_V);
        WAIT_BAR(6); }
    else WAIT_BAR(0);
    { DMA(3, kw_, vw_); SBAR();
      const LAS char* kp_ = K3 + kr_;
      KRD(0); KRD(1); KRD(2); KRD(3);
      QKM(pA0, pA1, 0); KRD(4); QKM(pA0, pA1, 1); KRD(5); QKM(pA0, pA1, 2); KRD(6); QKM(pA0, pA1, 3); KRD(7);
      QKM(pA0, pA1, 4); QKM(pA0, pA1, 5); QKM(pA0, pA1, 6); QKM(pA0, pA1, 7);
      const float rm = rowmax_b(pA1, rowmax_a(pA0)); float al_; decide<true>(rm, pA0, pA1, mhat, negm, al_); float ps = expsum16<VAR>(pA0); ps += expsum16<VAR>(pA1); l_reg = halves_sum(ps); }
    ENDW(0); ROT();
#define STEP(PC0, PC1, PP0, PP1, j) do { \
        if (!(VAR & 4096)) { if ((j) + 3 < NT) DMA((j) + 3, kw_, vw_); } SBAR(); \
        const LAS char* kp_ = K3 + kr_; const LAS char* vp_ = V3 + vr_; \
        unsigned ca0_, ca1_, cb0_, cb1_; float pmx_, pmb_, al_; f32x2 ps2_ = (f32x2){0.f, 0.f}; \
        KRD(0); KRD(1); KRD(2); KRD(3); VRD(0); VRD(1); PKA(PP0, 0); PKB(0); PKA(PP0, 8); PKB(1); SBAR(); \
        QKM(PC0, PC1, 0); KRD(4); VRD(2); PKA(PP1, 0); SBAR(); \
        QKM(PC0, PC1, 1); KRD(5); VRD(3); PKB(2); SBAR(); \
        QKM(PC0, PC1, 2); KRD(6); VRD(4); PKA(PP1, 8); SBAR(); \
        QKM(PC0, PC1, 3); KRD(7); VRD(5); PKB(3); SBAR(); \
        QKM(PC0, PC1, 4); VRD(6); SBAR(); \
        QKM(PC0, PC1, 5); VRD(7); SBAR(); \
        QKM(PC0, PC1, 6); SBAR(); \
        QKM(PC0, PC1, 7); SBAR(); \
        PVM(0); VRD(8); pmx_ = PC0[0]; pmb_ = PC0[2]; MAX8(pmx_, PC0, 0); SBAR(); \
        PVM(1); VRD(9); MAX8(pmx_, PC0, 8); SBAR(); \
        PVM(2); VRD(10); MAX8(pmx_, PC1, 0); SBAR(); \
        PVM(3); VRD(11); MAX8(pmx_, PC1, 8); pmx_ = fmaxf(pmx_, pmb_); { auto rr_ = __builtin_amdgcn_permlane32_swap(__float_as_uint(pmx_), __float_as_uint(pmx_), false, false); pmx_ = fmaxf(__uint_as_float(rr_[0]), __uint_as_float(rr_[1])); } SBAR(); \
        PVM(4); VRD(12); decide<false>(pmx_, PC0, PC1, mhat, negm, al_); SBAR(); \
        PVM(5); VRD(13); EX4(PC0, 0); SBAR(); \
        PVM(6); VRD(14); EX4(PC0, 4); SBAR(); \
        PVM(7); VRD(15); EX4(PC0, 8); SBAR(); \
        PVM(8); EX4(PC0, 12); SBAR(); \
        PVM(9); EX4(PC1, 0); SBAR(); \
        PVM(10); EX4(PC1, 4); SBAR(); \
        PVM(11); EX4(PC1, 8); SBAR(); \
        PVM(12); EX4(PC1, 12); SBAR(); \
        PVM(13); l_reg = l_reg * al_ + halves_sum(ps2_.x + ps2_.y); SBAR(); \
        PVM(14); PVM(15); SBAR(); \
        ENDW(j); RESC(al_); ROT(); } while (0)
    for (int j = 1; j + 1 < NT; j += 2) {
        STEP(pB0, pB1, pA0, pA1, j);
        STEP(pA0, pA1, pB0, pB1, j + 1);
    }
    STEP(pB0, pB1, pA0, pA1, NT - 1);
    if (nKh) {
        const bf16_t* ksrcn = nKh + (long)lane * LD + wid * 8; const bf16_t* vsrcn = nVh + (long)(16 * (wid & 3) + (lane >> 2)) * LD + (wid >> 2) * 32 + (lane & 3) * 8;
#pragma unroll
        for (int t = 0; t < 3; ++t) { const long go_ = (long)t * KVBLK * LD;
            glds16(ksrcn + go_, (unsigned)__builtin_amdgcn_readfirstlane(kdst + t * SHM_K));
            glds16(vsrcn + go_, (unsigned)__builtin_amdgcn_readfirstlane(vdst0 + t * SHM_V));
            glds16(vsrcn + 64 + go_, (unsigned)__builtin_amdgcn_readfirstlane(vdst1 + t * SHM_V)); } }
    { const LAS char* vp_ = V3 + vr_; unsigned ca0_, ca1_, cb0_, cb1_;
      PKA(pB0, 0); PKB(0); PKA(pB0, 8); PKB(1); PKA(pB1, 0); PKB(2); PKA(pB1, 8); PKB(3);
      VRD(0); VRD(1); VRD(2); VRD(3); VRD(4); VRD(5); VRD(6); VRD(7);
      PVM(0); VRD(8); PVM(1); VRD(9); PVM(2); VRD(10); PVM(3); VRD(11); PVM(4); VRD(12); PVM(5); VRD(13); PVM(6); VRD(14); PVM(7); VRD(15);
      PVM(8); PVM(9); PVM(10); PVM(11); PVM(12); PVM(13); PVM(14); PVM(15); }
    if (hi == 0) li_l[r32] = l_reg; asm volatile("s_waitcnt lgkmcnt(0)" ::: "memory");
#pragma unroll
    for (int r = 0; r < 16; ++r) rli[r] = __builtin_amdgcn_rcpf(li_l[crow(r, hi)]);
#undef DMA
#undef RESC
#undef ROT
#undef KRD
#undef VRD
#undef VFR
#undef QKM
#undef PVM
#undef PKA
#undef PKB
#undef MAX8
#undef EX4
#undef ENDW
#undef STEP
}
#undef WAIT_BAR
#undef KSWZ
#undef SBAR
}

template <int VAR> __device__ __forceinline__ void phase2_attn(const Args& a, char* lds, int nblk, int blk) {
    unsigned char* ws = a.ws;
    const bf16_t* Qb = (const bf16_t*)(ws + WS_Q); const bf16_t* Kb = (const bf16_t*)(ws + WS_K); const bf16_t* Vb = (const bf16_t*)(ws + WS_V);
    float* OS = (float*)(ws + WS_O0) + (size_t)blk * 32768;
    bf16_t* MIX = (bf16_t*)(ws + WS_MIX);
    const float lambda_init = 0.2f;
    float lam;
    { const int l0 = threadIdx.x & 63; const float d1 = wave_sum(a.in[3][l0] * a.in[4][l0]), d2 = wave_sum(a.in[5][l0] * a.in[6][l0]); lam = expf(d1) - expf(d2) + lambda_init; }
    const int seq = (VAR & 16384) ? SEQ / 2 : SEQ;
    bool pref = false;
    auto unit_of = [&](int i) -> int { if (nblk != 256) return blk + i * nblk; const int x = blk & 7, j = blk >> 3; return (i * 16 + 2 * x + (j >> 4)) * 16 + (j & 15); };
    const int nui = (nblk == 256) ? 2 : (NBATCH * 4 * 16 - 1 - blk + nblk) / nblk;
    for (int ui = 0; ui < nui; ++ui) {
        const int u = unit_of(ui);
        const int b = u >> 6, h = (u >> 4) & 3, qb = u & 15;
        const long row0 = (long)b * SEQ + qb * 256;
        const bf16_t* Kbh = Kb + (long)b * SEQ * 512 + h * 128; const bf16_t* Vbh = Vb + (long)b * SEQ * 512 + h * 128;
        const bool hasn = ui + 1 < nui; const int un = hasn ? unit_of(ui + 1) : 0;
        const bf16_t* Kn = hasn ? Kb + (long)(un >> 6) * SEQ * 512 + ((un >> 4) & 3) * 128 : nullptr; const bf16_t* Vn = hasn ? Vb + (long)(un >> 6) * SEQ * 512 + ((un >> 4) & 3) * 128 : nullptr;
        for (int m = 0; m < 2; ++m) {
            f32x16 o[4]; float rli[16];
            att::attn_pass<VAR>(Qb + row0 * 512 + (h * 2 + m) * 64, Kbh + m * 64, Vbh, seq, lds, o, rli, pref, m == 0 ? Kbh + 64 : Kn, m == 0 ? Vbh : Vn);
            pref = (m == 0) || hasn;
            int tid_ = threadIdx.x; asm volatile("" : "+v"(tid_));
            const int wid = tid_ >> 6, r32 = tid_ & 31, hi = (tid_ >> 5) & 1;
            float* od = OS + (wid * 32) * 128 + r32;
            if (m == 0) {
#pragma unroll
                for (int r = 0; r < 16; ++r) { const int orow = att::crow(r, hi);
#pragma unroll
                    for (int d0 = 0; d0 < 4; ++d0) od[orow * 128 + d0 * 32] = o[d0][r] * rli[r]; }
            } else {
                float ss[16];
#pragma unroll
                for (int r = 0; r < 16; ++r) ss[r] = 0.f;
#pragma unroll
                for (int d0 = 0; d0 < 4; ++d0) {
#pragma unroll
                    for (int r = 0; r < 16; ++r) { const float v = od[att::crow(r, hi) * 128 + d0 * 32] - lam * (o[d0][r] * rli[r]); o[d0][r] = v; ss[r] = fmaf(v, v, ss[r]); }
                    asm volatile("" ::: "memory"); }
                float gs[4];
#pragma unroll
                for (int d0 = 0; d0 < 4; ++d0) gs[d0] = a.in[7][d0 * 32 + r32] * (1.0f - lambda_init);
                bf16_t* dst = MIX + (size_t)(row0 + wid * 32) * 1024 + h * 128 + r32;
#pragma unroll
                for (int r = 0; r < 16; ++r) { float s = ss[r];
                    s += __shfl_xor(s, 1); s += __shfl_xor(s, 2); s += __shfl_xor(s, 4); s += __shfl_xor(s, 8); s += __shfl_xor(s, 16);
                    const float rstd = __builtin_amdgcn_rsqf(s * (1.0f / 128.f) + EPS);
                    if (VAR == 0) {
#pragma unroll
                        for (int d0 = 0; d0 < 4; ++d0) dst[att::crow(r, hi) * 1024 + d0 * 32] = (bf16_t)pk2(o[d0][r] * rstd * gs[d0], 0.f); }
                    else if (rstd == 123.456f) dst[0] = 1; }
            }
        }
    }
}

constexpr int LRU_XS = 68;
constexpr int LRU_HS = 36;
__device__ __forceinline__ void phase2_lru(const Args& a, LAS unsigned char* lds, int nblk, int blk) {
    unsigned char* ws = a.ws;
    const bf16_t* XR = (const bf16_t*)(ws + WS_XR); const bf16_t* GG = (const bf16_t*)(ws + WS_GG);
    float* H1 = (float*)(ws + WS_HF); bf16_t* MIX = (bf16_t*)(ws + WS_MIX);
    LAS float* xcf = (LAS float*)lds;
    LAS unsigned* plm = (LAS unsigned*)(xcf + 2 * 2 * 64 * LRU_XS);
    LAS float* cmp = (LAS float*)(plm + 2 * 2 * 64 * LRU_HS);
    const int tid = threadIdx.x, lane = tid & 63, wave = __builtin_amdgcn_readfirstlane(tid >> 6);
    const int c16 = lane & 15, fq = lane >> 4;
    const int sch = tid & 63, sdir = wave >> 2, sp0 = 16 * (wave & 3);
    const int dir = wave >> 2, cth = (wave >> 1) & 1, thalf = wave & 1;
    const int ic4 = tid & 7, ipos = tid >> 3, ihalf = ipos >> 5;
    for (int u = blk; u < NBATCH * 16; u += nblk) {
        const int b = u >> 4, kb = (u >> 1) & 7, chalf = u & 1;
        const bf16_t* XRb = XR + (size_t)b * SEQ * 512; const bf16_t* GGb = GG + (size_t)b * SEQ * 512; float* H1b = H1 + (size_t)b * SEQ * 512; bf16_t* MIXb = MIX + (size_t)b * SEQ * 1024;
        const int schg = kb * 64 + sch;
        float k0, k1, k2, k3; const float cbias = a.in[9][schg];
        { const float w0 = a.in[8][0 * 512 + schg], w1 = a.in[8][1 * 512 + schg], w2 = a.in[8][2 * 512 + schg], w3 = a.in[8][3 * 512 + schg];
          if (sdir == 0) { k0 = w0; k1 = w1; k2 = w2; k3 = w3; } else { k0 = w3; k1 = w2; k2 = w1; k3 = w0; } }
        const int chl = chalf * 32 + cth * 16 + c16, chg = kb * 64 + chl;
        bf16x8 wrf[2], wif[2]; float brs, bis, kA2;
        { const float* wrp = a.in[10] + (size_t)(dir * 8 + kb) * 4096 + chl; const float* wip = a.in[12] + (size_t)(dir * 8 + kb) * 4096 + chl;
          constexpr float NL2E = -1.4426950408889634f;
#pragma unroll
          for (int ks = 0; ks < 2; ++ks) { u32x4 pr, pi;
              const int kk = 32 * ks + 8 * fq;
              pr.x = pk2(wrp[(kk + 0) * 64] * NL2E, wrp[(kk + 1) * 64] * NL2E); pr.y = pk2(wrp[(kk + 2) * 64] * NL2E, wrp[(kk + 3) * 64] * NL2E);
              pr.z = pk2(wrp[(kk + 4) * 64] * NL2E, wrp[(kk + 5) * 64] * NL2E); pr.w = pk2(wrp[(kk + 6) * 64] * NL2E, wrp[(kk + 7) * 64] * NL2E);
              pi.x = pk2(wip[(kk + 0) * 64] * NL2E, wip[(kk + 1) * 64] * NL2E); pi.y = pk2(wip[(kk + 2) * 64] * NL2E, wip[(kk + 3) * 64] * NL2E);
              pi.z = pk2(wip[(kk + 4) * 64] * NL2E, wip[(kk + 5) * 64] * NL2E); pi.w = pk2(wip[(kk + 6) * 64] * NL2E, wip[(kk + 7) * 64] * NL2E);
              wrf[ks] = __builtin_bit_cast(bf16x8, pr); wif[ks] = __builtin_bit_cast(bf16x8, pi); }
          brs = a.in[11][dir * 512 + chg] * NL2E; bis = a.in[13][dir * 512 + chg] * NL2E;
          const float nl = -a.in[14][dir * 512 + chg];
          const float sp = (nl > 15.f) ? nl : log1pf(expf(nl));
          kA2 = -8.0f * sp * 1.4426950408889634f;
        }
        unsigned short er0[19], er1[19];
        auto stage_ld = [&](int st, unsigned short (&er)[19]) {
            const int t0 = (sdir == 0) ? 64 * st : 64 * (63 - st);
            const int tk0 = (sdir == 0) ? (t0 + sp0) : (t0 + 63 - sp0);
            const int sgn = (sdir == 0) ? 1 : -1, tbase = (sdir == 0) ? tk0 - 2 : tk0 + 1;
#pragma unroll
            for (int i = 0; i < 19; ++i) { const int t = tbase + sgn * i; er[i] = XRb[(long)(t * 512 + schg)]; }
        };
        auto stage_wr = [&](int st, const unsigned short (&er)[19]) {
            const int stc = st < 64 ? st : 63;
            const int t0 = (sdir == 0) ? 64 * stc : 64 * (63 - stc);
            const int tk0 = (sdir == 0) ? (t0 + sp0) : (t0 + 63 - sp0);
            const int sgn = (sdir == 0) ? 1 : -1, tbase = (sdir == 0) ? tk0 - 2 : tk0 + 1;
            float e[19];
            if (stc == 0 || stc == 63) {
#pragma unroll
                for (int i = 0; i < 19; ++i) { const int t = tbase + sgn * i; e[i] = (t >= 0 && t < SEQ) ? bf2f(er[i]) : 0.f; }
            } else {
#pragma unroll
                for (int i = 0; i < 19; ++i) e[i] = bf2f(er[i]);
            }
            LAS float* xd = xcf + ((st & 1) * 2 + sdir) * 64 * LRU_XS + sp0 * LRU_XS + sch;
#pragma unroll
            for (int q = 0; q < 16; ++q) xd[q * LRU_XS] = cbias + k0 * e[q] + k1 * e[q + 1] + k2 * e[q + 2] + k3 * e[q + 3];
        };
        const int ichg = kb * 64 + chalf * 32 + 4 * ic4;
        f32x4 hoth0[2], hoth1[2]; u32x2 ggv0[2], ggv1[2];
        f32x4 cry[2]; cry[0] = (f32x4){0.f, 0.f, 0.f, 0.f}; cry[1] = cry[0];
        auto io_ld = [&](int st, f32x4 (&hoth)[2], u32x2 (&ggv)[2]) {
#pragma unroll
            for (int d = 0; d < 2; ++d) { const int tok = (d == 0) ? 64 * st + ipos : 64 * (63 - st) + 63 - ipos;
                hoth[d] = *(const f32x4*)(H1b + (unsigned)(tok * 512 + ichg)); ggv[d] = *(const u32x2*)(GGb + (unsigned)(tok * 512 + ichg)); }
        };
        auto io_out = [&](int st, const f32x4 (&hoth)[2], const u32x2 (&ggv)[2]) {
#pragma unroll
            for (int d = 0; d < 2; ++d) { const int tok = (d == 0) ? 64 * st + ipos : 64 * (63 - st) + 63 - ipos;
                const u32x4 pl = *(const LAS u32x4*)(plm + ((st & 1) * 2 + d) * 64 * LRU_HS + ipos * LRU_HS + 4 * ic4);
                const LAS float* cp = cmp + (((st & 1) * 2 + d) * 2) * 64 + 8 * ic4;
                const f32x4 c0a = *(const LAS f32x4*)cp, c0b = *(const LAS f32x4*)(cp + 4), c1a = *(const LAS f32x4*)(cp + 64), c1b = *(const LAS f32x4*)(cp + 68);
                const f32x4 A0 = (f32x4){c0a.x, c0a.z, c0b.x, c0b.z}, H0 = (f32x4){c0a.y, c0a.w, c0b.y, c0b.w}, A1 = (f32x4){c1a.x, c1a.z, c1b.x, c1b.z}, Hh1 = (f32x4){c1a.y, c1a.w, c1b.y, c1b.w};
                const f32x4 cmid = A0 * cry[d] + H0;
                const f32x4 cin = ihalf ? cmid : cry[d];
                cry[d] = A1 * cmid + Hh1;
                f32x4 P, L;
                P.x = __builtin_bit_cast(float, pl.x << 16); L.x = __builtin_bit_cast(float, pl.x & 0xffff0000u); P.y = __builtin_bit_cast(float, pl.y << 16); L.y = __builtin_bit_cast(float, pl.y & 0xffff0000u);
                P.z = __builtin_bit_cast(float, pl.z << 16); L.z = __builtin_bit_cast(float, pl.z & 0xffff0000u); P.w = __builtin_bit_cast(float, pl.w << 16); L.w = __builtin_bit_cast(float, pl.w & 0xffff0000u);
                const f32x4 h = P * cin + L;
                if (st < 32) *(f32x4*)(H1b + (unsigned)(tok * 512 + ichg)) = h;
                else { f32x4 g; g.x = __builtin_bit_cast(float, ggv[d].x << 16); g.y = __builtin_bit_cast(float, ggv[d].x & 0xffff0000u); g.z = __builtin_bit_cast(float, ggv[d].y << 16); g.w = __builtin_bit_cast(float, ggv[d].y & 0xffff0000u);
                    store_bf16x4(MIXb + (unsigned)(tok * 1024 + 512 + ichg), (h + hoth[d]) * g); } }
        };
        auto body = [&](int s, bool second, unsigned short (&er)[19], f32x4 (&hoth)[2], u32x2 (&ggv)[2]) {
            stage_wr(s + 1, er);
            stage_ld(s + 3 < 64 ? s + 3 : 63, er);
            if (s < 64) {
                const LAS float* xb = xcf + ((s & 1) * 2 + dir) * 64 * LRU_XS;
                LAS unsigned* pb = plm + ((s & 1) * 2 + dir) * 64 * LRU_HS + cth * 16 + c16;
                float TA1 = 1.f, TH1 = 0.f;
#pragma unroll
                for (int t2 = 0; t2 < 2; ++t2) { const int tt = 2 * thalf + t2;
                    f32x4 ra = (f32x4){0.f, 0.f, 0.f, 0.f}, ia = (f32x4){0.f, 0.f, 0.f, 0.f};
#pragma unroll
                    for (int ks = 0; ks < 2; ++ks) { const LAS f32x4* xp = (const LAS f32x4*)(xb + (16 * tt + c16) * LRU_XS + 32 * ks + 8 * fq);
                        const f32x4 x0 = xp[0], x1 = xp[1]; u32x4 pa; pa.x = pk2(x0.x, x0.y); pa.y = pk2(x0.z, x0.w); pa.z = pk2(x1.x, x1.y); pa.w = pk2(x1.z, x1.w);
                        const bf16x8 af = __builtin_bit_cast(bf16x8, pa);
                        ra = __builtin_amdgcn_mfma_f32_16x16x32_bf16(af, wrf[ks], ra, 0, 0, 0);
                        ia = __builtin_amdgcn_mfma_f32_16x16x32_bf16(af, wif[ks], ia, 0, 0, 0); }
                    float Ap[4], Hp[4];
#pragma unroll
                    for (int j = 0; j < 4; ++j) { const float xv = xb[(16 * tt + 4 * fq + j) * LRU_XS + chl];
                        const float r = __builtin_amdgcn_rcpf(1.0f + __builtin_amdgcn_exp2f(ra[j] + brs));
                        const float ig = __builtin_amdgcn_rcpf(1.0f + __builtin_amdgcn_exp2f(ia[j] + bis));
                        const float aa = __builtin_amdgcn_exp2f(kA2 * r);
                        const float uv = __builtin_amdgcn_sqrtf(fmaxf(1.0f - aa * aa, 0.f)) * (ig * xv);
                        if (j == 0) { Ap[0] = aa; Hp[0] = uv; } else { Ap[j] = aa * Ap[j - 1]; Hp[j] = fmaf(aa, Hp[j - 1], uv); } }
                    float Ag = Ap[3], Hg = Hp[3];
                    { const float A1 = __shfl_up(Ag, 16), Hs1 = __shfl_up(Hg, 16); if (fq >= 1) { Hg = fmaf(Ag, Hs1, Hg); Ag = Ag * A1; } }
                    { const float A2 = __shfl_up(Ag, 32), Hs2 = __shfl_up(Hg, 32); if (fq >= 2) { Hg = fmaf(Ag, Hs2, Hg); Ag = Ag * A2; } }
                    float EA = __shfl_up(Ag, 16), EH = __shfl_up(Hg, 16); if (fq == 0) { EA = 1.f; EH = 0.f; }
                    const float TA = __shfl(Ag, 48 + c16), TH = __shfl(Hg, 48 + c16);
#pragma unroll
                    for (int j = 0; j < 4; ++j) { const float Pt = Ap[j] * EA, Lt = fmaf(Ap[j], EH, Hp[j]);
                        const float Ph = Pt * TA1, Lh = fmaf(Pt, TH1, Lt);
                        pb[(16 * tt + 4 * fq + j) * LRU_HS] = pk2(Ph, Lh); }
                    if (t2 == 0) { TA1 = TA; TH1 = TH; }
                    else if (fq == 0) { LAS float* cw = cmp + ((((s & 1) * 2 + dir) * 2 + thalf) * 32 + cth * 16 + c16) * 2; cw[0] = TA * TA1; cw[1] = fmaf(TA, TH1, TH); }
                }
            }
            if (s >= 1) io_out(s - 1, hoth, ggv);
            if (second) io_ld(s + 1 < 64 ? s + 1 : 63, hoth, ggv);
            __syncthreads();
        };
        __syncthreads();
        stage_ld(0, er0); stage_wr(0, er0); stage_ld(1, er1); stage_ld(2, er0);
        __syncthreads();
        body(0, false, er1, hoth1, ggv1);
        for (int s = 1; s <= 31; s += 2) { body(s, false, er0, hoth0, ggv0); body(s + 1, false, er1, hoth1, ggv1); }
        io_ld(32, hoth0, ggv0); io_ld(33, hoth1, ggv1);
        for (int s = 33; s <= 63; s += 2) { body(s, true, er0, hoth0, ggv0); body(s + 1, true, er1, hoth1, ggv1); }
    }
}

struct EpiOutProj {
    static constexpr bool PERM = true;
    const float* x; bf16_t* X1;
    __device__ __forceinline__ void operator()(const f32x4 (&acc)[2][2][4][2], const pg8::Unit& u, int wr, int wc, int fr, int fq) const {
        const int row0 = u.pm * 256 + wr * 64 + fr, col0 = u.pn * 256 + wc * 32 + 8 * fq;
#pragma unroll
        for (int ai = 0; ai < 2; ++ai)
#pragma unroll
            for (int m = 0; m < 4; ++m) { const size_t rowoff = (size_t)(row0 + ai * 128 + m * 16) * DM + col0;
#pragma unroll
                for (int bj = 0; bj < 2; ++bj) { const size_t off = rowoff + bj * 128;
                    const f32x4 v0 = *(const f32x4*)(x + off) + acc[ai][bj][m][0], v1 = *(const f32x4*)(x + off + 4) + acc[ai][bj][m][1];
                    u32x4 w; w.x = pk2(v0.x, v0.y); w.y = pk2(v0.z, v0.w); w.z = pk2(v1.x, v1.y); w.w = pk2(v1.z, v1.w);
                    *(u32x4*)(X1 + off) = w; } }
    }
};
__device__ __forceinline__ void phase3(const Args& a, LAS unsigned char* lds, int nblk, int blk) {
    unsigned char* ws = a.ws;
    pg8::DenseOrder S; S.init(ws + WS_MIX, ws + WS_WOUT, MTOK, DM, DM, nblk, blk);
    EpiOutProj E{a.in[0], (bf16_t*)(ws + WS_X1)};
    pg8::gemm_phase(lds, DM, S, E);
}

template <bool DUMMY> __device__ __forceinline__ void phase4(const Args& a, LAS unsigned char* lds, int nblk, int blk) {
    unsigned char* ws = a.ws;
    const bf16_t* X1 = (const bf16_t*)(ws + WS_X1); const float* g2 = a.in[16]; bf16_t* H2 = (bf16_t*)(ws + WS_XN);
    const bf16_t* WRH = (const bf16_t*)(ws + WS_WRH); const bf16_t* WRL = (const bf16_t*)(ws + WS_WRL);
    int* cnt = (int*)(ws + WS_CTL); int* LIST = (int*)(ws + WS_LIST); float* EW = (float*)(ws + WS_EW);
    LAS float* part = (LAS float*)lds;
    LAS float* tot = part + 8 * 16 * 52;
    LAS float* rs = tot + 16 * 52;
    const int tid = threadIdx.x, lane = tid & 63, wave = __builtin_amdgcn_readfirstlane(tid >> 6), r16 = lane & 15, kg = lane >> 4;
    const int kbase = 128 * wave + 8 * kg;
    bf16x8 bh[4][3], bl[4][3];
#pragma unroll
    for (int ks = 0; ks < 4; ++ks)
#pragma unroll
        for (int nt = 0; nt < 3; ++nt) { bh[ks][nt] = *(const bf16x8*)(WRH + (size_t)(16 * nt + r16) * DM + kbase + 32 * ks); bl[ks][nt] = *(const bf16x8*)(WRL + (size_t)(16 * nt + r16) * DM + kbase + 32 * ks); }
    constexpr int NTILE = MTOK / 16;
    LAS float* lg = rs + 16;
    LAS int* lcnt = (LAS int*)(lg + 8 * 16 * 36); LAS int* lbase = lcnt + 32;
    if (tid < NEXP) lcnt[tid] = 0;
    u32x4 xn[4];
    { const int t0 = blk; if (t0 < NTILE) {
#pragma unroll
        for (int ks = 0; ks < 4; ++ks) xn[ks] = *(const u32x4*)(X1 + (size_t)(t0 * 16 + r16) * DM + kbase + 32 * ks); } }
    int ti = 0;
    for (int t = blk; t < NTILE; t += nblk, ++ti) {
        u32x4 xv[4];
#pragma unroll
        for (int ks = 0; ks < 4; ++ks) xv[ks] = xn[ks];
        { const int tn = (t + nblk < NTILE) ? t + nblk : t;
#pragma unroll
          for (int ks = 0; ks < 4; ++ks) xn[ks] = *(const u32x4*)(X1 + (size_t)(tn * 16 + r16) * DM + kbase + 32 * ks); }
        f32x4 acc[3]; acc[0] = (f32x4){0.f, 0.f, 0.f, 0.f}; acc[1] = acc[0]; acc[2] = acc[0];
        float ss = 0.f;
#pragma unroll
        for (int ks = 0; ks < 4; ++ks) { const u32x4 xw = xv[ks];
            const float f0 = __builtin_bit_cast(float, xw.x << 16), f1 = __builtin_bit_cast(float, xw.x & 0xffff0000u), f2 = __builtin_bit_cast(float, xw.y << 16), f3 = __builtin_bit_cast(float, xw.y & 0xffff0000u);
            const float f4 = __builtin_bit_cast(float, xw.z << 16), f5 = __builtin_bit_cast(float, xw.z & 0xffff0000u), f6 = __builtin_bit_cast(float, xw.w << 16), f7 = __builtin_bit_cast(float, xw.w & 0xffff0000u);
            ss += (f0 * f0 + f1 * f1) + (f2 * f2 + f3 * f3) + (f4 * f4 + f5 * f5) + (f6 * f6 + f7 * f7);
            const bf16x8 ah = __builtin_bit_cast(bf16x8, xw);
#pragma unroll
            for (int nt = 0; nt < 3; ++nt) {
                acc[nt] = __builtin_amdgcn_mfma_f32_16x16x32_bf16(ah, bh[ks][nt], acc[nt], 0, 0, 0);
                acc[nt] = __builtin_amdgcn_mfma_f32_16x16x32_bf16(ah, bl[ks][nt], acc[nt], 0, 0, 0); } }
        ss += __shfl_xor(ss, 16); ss += __shfl_xor(ss, 32);
#pragma unroll
        for (int nt = 0; nt < 3; ++nt)
#pragma unroll
            for (int j = 0; j < 4; ++j) part[(wave * 16 + 4 * kg + j) * 52 + 16 * nt + r16] = acc[nt][j];
        if (kg == 0) part[(wave * 16 + r16) * 52 + 48] = ss;
        __syncthreads();
        for (int idx = tid; idx < 16 * 49; idx += NTHREADS) { const int row = idx / 49, o = idx % 49; float s = 0.f;
#pragma unroll
            for (int w = 0; w < 8; ++w) s += part[(w * 16 + row) * 52 + o];
            tot[row * 52 + o] = s; }
        __syncthreads();
        { const float rstd = 1.0f / sqrtf(tot[r16 * 52 + 48] * (1.0f / DM) + EPS);
#pragma unroll
          for (int ks = 0; ks < 4; ++ks) { const f32x4* gp4 = (const f32x4*)(g2 + kbase + 32 * ks); const f32x4 ga = gp4[0], gb = gp4[1]; const u32x4 xw = xv[ks];
              u32x4 w;
              w.x = pk2(__builtin_bit_cast(float, xw.x << 16) * rstd * ga.x, __builtin_bit_cast(float, xw.x & 0xffff0000u) * rstd * ga.y);
              w.y = pk2(__builtin_bit_cast(float, xw.y << 16) * rstd * ga.z, __builtin_bit_cast(float, xw.y & 0xffff0000u) * rstd * ga.w);
              w.z = pk2(__builtin_bit_cast(float, xw.z << 16) * rstd * gb.x, __builtin_bit_cast(float, xw.z & 0xffff0000u) * rstd * gb.y);
              w.w = pk2(__builtin_bit_cast(float, xw.w << 16) * rstd * gb.z, __builtin_bit_cast(float, xw.w & 0xffff0000u) * rstd * gb.w);
              *(u32x4*)(H2 + (size_t)(t * 16 + r16) * DM + kbase + 32 * ks) = w; } }
        for (int idx = tid; idx < 16 * 36; idx += NTHREADS) { const int row = idx / 36, o = idx % 36;
            const float rstd = 1.0f / sqrtf(tot[row * 52 + 48] * (1.0f / DM) + EPS);
            lg[((ti & 7) * 16 + row) * 36 + o] = tot[row * 52 + o] * rstd; }
        const bool lastt = (t + nblk >= NTILE);
        if ((ti & 7) == 7 || lastt) {
            __syncthreads();
            const int nch = (ti & 7) + 1;
            int ea = 0, eb = 0, ra = 0, rb = 0, rowg = 0; float w1 = 0.f, w2 = 0.f;
            const bool act = !DUMMY && tid < nch * 16;
            if (act) {
                const int ci = tid >> 4, row16 = tid & 15;
                const LAS float* tr = lg + (ci * 16 + row16) * 36;
                const float g0 = tr[0], g1 = tr[1], g2l = tr[2], g3 = tr[3];
                int gi = 0; float gm = g0;
                if (g1 > gm) { gm = g1; gi = 1; } if (g2l > gm) { gm = g2l; gi = 2; } if (g3 > gm) { gm = g3; gi = 3; }
                const float gp = 1.0f / (expf(g0 - gm) + expf(g1 - gm) + expf(g2l - gm) + expf(g3 - gm));
                const LAS float* ep = tr + 4 + gi * 8;
                int i1 = 0; float l1 = ep[0];
                for (int j = 1; j < 8; ++j) { const float v = ep[j]; if (v > l1) { l1 = v; i1 = j; } }
                int i2 = -1; float l2 = -3.0e38f;
                for (int j = 0; j < 8; ++j) { const float v = ep[j]; if (j != i1 && v > l2) { l2 = v; i2 = j; } }
                const float e2 = expf(l2 - l1); w1 = gp / (1.0f + e2); w2 = gp * e2 / (1.0f + e2);
                const int tile = t - (nch - 1 - ci) * nblk;
                rowg = tile * 16 + row16; ea = gi * 8 + i1; eb = gi * 8 + i2;
                ra = __hip_atomic_fetch_add((int*)(lcnt + ea), 1, __ATOMIC_RELAXED, __HIP_MEMORY_SCOPE_WORKGROUP); rb = __hip_atomic_fetch_add((int*)(lcnt + eb), 1, __ATOMIC_RELAXED, __HIP_MEMORY_SCOPE_WORKGROUP);
            }
            __syncthreads();
            if (tid < NEXP) { const int n = lcnt[tid]; lbase[tid] = (n > 0) ? atomicAdd(&cnt[tid * 64], n) : 0; lcnt[tid] = 0; }
            __syncthreads();
            if (act) {
                LIST[(size_t)ea * MTOK + lbase[ea] + ra] = rowg * 2 + 0; EW[rowg * 2 + 0] = w1;
                LIST[(size_t)eb * MTOK + lbase[eb] + rb] = rowg * 2 + 1; EW[rowg * 2 + 1] = w2;
            }
            __syncthreads();
        }
    }
}

constexpr int MOE_TAB_OFF = 131072;
constexpr int MOE_MAXT = 320;
__device__ __forceinline__ int moe_build_table(const int* cnt, LAS int* tab) {
    __syncthreads();
    if (threadIdx.x == 0) { int nt = 0, seg = 0;
        for (int e = 0; e < NEXP; ++e) { const int n = cnt[e * 64], mt = (n + 255) >> 8;
            for (int m = 0; m < mt; ++m) { tab[3 * nt] = e | (m << 8); tab[3 * nt + 1] = seg + m * 256; tab[3 * nt + 2] = (n - m * 256) < 256 ? (n - m * 256) : 256; ++nt; }
            seg += mt * 256; }
        tab[3 * MOE_MAXT] = nt; }
    __syncthreads();
    return tab[3 * MOE_MAXT];
}
struct MoeOrder1 {
    const char* H2; const char* W; const int* LIST; LAS const int* tab; int nunits, G, c;
    __device__ __forceinline__ bool next(int i, pg8::Unit& u) const {
        const int L = i * G + c; if (L >= nunits) return false;
        const int t = L >> 1; const int em = tab[3 * t]; u.e = em & 255; u.pm = em >> 8; u.pn = L & 1; u.seg = tab[3 * t + 1]; u.nrows = tab[3 * t + 2];
        u.A = H2; u.B = W + ((size_t)(u.e * 512 + u.pn * 256) * DM) * 2; return true;
    }
    __device__ __forceinline__ unsigned a_row(const pg8::Unit& u, int r, int K_) const { const int tok = (r < u.nrows) ? (LIST[(size_t)u.e * MTOK + u.pm * 256 + r] >> 1) : 0; return (unsigned)(tok * K_) * 2u; }
};
struct EpiMoe1 {
    static constexpr bool PERM = true;
    bf16_t* HID;
    __device__ __forceinline__ void operator()(const f32x4 (&acc)[2][2][4][2], const pg8::Unit& u, int wr, int wc, int fr, int fq) const {
        const int col0 = u.pn * 128 + wc * 32 + 8 * fq;
#pragma unroll
        for (int ai = 0; ai < 2; ++ai)
#pragma unroll
            for (int m = 0; m < 4; ++m) { const int r = ai * 128 + wr * 64 + m * 16 + fr;
                const f32x4 g0 = acc[ai][0][m][0], g1 = acc[ai][0][m][1], u0 = acc[ai][1][m][0], u1 = acc[ai][1][m][1];
                f32x4 h0, h1;
                h0.x = g0.x * sigmoidf_(g0.x) * u0.x; h0.y = g0.y * sigmoidf_(g0.y) * u0.y; h0.z = g0.z * sigmoidf_(g0.z) * u0.z; h0.w = g0.w * sigmoidf_(g0.w) * u0.w;
                h1.x = g1.x * sigmoidf_(g1.x) * u1.x; h1.y = g1.y * sigmoidf_(g1.y) * u1.y; h1.z = g1.z * sigmoidf_(g1.z) * u1.z; h1.w = g1.w * sigmoidf_(g1.w) * u1.w;
                u32x4 w; w.x = pk2(h0.x, h0.y); w.y = pk2(h0.z, h0.w); w.z = pk2(h1.x, h1.y); w.w = pk2(h1.z, h1.w);
                *(u32x4*)(HID + (size_t)(u.seg + r) * DEXP + col0) = w; }
    }
};
struct MoeOrder2 {
    const char* HID; const char* W; LAS const int* tab; int nunits, G, c;
    __device__ __forceinline__ bool next(int i, pg8::Unit& u) const {
        const int L = i * G + c; if (L >= nunits) return false;
        const int t = L >> 2; const int em = tab[3 * t]; u.e = em & 255; u.pm = em >> 8; u.pn = L & 3; u.seg = tab[3 * t + 1]; u.nrows = tab[3 * t + 2];
        u.A = HID + (size_t)u.seg * DEXP * 2; u.B = W + ((size_t)(u.e * DM + u.pn * 256) * DEXP) * 2; return true;
    }
    __device__ __forceinline__ unsigned a_row(const pg8::Unit&, int r, int K_) const { return (unsigned)(r * K_) * 2u; }
};
struct EpiMoe2 {
    static constexpr bool PERM = true;
    bf16_t* Y; const int* LIST;
    __device__ __forceinline__ void operator()(const f32x4 (&acc)[2][2][4][2], const pg8::Unit& u, int wr, int wc, int fr, int fq) const {
        const int col0 = u.pn * 256 + wc * 32 + 8 * fq;
        const int* lp = LIST + (size_t)u.e * MTOK + u.pm * 256;
        int dst[2][4];
#pragma unroll
        for (int ai = 0; ai < 2; ++ai)
#pragma unroll
            for (int m = 0; m < 4; ++m) { const int r = ai * 128 + wr * 64 + m * 16 + fr; dst[ai][m] = (r < u.nrows) ? lp[r] : -1; }
#pragma unroll
        for (int ai = 0; ai < 2; ++ai)
#pragma unroll
            for (int m = 0; m < 4; ++m) {
                if (dst[ai][m] >= 0) {
#pragma unroll
                    for (int bj = 0; bj < 2; ++bj) { const f32x4 v0 = acc[ai][bj][m][0], v1 = acc[ai][bj][m][1];
                        u32x4 w; w.x = pk2(v0.x, v0.y); w.y = pk2(v0.z, v0.w); w.z = pk2(v1.x, v1.y); w.w = pk2(v1.z, v1.w);
                        *(u32x4*)(Y + ((unsigned)dst[ai][m] * (unsigned)DM + (unsigned)(col0 + bj * 128))) = w; } } }
    }
};
__device__ __forceinline__ void phase5(const Args& a, LAS unsigned char* lds, int nblk, int blk) {
    unsigned char* ws = a.ws;
    LAS int* tab = (LAS int*)(lds + MOE_TAB_OFF);
    const int nt = moe_build_table((const int*)(ws + WS_CTL), tab);
    const int vcu = (nblk % 8 == 0) ? (blk % 8) * (nblk / 8) + blk / 8 : blk;
    MoeOrder1 S{(const char*)(ws + WS_XN), (const char*)(ws + WS_WGU), (const int*)(ws + WS_LIST), tab, nt * 2, nblk, vcu};
    EpiMoe1 E{(bf16_t*)(ws + WS_HID)};
    pg8::gemm_phase(lds, DM, S, E);
}
__device__ __forceinline__ void phase6(const Args& a, LAS unsigned char* lds, int nblk, int blk) {
    unsigned char* ws = a.ws;
    LAS int* tab = (LAS int*)(lds + MOE_TAB_OFF);
    const int nt = moe_build_table((const int*)(ws + WS_CTL), tab);
    const int vcu = (nblk % 8 == 0) ? (blk % 8) * (nblk / 8) + blk / 8 : blk;
    MoeOrder2 S{(const char*)(ws + WS_HID), (const char*)(ws + WS_WD), tab, nt * 4, nblk, vcu};
    EpiMoe2 E{(bf16_t*)(ws + WS_Y), (const int*)(ws + WS_LIST)};
    pg8::gemm_phase(lds, DEXP, S, E);
}

template <bool DUMMY> __device__ __forceinline__ void phase7(const Args& a, int lane, int gw, int NGW) {
    unsigned char* ws = a.ws;
    float* out = a.out; const bf16_t* X1 = (const bf16_t*)(ws + WS_X1); const bf16_t* Y = (const bf16_t*)(ws + WS_Y); const float* EW = (const float*)(ws + WS_EW); const float* gf = a.in[22];
    f32x4 gv[4];
#pragma unroll
    for (int j = 0; j < 4; ++j) gv[j] = ((const f32x4*)gf)[lane + 64 * j];
    u32x2 xn[4]; u32x2 y0n[4], y1n[4]; float w0n, w1n;
    auto ld = [&](int m) {
        const u32x2* xr = (const u32x2*)(X1 + (size_t)m * DM) + lane;
        const u32x2* y0 = (const u32x2*)(Y + (size_t)(2 * m) * DM) + lane; const u32x2* y1 = (const u32x2*)(Y + (size_t)(2 * m + 1) * DM) + lane;
#pragma unroll
        for (int j = 0; j < 4; ++j) { xn[j] = xr[64 * j]; y0n[j] = y0[64 * j]; y1n[j] = y1[64 * j]; }
        w0n = EW[2 * m]; w1n = EW[2 * m + 1];
    };
    if (gw < MTOK) ld(gw);
    for (int m = gw; m < MTOK; m += NGW) {
        f32x4 xv[4]; u32x2 a0[4], a1[4];
#pragma unroll
        for (int j = 0; j < 4; ++j) { xv[j].x = __builtin_bit_cast(float, xn[j].x << 16); xv[j].y = __builtin_bit_cast(float, xn[j].x & 0xffff0000u); xv[j].z = __builtin_bit_cast(float, xn[j].y << 16); xv[j].w = __builtin_bit_cast(float, xn[j].y & 0xffff0000u); a0[j] = y0n[j]; a1[j] = y1n[j]; }
        const float w0 = w0n, w1 = w1n;
        ld(m + NGW < MTOK ? m + NGW : m);
        f32x4 v[4]; float s = 0.f;
#pragma unroll
        for (int j = 0; j < 4; ++j) { f32x4 t;
            t.x = xv[j].x + w0 * __builtin_bit_cast(float, a0[j].x << 16) + w1 * __builtin_bit_cast(float, a1[j].x << 16);
            t.y = xv[j].y + w0 * __builtin_bit_cast(float, a0[j].x & 0xffff0000u) + w1 * __builtin_bit_cast(float, a1[j].x & 0xffff0000u);
            t.z = xv[j].z + w0 * __builtin_bit_cast(float, a0[j].y << 16) + w1 * __builtin_bit_cast(float, a1[j].y << 16);
            t.w = xv[j].w + w0 * __builtin_bit_cast(float, a0[j].y & 0xffff0000u) + w1 * __builtin_bit_cast(float, a1[j].y & 0xffff0000u);
            v[j] = t; s += (t.x * t.x + t.y * t.y) + (t.z * t.z + t.w * t.w); }
        s = wave_sum(s);
        const float rstd = 1.0f / sqrtf(s * (1.0f / DM) + EPS);
        f32x4* o = (f32x4*)(out + (size_t)m * DM) + lane;
#pragma unroll
        for (int j = 0; j < 4; ++j) { if (!DUMMY || rstd == 123.4567f) o[64 * j] = v[j] * rstd * gv[j]; }
    }
}

#define XB_TMO      128
#define XB_XCNT(j)  (256  + 64 * (j))
#define XB_XSUB(j)  (1280 + 64 * (j))
#define XB_XGEN(j)  (2304 + 64 * (j))
#define XB_TOP      3328
#define XB_TOPGEN   3392
#define XCD_BAR_WORDS 3456
#define XB_SPIN_CAP (1u << 22)
__device__ __forceinline__ unsigned xb_ld(unsigned* p)              { return __hip_atomic_load(p, __ATOMIC_RELAXED, __HIP_MEMORY_SCOPE_AGENT); }
__device__ __forceinline__ unsigned xb_add(unsigned* p, unsigned v) { return __hip_atomic_fetch_add(p, v, __ATOMIC_RELAXED, __HIP_MEMORY_SCOPE_AGENT); }
__device__ __forceinline__ unsigned xb_xcc_id() { return (unsigned)__builtin_amdgcn_s_getreg((3 << 11) | 20) & 0xFu; }
#define XB_SPIN(cond, bar) do { unsigned _sp = 0; while (cond) { __builtin_amdgcn_s_sleep(1); \
    if ((++_sp & 255u) == 0u) { if (xb_ld(&(bar)[XB_TMO])) break; if (_sp > XB_SPIN_CAP) { atomicAdd(&(bar)[XB_TMO], 1u); break; } } } } while (0)
struct XcdBarrier { unsigned* bar; unsigned x; volatile LAS unsigned* st; };
__device__ __forceinline__ XcdBarrier xcd_barrier_post(unsigned* bar, volatile LAS unsigned* st) {
    XcdBarrier b; b.bar = bar; b.x = xb_xcc_id(); b.st = st;
    if (threadIdx.x == 0) (void)xb_add(&bar[XB_XCNT(b.x)], 1u);
    return b;
}
__device__ __forceinline__ void xcd_barrier_complete(unsigned* bar, unsigned x, unsigned& nloc, unsigned& nx) {
    const unsigned G = gridDim.x * gridDim.y * gridDim.z;
    unsigned sum, cnt, mine, sp = 0u;
    for (;;) {
        sum = 0u; cnt = 0u; mine = 0u;
#pragma unroll
        for (unsigned j = 0; j < 16; ++j) { const unsigned c = xb_ld(&bar[XB_XCNT(j)]); sum += c; cnt += (c > 0u) ? 1u : 0u; mine = (j == x) ? c : mine; }
        if (sum == G) break;
        __builtin_amdgcn_s_sleep(1);
        if ((++sp & 255u) == 0u) { if (xb_ld(&bar[XB_TMO])) break; if (sp > XB_SPIN_CAP) { atomicAdd(&bar[XB_TMO], 1u); break; } }
    }
    nloc = mine > 0u ? mine : 1u; nx = cnt > 0u ? cnt : 1u;
}
__device__ __forceinline__ void xcd_barrier(const XcdBarrier& b) {
    asm volatile("s_waitcnt vmcnt(0)" ::: "memory");
    __syncthreads();
    if (threadIdx.x == 0) {
        unsigned* bar = b.bar;
        __builtin_amdgcn_s_waitcnt(0);
        unsigned nloc = b.st[0], nx = b.st[1];
        if (nloc == 0u) { xcd_barrier_complete(bar, b.x, nloc, nx); b.st[0] = nloc; b.st[1] = nx; }
        const unsigned old = xb_add(&bar[XB_XSUB(b.x)], 1u);
        const unsigned gen = old / nloc;
        if (old + 1u == (gen + 1u) * nloc) {
            __builtin_amdgcn_fence(__ATOMIC_RELEASE, "agent");
            asm volatile("s_waitcnt vmcnt(0)" ::: "memory");
            const unsigned og = xb_add(&bar[XB_TOP], 1u);
            const unsigned tg = og / nx;
            if (og + 1u == (tg + 1u) * nx) xb_add(&bar[XB_TOPGEN], 1u);
            else XB_SPIN(xb_ld(&bar[XB_TOPGEN]) == tg, bar);
            __builtin_amdgcn_fence(__ATOMIC_ACQUIRE, "agent");
            xb_add(&bar[XB_XGEN(b.x)], 1u);
            asm volatile("s_waitcnt vmcnt(0)" ::: "memory");
        } else {
            XB_SPIN(xb_ld(&bar[XB_XGEN(b.x)]) == gen, bar);
            __builtin_amdgcn_fence(__ATOMIC_ACQUIRE, "agent");
            asm volatile("s_waitcnt vmcnt(0)" ::: "memory");
        }
    }
    __syncthreads();
}

__global__ void __launch_bounds__(NTHREADS, 2) mega_fwd(Args args) {
    extern __shared__ __attribute__((aligned(16))) unsigned char lds[];
    const int tid = threadIdx.x, lane = tid & 63, wave = __builtin_amdgcn_readfirstlane(tid >> 6);
    const int nblk = gridDim.x, blk = blockIdx.x;
    const int gw = blk * NWAVES + wave, NGW = nblk * NWAVES;
    const int lo = args.ph_lo, hi = args.ph_hi;
#define IN(k) (lo <= (k) && (k) < hi)
#if MK_CG_SYNC
#define SEAM(k) do { if (IN(k) && IN((k) + 1)) { cg::this_grid().sync(); } } while (0)
#else
    volatile LAS unsigned* bst = (volatile LAS unsigned*)((LAS unsigned char*)lds + LDS_BYTES - 64);
    if (tid == 0) { bst[0] = 0u; bst[1] = 0u; }
    __syncthreads();
    const XcdBarrier gbar = xcd_barrier_post((unsigned*)(args.ws + WS_CTL) + 4096, bst);
#define SEAM(k) do { if (IN(k) && IN((k) + 1)) { xcd_barrier(gbar); } } while (0)
#endif
    if (IN(0)) { phase0(args, (LAS unsigned char*)lds, tid, wave, lane, gw, NGW); if (PROBE_DUP == 0) phase0(args, (LAS unsigned char*)lds, tid, wave, lane, gw, NGW); }
    SEAM(0);
    if (IN(1)) { phase1(args, (LAS unsigned char*)lds, nblk, blk, 6, 1024); if (PROBE_DUP == 1) phase1(args, (LAS unsigned char*)lds, nblk, blk, 6, 1024); }
    SEAM(1);
    if (IN(2)) { const int nl = (nblk >= 256) ? 128 : nblk / 2, ng = nblk - nl;
        const bool probe_ = (hi != NPHASES);
        if (blk < ng) { if (!(probe_ && PROBE_P2_MODE == 1)) phase1(args, (LAS unsigned char*)lds, ng, blk, 0, 1536); }
        else { if (!(probe_ && PROBE_P2_MODE == 2)) phase2_lru(args, (LAS unsigned char*)lds, nl, blk - ng); } }
    SEAM(2);
    if (IN(3)) { phase2_attn<0>(args, (char*)lds, nblk, blk); if (PROBE_DUP == 3) phase2_attn<0>(args, (char*)lds, nblk, blk); }
    SEAM(3);
    if (IN(4)) { phase3(args, (LAS unsigned char*)lds, nblk, blk); if (PROBE_DUP == 4) phase3(args, (LAS unsigned char*)lds, nblk, blk); }
    SEAM(4);
    if (IN(5)) { phase4<false>(args, (LAS unsigned char*)lds, nblk, blk); if (PROBE_DUP == 5) phase4<true>(args, (LAS unsigned char*)lds, nblk, blk); }
    SEAM(5);
    if (IN(6)) { phase5(args, (LAS unsigned char*)lds, nblk, blk); if (PROBE_DUP == 6) phase5(args, (LAS unsigned char*)lds, nblk, blk); }
    SEAM(6);
    if (IN(7)) { phase6(args, (LAS unsigned char*)lds, nblk, blk); if (PROBE_DUP == 7) phase6(args, (LAS unsigned char*)lds, nblk, blk); }
    SEAM(7);
    if (IN(8)) { if (PROBE_DUP == 8) phase7<true>(args, lane, gw, NGW); phase7<false>(args, lane, gw, NGW); }
#undef IN
#undef SEAM
}

#if PROBE_ATT_VAR > 0
__global__ void __launch_bounds__(NTHREADS, 2) probe_attn(Args args) {
    extern __shared__ __attribute__((aligned(16))) unsigned char lds[];
    phase2_attn<PROBE_ATT_VAR>(args, (char*)lds, gridDim.x, blockIdx.x);
}
#endif
#if PROBE_VALU > 0
__global__ void __launch_bounds__(NTHREADS, 2) probe_valu(float* out, float seed) {
    float v[16];
#pragma unroll
    for (int i = 0; i < 16; ++i) v[i] = seed + (float)(threadIdx.x + i);
    f32x16 macc0 = f32x16{}, macc1 = f32x16{}; bf16x8 ma, mb;
#pragma unroll
    for (int i = 0; i < 8; ++i) { ma[i] = (short)(0x3F80 + threadIdx.x + i); mb[i] = (short)(0x3F00 + threadIdx.x * 3 + i); }
    for (int it = 0; it < 4096; ++it) {
#pragma unroll
        for (int i = 0; i < 16; ++i) {
#if PROBE_VALU == 1
            v[i] = fmaf(v[i], 1.0001f, 0.5f);
#elif PROBE_VALU == 2
            v[i] = __builtin_amdgcn_exp2f(v[i]);
#elif PROBE_VALU == 3
            v[i] = fmaxf(fmaxf(v[i], v[(i + 1) & 15]), seed);
#endif
        }
#if PROBE_VALU == 4 || PROBE_VALU == 5
        macc0 = __builtin_amdgcn_mfma_f32_32x32x16_bf16(ma, mb, macc0, 0, 0, 0);
#if PROBE_VALU == 4
        v[0] = fmaf(v[0], 1.0001f, 0.5f); v[1] = fmaf(v[1], 1.0001f, 0.5f); v[2] = fmaf(v[2], 1.0001f, 0.5f); v[3] = fmaf(v[3], 1.0001f, 0.5f); v[4] = fmaf(v[4], 1.0001f, 0.5f); v[5] = fmaf(v[5], 1.0001f, 0.5f);
#endif
        macc1 = __builtin_amdgcn_mfma_f32_32x32x16_bf16(ma, mb, macc1, 0, 0, 0);
#if PROBE_VALU == 4
        v[6] = fmaf(v[6], 1.0001f, 0.5f); v[7] = fmaf(v[7], 1.0001f, 0.5f); v[8] = fmaf(v[8], 1.0001f, 0.5f); v[9] = fmaf(v[9], 1.0001f, 0.5f); v[10] = fmaf(v[10], 1.0001f, 0.5f); v[11] = fmaf(v[11], 1.0001f, 0.5f);
#endif
#endif
        asm volatile("" : "+v"(v[0]), "+v"(v[1]), "+v"(v[2]), "+v"(v[3]), "+v"(v[4]), "+v"(v[5]), "+v"(v[6]), "+v"(v[7]));
    }
    float s = 0.f;
#pragma unroll
    for (int i = 0; i < 16; ++i) s += v[i] + macc0[i] + macc1[i];
    if (s == 123.456f) out[threadIdx.x] = s;
}
#endif
extern "C" void kernel_launch(void* const* d_in, const int* in_sizes, int n_in, void* d_out, int out_size, void* d_ws, size_t ws_size, hipStream_t stream) {
    static int grid = 0;
    if (grid == 0) {
        if (n_in != 23 || out_size != MTOK * DM || ws_size < WS_END) { fprintf(stderr, "kernel_launch: unexpected shapes (n_in %d out %d ws %zu)\n", n_in, out_size, ws_size); grid = -1; return; }
        int dev = 0, cus = 0, per_cu = 0;
        hipGetDevice(&dev);
        hipDeviceGetAttribute(&cus, hipDeviceAttributeMultiprocessorCount, dev);
        hipFuncSetAttribute((const void*)mega_fwd, hipFuncAttributeMaxDynamicSharedMemorySize, LDS_BYTES);
        hipOccupancyMaxActiveBlocksPerMultiprocessor(&per_cu, (const void*)mega_fwd, NTHREADS, LDS_BYTES);
        if (per_cu < 1) per_cu = 1;
        if (per_cu > 1) per_cu = 1;
        grid = cus * per_cu;
        (void)hipGetLastError();
    }
    if (grid < 0) return;
    (void)hipMemsetAsync((char*)d_ws + WS_CTL, 0, 65536, stream);
    Args a{};
    for (int i = 0; i < 23; ++i) a.in[i] = (const float*)d_in[i];
    a.out = (float*)d_out; a.ws = (unsigned char*)d_ws;
#if MK_N_LAUNCHES == 1
#if PROBE_VALU > 0
    hipLaunchKernelGGL(probe_valu, dim3(grid), dim3(NTHREADS), 0, stream, (float*)((char*)d_ws + WS_O0), 1.0f);
#endif
#if PROBE_PREFIX > 0
    { a.ph_lo = 0; a.ph_hi = PROBE_PREFIX; void* kargs0[] = {&a};
      (void)hipLaunchCooperativeKernel((const void*)mega_fwd, dim3(grid), dim3(NTHREADS), kargs0, LDS_BYTES, stream);
      (void)hipMemsetAsync((char*)d_ws + WS_CTL, 0, 65536, stream); }
#if PROBE_ATT_VAR > 0
    { (void)hipFuncSetAttribute((const void*)probe_attn, hipFuncAttributeMaxDynamicSharedMemorySize, LDS_BYTES); hipLaunchKernelGGL(probe_attn, dim3(grid), dim3(PROBE_ATT_THREADS), LDS_BYTES, stream, a); }
#endif
#endif
    a.ph_lo = 0; a.ph_hi = NPHASES;
    void* kargs[] = {&a};
    hipError_t e = hipLaunchCooperativeKernel((const void*)mega_fwd, dim3(grid), dim3(NTHREADS), kargs, LDS_BYTES, stream);
    if (e != hipSuccess) fprintf(stderr, "cooperative launch failed: %s (grid %d)\n", hipGetErrorString(e), grid);
#else
    for (int p = 0; p < NPHASES; ++p) {
        a.ph_lo = p; a.ph_hi = p + 1;
        hipLaunchKernelGGL(mega_fwd, dim3(grid), dim3(NTHREADS), LDS_BYTES, stream, a);
    }
#endif
}
```

```cpp
#include <hip/hip_runtime.h>
#include <hip/hip_cooperative_groups.h>
#include <hip/hip_bf16.h>
#include <cstdint>
#include <cstdio>
namespace cg = cooperative_groups;

#ifndef PROBE_DUP
#define PROBE_DUP -1
#endif
#ifndef PROBE_PREFIX
#define PROBE_PREFIX 0
#endif
#ifndef PROBE_P2_MODE
#define PROBE_P2_MODE 0
#endif
#ifndef PROBE_LRU_ABL
#define PROBE_LRU_ABL 0
#endif
#ifndef PROBE_VALU
#define PROBE_VALU 0
#endif
#ifndef PROBE_ATT_THREADS
#define PROBE_ATT_THREADS 512
#endif
#ifndef PROBE_ATT_VAR
#define PROBE_ATT_VAR 0
#endif
#ifndef MK_CG_SYNC
#define MK_CG_SYNC 0
#endif
#ifndef MK_N_LAUNCHES
#define MK_N_LAUNCHES 1
#endif

#define LAS __attribute__((address_space(3)))
typedef unsigned short bf16_t;
typedef __hip_bfloat16 bf16;
typedef short bf16x8 __attribute__((ext_vector_type(8)));
typedef short s16x4 __attribute__((ext_vector_type(4)));
typedef float f32x4 __attribute__((ext_vector_type(4)));
typedef float f32x16 __attribute__((ext_vector_type(16)));
typedef unsigned u32x4 __attribute__((ext_vector_type(4)));
typedef unsigned u32x2 __attribute__((ext_vector_type(2)));
typedef float f32x2 __attribute__((ext_vector_type(2)));

constexpr int NBATCH = 8, SEQ = 4096, DM = 1024, MTOK = NBATCH * SEQ;
constexpr int NIN = 2560;
constexpr int NEXP = 32, DEXP = 256;
constexpr float EPS = 1e-6f;
constexpr float QSCALE = 0.125f * 1.4426950408889634f;
constexpr int NWAVES = 8, NTHREADS = 512;
constexpr int NPHASES = 9;

constexpr size_t MiB = 1u << 20;
constexpr size_t WS_CTL = 0;
constexpr size_t WS_RT = 1 * MiB;
constexpr size_t WS_WRH = 1 * MiB + 512 * 1024;
constexpr size_t WS_WRL = 1 * MiB + 768 * 1024;
constexpr size_t WS_WIN = 2 * MiB;
constexpr size_t WS_WOUT = 7 * MiB;
constexpr size_t WS_WGU = 9 * MiB;
constexpr size_t WS_WD = 41 * MiB;
constexpr size_t WS_EW = 58 * MiB;
constexpr size_t WS_LIST = 59 * MiB;
constexpr size_t WS_XN = 64 * MiB;
constexpr size_t WS_Q = 128 * MiB, WS_K = 160 * MiB, WS_V = 192 * MiB, WS_XR = 224 * MiB, WS_GG = 256 * MiB;
constexpr size_t WS_X1 = 128 * MiB;
constexpr size_t WS_Y = 352 * MiB;
constexpr size_t WS_O0 = 288 * MiB;
constexpr size_t WS_HID = 288 * MiB;
constexpr size_t WS_HF = 352 * MiB;
constexpr size_t WS_MIX = 416 * MiB;
constexpr size_t WS_END = 480 * MiB;

constexpr int LDS_BYTES = 136 * 1024;

struct Args { const float* in[23]; float* out; unsigned char* ws; int ph_lo, ph_hi; };

#define LDS_WAIT() asm volatile("s_waitcnt lgkmcnt(0)" ::: "memory")
__device__ __forceinline__ unsigned f2bf(float f) { unsigned u = __builtin_bit_cast(unsigned, f); return (u + 0x7fffu + ((u >> 16) & 1u)) >> 16; }
__device__ __forceinline__ unsigned pk2(float lo, float hi) { unsigned r; asm("v_cvt_pk_bf16_f32 %0, %1, %2" : "=v"(r) : "v"(lo), "v"(hi)); return r; }
__device__ __forceinline__ float bf2f(bf16_t b) { return __builtin_bit_cast(float, (unsigned)b << 16); }
__device__ __forceinline__ float wave_sum(float v) {
#pragma unroll
    for (int o = 1; o < 64; o <<= 1) v += __shfl_xor(v, o);
    return v;
}
__device__ __forceinline__ float gelu_tanh(float x) {
    const float y = 0.7978845608028654f * (x + 0.044715f * x * x * x);
    const float t = 1.0f - 2.0f * __builtin_amdgcn_rcpf(1.0f + __builtin_amdgcn_exp2f(2.885390081777927f * y));
    return 0.5f * x * (1.0f + t);
}
__device__ __forceinline__ float sigmoidf_(float x) { return __builtin_amdgcn_rcpf(1.0f + __builtin_amdgcn_exp2f(-1.4426950408889634f * x)); }

__device__ __forceinline__ void tr_item(const float* W, int N, int k0, int n0, bf16_t* WT, int ldt, int dst_row0, LAS float* scr, int lane) {
    float wv[32];
#pragma unroll
    for (int i = 0; i < 32; ++i) { const int kk = 2 * i + (lane >> 5); wv[i] = __builtin_nontemporal_load(W + (size_t)(k0 + kk) * N + n0 + (lane & 31)); }
    asm volatile("" : "+v"(wv[0]), "+v"(wv[1]), "+v"(wv[2]), "+v"(wv[3]), "+v"(wv[4]), "+v"(wv[5]), "+v"(wv[6]), "+v"(wv[7]), "+v"(wv[8]), "+v"(wv[9]), "+v"(wv[10]), "+v"(wv[11]), "+v"(wv[12]), "+v"(wv[13]), "+v"(wv[14]), "+v"(wv[15]));
    asm volatile("" : "+v"(wv[16]), "+v"(wv[17]), "+v"(wv[18]), "+v"(wv[19]), "+v"(wv[20]), "+v"(wv[21]), "+v"(wv[22]), "+v"(wv[23]), "+v"(wv[24]), "+v"(wv[25]), "+v"(wv[26]), "+v"(wv[27]), "+v"(wv[28]), "+v"(wv[29]), "+v"(wv[30]), "+v"(wv[31]));
#pragma unroll
    for (int i = 0; i < 32; ++i) { const int kk = 2 * i + (lane >> 5); scr[kk * 33 + (lane & 31)] = wv[i]; }
    LDS_WAIT(); asm volatile("" ::: "memory");
    const int c = lane & 7;
#pragma unroll
    for (int j = 0; j < 4; ++j) { const int n = (lane >> 3) + 8 * j; const LAS float* s = scr + (8 * c) * 33 + n;
        u32x4 o; o.x = pk2(s[0 * 33], s[1 * 33]); o.y = pk2(s[2 * 33], s[3 * 33]); o.z = pk2(s[4 * 33], s[5 * 33]); o.w = pk2(s[6 * 33], s[7 * 33]);
        __builtin_nontemporal_store(o, (u32x4*)(WT + (size_t)(dst_row0 + n) * ldt + k0 + 8 * c)); }
    LDS_WAIT(); asm volatile("" ::: "memory");
}
__device__ __forceinline__ int gu_row(int c, int is_up) { return 256 * (c >> 7) + 128 * is_up + (c & 127); }

__device__ __forceinline__ void rms_row_bf16(const float* xrow, const float* g, bf16_t* orow, int lane) {
    const f32x4* xr = (const f32x4*)xrow + lane; const f32x4* gr = (const f32x4*)g + lane;
    f32x4 v[4]; float s = 0.f;
#pragma unroll
    for (int j = 0; j < 4; ++j) { v[j] = xr[64 * j]; s += (v[j].x * v[j].x + v[j].y * v[j].y) + (v[j].z * v[j].z + v[j].w * v[j].w); }
    s = wave_sum(s);
    const float rstd = 1.0f / sqrtf(s * (1.0f / DM) + EPS);
    u32x2* o8 = (u32x2*)orow + lane;
#pragma unroll
    for (int j = 0; j < 4; ++j) { const f32x4 gv = gr[64 * j]; u32x2 w; w.x = pk2(v[j].x * rstd * gv.x, v[j].y * rstd * gv.y); w.y = pk2(v[j].z * rstd * gv.z, v[j].w * rstd * gv.w); o8[64 * j] = w; }
}

template <int PART> __device__ __forceinline__ void phase0(const Args& a, LAS unsigned char* lds, int tid, int wave, int lane, int gw, int NGW) {
    unsigned char* ws = a.ws;
    LAS float* scr = (LAS float*)(lds + wave * 8704);
    bf16_t* WinT = (bf16_t*)(ws + WS_WIN); bf16_t* WoutT = (bf16_t*)(ws + WS_WOUT); bf16_t* WguT = (bf16_t*)(ws + WS_WGU); bf16_t* WdT = (bf16_t*)(ws + WS_WD);
    constexpr int I_IN = 16 * 80, I_OUT = 16 * 32, I_G = 32 * 128, NITEMS = I_IN + I_OUT + I_G;
    for (int it = (PART == 1 ? I_IN + gw : gw); it < (PART == 0 ? I_IN : NITEMS); it += NGW) {
        int r = it;
        if (r < I_IN) { const int kb = r / 80, nb = r % 80; tr_item(a.in[2], NIN, 64 * kb, 32 * nb, WinT, DM, 32 * nb, scr, lane); continue; } r -= I_IN;
        if (r < I_OUT) { const int kb = r / 32, nb = r % 32; tr_item(a.in[15], DM, 64 * kb, 32 * nb, WoutT, DM, 32 * nb, scr, lane); continue; } r -= I_OUT;
        if (r < I_G) { const int e = r / 128, rr = r % 128, kb = rr / 8, nb = rr % 8; tr_item(a.in[19] + (size_t)e * DM * DEXP, DEXP, 64 * kb, 32 * nb, WguT + (size_t)e * 512 * DM, DM, gu_row(32 * nb, 0), scr, lane); continue; }
        (void)r;
    }
    { bf16_t* WRH = (bf16_t*)(ws + WS_WRH); bf16_t* WRL = (bf16_t*)(ws + WS_WRL); const int gt = gw * 64 + lane, NGT = NGW * 64;
      if (PART != 0) for (int idx = gt; idx < 48 * DM; idx += NGT) { const int j = idx / DM, k = idx % DM;
          const float w = (j < 4) ? a.in[17][k * 4 + j] : (j < 36) ? a.in[18][k * 32 + (j - 4)] : 0.f; const float wg = w * a.in[16][k];
          const unsigned hi = f2bf(wg); const float hif = __builtin_bit_cast(float, hi << 16);
          WRH[idx] = (bf16_t)hi; WRL[idx] = (bf16_t)f2bf(wg - hif); }
      if (PART != 0 && gt < 2048) ((int*)(ws + WS_CTL))[gt] = 0;
      float2* RT = (float2*)(ws + WS_RT);
      if (PART != 1) for (int idx = gt; idx < SEQ * 8; idx += NGT) { const int pos = idx >> 3, i = idx & 7;
          const float invf = __builtin_amdgcn_exp2f(-(float)i * (18.931568569324174f / 8.0f));
          const float ang = (float)pos * invf;
          const double rev = (double)ang * 0.15915494309189535; const double fr = rev - __builtin_rint(rev);
          const float frf = (float)fr;
          RT[idx] = make_float2(__builtin_amdgcn_cosf(frf), __builtin_amdgcn_sinf(frf)); }
    }
    if (PART != 1) { bf16_t* XN = (bf16_t*)(ws + WS_XN); const float* x = a.in[0];
      f32x4 gv[4];
#pragma unroll
      for (int j = 0; j < 4; ++j) gv[j] = ((const f32x4*)a.in[1])[lane + 64 * j];
      f32x4 xn[4];
      if (gw < MTOK) {
#pragma unroll
          for (int j = 0; j < 4; ++j) xn[j] = __builtin_nontemporal_load((const f32x4*)(x + (size_t)gw * DM) + lane + 64 * j); }
      for (int m = gw; m < MTOK; m += NGW) {
          f32x4 v[4]; float s = 0.f;
#pragma unroll
          for (int j = 0; j < 4; ++j) { v[j] = xn[j]; s += (v[j].x * v[j].x + v[j].y * v[j].y) + (v[j].z * v[j].z + v[j].w * v[j].w); }
          { const int mn = (m + NGW < MTOK) ? m + NGW : m;
#pragma unroll
            for (int j = 0; j < 4; ++j) xn[j] = __builtin_nontemporal_load((const f32x4*)(x + (size_t)mn * DM) + lane + 64 * j); }
          s = wave_sum(s);
          const float rstd = 1.0f / sqrtf(s * (1.0f / DM) + EPS);
          u32x2* o8 = (u32x2*)(XN + (size_t)m * DM) + lane;
#pragma unroll
          for (int j = 0; j < 4; ++j) { u32x2 w; w.x = pk2(v[j].x * rstd * gv[j].x, v[j].y * rstd * gv[j].y); w.y = pk2(v[j].z * rstd * gv[j].z, v[j].w * rstd * gv[j].w); o8[64 * j] = w; } } }
}

__device__ __forceinline__ void phase0_down(const Args& a, LAS unsigned char* lds, int wave, int lane, int gw, int NGW) {
    LAS float* scr = (LAS float*)(lds + wave * 8704);
    bf16_t* WdT = (bf16_t*)(a.ws + WS_WD); bf16_t* WguT = (bf16_t*)(a.ws + WS_WGU);
    for (int r = gw; r < 2 * 32 * 128; r += NGW) {
        if (r < 32 * 128) { const int e = r / 128, rr = r % 128, kb = rr / 32, nb = rr % 32;
            tr_item(a.in[21] + (size_t)e * DEXP * DM, DM, 64 * kb, 32 * nb, WdT + (size_t)e * DM * DEXP, DEXP, 32 * nb, scr, lane); }
        else { const int q = r - 32 * 128, e = q / 128, rr = q % 128, kb = rr / 8, nb = rr % 8;
            tr_item(a.in[20] + (size_t)e * DM * DEXP, DEXP, 64 * kb, 32 * nb, WguT + (size_t)e * 512 * DM, DM, gu_row(32 * nb, 1), scr, lane); } }
}

template <class ARow>
__device__ __forceinline__ void wave_gemm_64x64(f32x4 (&acc)[4][4], const ARow& arow, const bf16_t* __restrict__ Bt, int ldb, int K, int m0, int n0, int lane) {
    const int fr = lane & 15, fq = lane >> 4;
#pragma unroll
    for (int mi = 0; mi < 4; ++mi)
#pragma unroll
        for (int ni = 0; ni < 4; ++ni) acc[mi][ni] = (f32x4){0.f, 0.f, 0.f, 0.f};
    const bf16_t* ap[4];
#pragma unroll
    for (int mi = 0; mi < 4; ++mi) ap[mi] = arow(m0 + 16 * mi + fr) + 8 * fq;
    const bf16_t* bp = Bt + (size_t)(n0 + fr) * ldb + 8 * fq;
    for (int k0 = 0; k0 < K; k0 += 32) {
        bf16x8 av[4], bv[4];
#pragma unroll
        for (int mi = 0; mi < 4; ++mi) av[mi] = *(const bf16x8*)(ap[mi] + k0);
#pragma unroll
        for (int ni = 0; ni < 4; ++ni) bv[ni] = *(const bf16x8*)(bp + (size_t)(16 * ni) * ldb + k0);
#pragma unroll
        for (int mi = 0; mi < 4; ++mi)
#pragma unroll
            for (int ni = 0; ni < 4; ++ni) acc[mi][ni] = __builtin_amdgcn_mfma_f32_16x16x32_bf16(bv[ni], av[mi], acc[mi][ni], 0, 0, 0);
    }
}
struct RowsContig { const bf16_t* base; int ld; __device__ __forceinline__ const bf16_t* operator()(int r) const { return base + (size_t)r * ld; } };

__device__ __forceinline__ void store_bf16x4(bf16_t* p, f32x4 v) { u32x2 w; w.x = pk2(v.x, v.y); w.y = pk2(v.z, v.w); *(u32x2*)p = w; }


namespace pg8 {
constexpr int BM = 256, BK = 64, HALF = 128, HTB = HALF * BK * 2, STAGE_BYTES = 8 * HTB, NXCD = 8, WGM = 8;
__host__ __device__ __forceinline__ int lds_byte(int r, int c) { const int st = (r >> 4) * 2 + (c >> 5), rr = r & 15, cc = c & 31, ob = rr * 64 + cc * 2; return st * 1024 + (ob ^ (((ob >> 9) & 1) << 5)); }
__host__ __device__ __forceinline__ void stage_rc(int b, int& R, int& C) { const int st = b / 1024, sb = b % 1024, swz = sb ^ (((sb >> 9) & 1) << 5); R = (st >> 1) * 16 + swz / 64; C = (st & 1) * 32 + (swz % 64) / 2; }
__host__ __device__ __forceinline__ int perm32(int rho) { const int n = rho >> 4, i = rho & 15; return 8 * (i >> 2) + 4 * n + (i & 3); }

struct Unit { const char* A; const char* B; int pm, pn, e, nrows, seg, K, typ, tix; };

template <class Epi, class Sched>
__device__ __forceinline__ void gemm_phase(LAS unsigned char* lds, const int K, const Sched& S, const Epi& E) {
    const int tid = threadIdx.x, wid = __builtin_amdgcn_readfirstlane(tid >> 6), lane = tid & 63, wr = wid >> 2, wc = wid & 3, fr = lane & 15, fq = lane >> 4;
    const int nt = K / BK;
    int Rl[2], Cl[2]; unsigned voffB[2];
#pragma unroll
    for (int i = 0; i < 2; ++i) { int R, C; stage_rc(tid * 16 + i * 8192, R, C); const int Rb = Epi::PERM ? ((R & ~31) + perm32(R & 31)) : R;
        Rl[i] = R; Cl[i] = C; voffB[i] = (unsigned)(Rb * K + C) * 2u; }
    const size_t kstep = (size_t)(BK * 2);
    const size_t hstep = (size_t)HALF * K * 2;
    const unsigned ldsw = (unsigned)wid * 1024u;
    const int aoff = lds_byte(wr * 64 + fr, fq * 8), boff = lds_byte(wc * 32 + fr, fq * 8);
#define PG8_SA(b, h) (((b) * 2 + (h)) * HTB)
#define PG8_SB(b, h) ((4 + (b) * 2 + (h)) * HTB)
#define PG8_STAGE(bufoff, gbase, voff) do { _Pragma("unroll") for (int _i = 0; _i < 2; ++_i) \
        __builtin_amdgcn_global_load_lds((const unsigned*)((const char*)(gbase) + (voff)[_i]), (LAS unsigned*)(lds + (bufoff) + ldsw + _i * 8192), 16, 0, 0); } while (0)
#define PG8_LDA(dst, b, h) do { _Pragma("unroll") for (int m = 0; m < 4; ++m) _Pragma("unroll") for (int k = 0; k < 2; ++k) dst[m][k] = *(const LAS bf16x8*)(lds + PG8_SA(b, h) + aoff + m * 2048 + k * 1024); } while (0)
#define PG8_LDB(dst, b, h) do { _Pragma("unroll") for (int n = 0; n < 2; ++n) _Pragma("unroll") for (int k = 0; k < 2; ++k) dst[n][k] = *(const LAS bf16x8*)(lds + PG8_SB(b, h) + boff + n * 2048 + k * 1024); } while (0)
#define PG8_MMA(ai, bj, At, Bt) do { __builtin_amdgcn_s_setprio(1); _Pragma("unroll") for (int m = 0; m < 4; ++m) _Pragma("unroll") for (int n = 0; n < 2; ++n) _Pragma("unroll") for (int k = 0; k < 2; ++k) \
        acc[ai][bj][m][n] = __builtin_amdgcn_mfma_f32_16x16x32_bf16(Bt[n][k], At[m][k], acc[ai][bj][m][n], 0, 0, 0); __builtin_amdgcn_s_setprio(0); } while (0)
#define PG8_WAIT_V(n) asm volatile("s_waitcnt vmcnt(" #n ")" ::: "memory")
#define PG8_WAIT_L(n) asm volatile("s_waitcnt lgkmcnt(" #n ")" ::: "memory")
#define PG8_BAR __builtin_amdgcn_s_barrier()
#define PG8_SCHED __builtin_amdgcn_sched_barrier(0)
    Unit cur, nxt; int ui = 0;
    if (!S.next(0, cur)) return;
    f32x4 acc[2][2][4][2];
#pragma unroll
    for (int a = 0; a < 2; ++a)
#pragma unroll
        for (int b = 0; b < 2; ++b)
#pragma unroll
            for (int m = 0; m < 4; ++m)
#pragma unroll
                for (int n = 0; n < 2; ++n) acc[a][b][m][n] = (f32x4){0.f, 0.f, 0.f, 0.f};
    bf16x8 At[4][2], B0[2][2], B1[2][2];
    const char* cA = cur.A; const char* cB = cur.B;
    unsigned vA0[2], vA1[2], nA0[2], nA1[2];
#pragma unroll
    for (int i = 0; i < 2; ++i) { vA0[i] = S.a_row(cur, Rl[i], K) + (unsigned)Cl[i] * 2u; vA1[i] = S.a_row(cur, HALF + Rl[i], K) + (unsigned)Cl[i] * 2u; nA0[i] = vA0[i]; nA1[i] = vA1[i]; }
    PG8_STAGE(PG8_SB(0, 0), cB, voffB); PG8_STAGE(PG8_SB(0, 1), cB + hstep, voffB); PG8_STAGE(PG8_SA(0, 0), cA, vA0); PG8_STAGE(PG8_SA(0, 1), cA, vA1);
    if (wr == 1) PG8_BAR;
    PG8_WAIT_V(2); PG8_BAR;
    PG8_STAGE(PG8_SB(1, 0), cB + kstep, voffB); PG8_STAGE(PG8_SA(1, 0), cA + kstep, vA0); PG8_STAGE(PG8_SB(1, 1), cB + hstep + kstep, voffB);
    PG8_WAIT_V(6); PG8_BAR;
    for (;;) {
        const bool has_next = S.next(ui + 1, nxt);
        const char* nA = has_next ? nxt.A : cA; const char* nB = has_next ? nxt.B : cB;
        if (has_next) {
#pragma unroll
            for (int i = 0; i < 2; ++i) { nA0[i] = S.a_row(nxt, Rl[i], K) + (unsigned)Cl[i] * 2u; nA1[i] = S.a_row(nxt, HALF + Rl[i], K) + (unsigned)Cl[i] * 2u; }
        }
#pragma nounroll
        for (int t = 0; t < nt; t += 2) {
            const bool last = (t == nt - 2);
            const char* a1 = cA + (size_t)(t + 1) * kstep;
            const char* a2 = last ? nA : cA + (size_t)(t + 2) * kstep; const char* b2 = last ? nB : cB + (size_t)(t + 2) * kstep;
            const char* a3 = a2 + kstep; const char* b3 = b2 + kstep;
            unsigned w0[2], w1[2];
#pragma unroll
            for (int i = 0; i < 2; ++i) { w0[i] = last ? nA0[i] : vA0[i]; w1[i] = last ? nA1[i] : vA1[i]; }
            PG8_LDB(B0, 0, 0); PG8_LDB(B1, 0, 1); PG8_SCHED; PG8_LDA(At, 0, 0); PG8_STAGE(PG8_SA(1, 1), a1, vA1);
            PG8_WAIT_V(8); PG8_WAIT_L(0); PG8_BAR; PG8_MMA(0, 0, At, B0); PG8_MMA(0, 1, At, B1); PG8_BAR; PG8_SCHED;
            PG8_LDA(At, 0, 1); PG8_STAGE(PG8_SB(0, 0), b2, voffB); PG8_STAGE(PG8_SB(0, 1), b2 + hstep, voffB); PG8_STAGE(PG8_SA(0, 0), a2, w0);
            PG8_WAIT_V(8); PG8_WAIT_L(0); PG8_BAR; PG8_MMA(1, 0, At, B0); PG8_MMA(1, 1, At, B1); PG8_BAR; PG8_SCHED;
            PG8_LDB(B0, 1, 0); PG8_LDB(B1, 1, 1); PG8_SCHED; PG8_LDA(At, 1, 0); PG8_STAGE(PG8_SA(0, 1), a2, w1);
            PG8_WAIT_V(8); PG8_WAIT_L(0); PG8_BAR; PG8_MMA(0, 0, At, B0); PG8_MMA(0, 1, At, B1); PG8_BAR; PG8_SCHED;
            PG8_LDA(At, 1, 1); PG8_STAGE(PG8_SB(1, 0), b3, voffB); PG8_STAGE(PG8_SB(1, 1), b3 + hstep, voffB); PG8_STAGE(PG8_SA(1, 0), a3, w0);
            PG8_WAIT_V(8); PG8_WAIT_L(0); PG8_BAR; PG8_MMA(1, 0, At, B0); PG8_MMA(1, 1, At, B1); PG8_BAR; PG8_SCHED;
        }
        if (wr == 0) PG8_BAR;
        E(acc, cur, wr, wc, fr, fq);
        if (!has_next) break;
#pragma unroll
        for (int a = 0; a < 2; ++a)
#pragma unroll
            for (int b = 0; b < 2; ++b)
#pragma unroll
                for (int m = 0; m < 4; ++m)
#pragma unroll
                    for (int n = 0; n < 2; ++n) acc[a][b][m][n] = (f32x4){0.f, 0.f, 0.f, 0.f};
        cur = nxt; cA = nA; cB = nB; ++ui;
#pragma unroll
        for (int i = 0; i < 2; ++i) { vA0[i] = nA0[i]; vA1[i] = nA1[i]; }
        if (wr == 1) PG8_BAR;
    }
    PG8_WAIT_V(0);
    PG8_BAR;
#undef PG8_SA
#undef PG8_SB
#undef PG8_STAGE
#undef PG8_LDA
#undef PG8_LDB
#undef PG8_MMA
#undef PG8_WAIT_V
#undef PG8_WAIT_L
#undef PG8_BAR
#undef PG8_SCHED
}

template <class Epi, class Sched>
__device__ __forceinline__ void gemm_phase_vk(LAS unsigned char* lds, const Sched& S, const Epi& E) {
    const int tid = threadIdx.x, wid = __builtin_amdgcn_readfirstlane(tid >> 6), lane = tid & 63, wr = wid >> 2, wc = wid & 3, fr = lane & 15, fq = lane >> 4;
    int Rl[2], Cl[2], Rbl[2]; unsigned voffB[2], nvoffB[2];
#pragma unroll
    for (int i = 0; i < 2; ++i) { int R, C; stage_rc(tid * 16 + i * 8192, R, C); const int Rb = Epi::PERM ? ((R & ~31) + perm32(R & 31)) : R;
        Rl[i] = R; Cl[i] = C; Rbl[i] = Rb; }
    const size_t kstep = (size_t)(BK * 2);
    const unsigned ldsw = (unsigned)wid * 1024u;
    const int aoff = lds_byte(wr * 64 + fr, fq * 8), boff = lds_byte(wc * 32 + fr, fq * 8);
#define PG8_SA(b, h) (((b) * 2 + (h)) * HTB)
#define PG8_SB(b, h) ((4 + (b) * 2 + (h)) * HTB)
#define PG8_STAGE(bufoff, gbase, voff) do { _Pragma("unroll") for (int _i = 0; _i < 2; ++_i) \
        __builtin_amdgcn_global_load_lds((const unsigned*)((const char*)(gbase) + (voff)[_i]), (LAS unsigned*)(lds + (bufoff) + ldsw + _i * 8192), 16, 0, 0); } while (0)
#define PG8_LDA(dst, b, h) do { _Pragma("unroll") for (int m = 0; m < 4; ++m) _Pragma("unroll") for (int k = 0; k < 2; ++k) dst[m][k] = *(const LAS bf16x8*)(lds + PG8_SA(b, h) + aoff + m * 2048 + k * 1024); } while (0)
#define PG8_LDB(dst, b, h) do { _Pragma("unroll") for (int n = 0; n < 2; ++n) _Pragma("unroll") for (int k = 0; k < 2; ++k) dst[n][k] = *(const LAS bf16x8*)(lds + PG8_SB(b, h) + boff + n * 2048 + k * 1024); } while (0)
#define PG8_MMA(ai, bj, At, Bt) do { __builtin_amdgcn_s_setprio(1); _Pragma("unroll") for (int m = 0; m < 4; ++m) _Pragma("unroll") for (int n = 0; n < 2; ++n) _Pragma("unroll") for (int k = 0; k < 2; ++k) \
        acc[ai][bj][m][n] = __builtin_amdgcn_mfma_f32_16x16x32_bf16(Bt[n][k], At[m][k], acc[ai][bj][m][n], 0, 0, 0); __builtin_amdgcn_s_setprio(0); } while (0)
#define PG8_WAIT_V(n) asm volatile("s_waitcnt vmcnt(" #n ")" ::: "memory")
#define PG8_WAIT_L(n) asm volatile("s_waitcnt lgkmcnt(" #n ")" ::: "memory")
#define PG8_BAR __builtin_amdgcn_s_barrier()
#define PG8_SCHED __builtin_amdgcn_sched_barrier(0)
    Unit cur, nxt; int ui = 0;
    if (!S.next(0, cur)) return;
    int K = cur.K; size_t hstep = (size_t)HALF * K * 2, nhstep = hstep;
#pragma unroll
    for (int i = 0; i < 2; ++i) { voffB[i] = (unsigned)(Rbl[i] * K + Cl[i]) * 2u; nvoffB[i] = voffB[i]; }
    f32x4 acc[2][2][4][2];
#pragma unroll
    for (int a = 0; a < 2; ++a)
#pragma unroll
        for (int b = 0; b < 2; ++b)
#pragma unroll
            for (int m = 0; m < 4; ++m)
#pragma unroll
                for (int n = 0; n < 2; ++n) acc[a][b][m][n] = (f32x4){0.f, 0.f, 0.f, 0.f};
    bf16x8 At[4][2], B0[2][2], B1[2][2];
    const char* cA = cur.A; const char* cB = cur.B;
    unsigned vA0[2], vA1[2], nA0[2], nA1[2];
    { int r0[2], r1[2];
#pragma unroll
      for (int i = 0; i < 2; ++i) { r0[i] = S.row_of(cur, Rl[i]); r1[i] = S.row_of(cur, HALF + Rl[i]); }
#pragma unroll
      for (int i = 0; i < 2; ++i) { vA0[i] = ((unsigned)r0[i] * (unsigned)K) * 2u + (unsigned)Cl[i] * 2u; vA1[i] = ((unsigned)r1[i] * (unsigned)K) * 2u + (unsigned)Cl[i] * 2u; nA0[i] = vA0[i]; nA1[i] = vA1[i]; } }
    PG8_STAGE(PG8_SB(0, 0), cB, voffB); PG8_STAGE(PG8_SB(0, 1), cB + hstep, voffB); PG8_STAGE(PG8_SA(0, 0), cA, vA0); PG8_STAGE(PG8_SA(0, 1), cA, vA1);
    if (wr == 1) PG8_BAR;
    PG8_WAIT_V(2); PG8_BAR;
    PG8_STAGE(PG8_SB(1, 0), cB + kstep, voffB); PG8_STAGE(PG8_SA(1, 0), cA + kstep, vA0); PG8_STAGE(PG8_SB(1, 1), cB + hstep + kstep, voffB);
    PG8_WAIT_V(6); PG8_BAR;
    for (;;) {
        const bool has_next = S.next(ui + 1, nxt);
        const char* nA = has_next ? nxt.A : cA; const char* nB = has_next ? nxt.B : cB;
        const int nK = has_next ? nxt.K : K;
        if (has_next) { nhstep = (size_t)HALF * nK * 2;
#pragma unroll
            for (int i = 0; i < 2; ++i) { nA0[i] = (unsigned)S.row_of(nxt, Rl[i]); nA1[i] = (unsigned)S.row_of(nxt, HALF + Rl[i]); nvoffB[i] = (unsigned)(Rbl[i] * nK + Cl[i]) * 2u; }
        }
        const int nt = K / BK;
#pragma nounroll
        for (int t = 0; t < nt; t += 2) {
            const bool last = (t == nt - 2);
            if (last && has_next) S.wait_ready(nxt);
            const char* a1 = cA + (size_t)(t + 1) * kstep;
            const char* a2 = last ? nA : cA + (size_t)(t + 2) * kstep; const char* b2 = last ? nB : cB + (size_t)(t + 2) * kstep;
            const char* a3 = a2 + kstep; const char* b3 = b2 + kstep;
            if (last && has_next) {
#pragma unroll
                for (int i = 0; i < 2; ++i) { nA0[i] = (nA0[i] * (unsigned)nK) * 2u + (unsigned)Cl[i] * 2u; nA1[i] = (nA1[i] * (unsigned)nK) * 2u + (unsigned)Cl[i] * 2u; } }
            unsigned w0[2], w1[2];
#pragma unroll
            for (int i = 0; i < 2; ++i) { w0[i] = last ? nA0[i] : vA0[i]; w1[i] = last ? nA1[i] : vA1[i]; }
            unsigned vb[2]; vb[0] = last ? nvoffB[0] : voffB[0]; vb[1] = last ? nvoffB[1] : voffB[1]; const size_t hs = last ? nhstep : hstep;
            PG8_LDB(B0, 0, 0); PG8_LDB(B1, 0, 1); PG8_SCHED; PG8_LDA(At, 0, 0); PG8_STAGE(PG8_SA(1, 1), a1, vA1);
            PG8_WAIT_V(8); PG8_WAIT_L(0); PG8_BAR; PG8_MMA(0, 0, At, B0); PG8_MMA(0, 1, At, B1); PG8_BAR; PG8_SCHED;
            PG8_LDA(At, 0, 1); PG8_STAGE(PG8_SB(0, 0), b2, vb); PG8_STAGE(PG8_SB(0, 1), b2 + hs, vb); PG8_STAGE(PG8_SA(0, 0), a2, w0);
            PG8_WAIT_V(8); PG8_WAIT_L(0); PG8_BAR; PG8_MMA(1, 0, At, B0); PG8_MMA(1, 1, At, B1); PG8_BAR; PG8_SCHED;
            PG8_LDB(B0, 1, 0); PG8_LDB(B1, 1, 1); PG8_SCHED; PG8_LDA(At, 1, 0); PG8_STAGE(PG8_SA(0, 1), a2, w1);
            PG8_WAIT_V(8); PG8_WAIT_L(0); PG8_BAR; PG8_MMA(0, 0, At, B0); PG8_MMA(0, 1, At, B1); PG8_BAR; PG8_SCHED;
            PG8_LDA(At, 1, 1); PG8_STAGE(PG8_SB(1, 0), b3, vb); PG8_STAGE(PG8_SB(1, 1), b3 + hs, vb); PG8_STAGE(PG8_SA(1, 0), a3, w0);
            PG8_WAIT_V(8); PG8_WAIT_L(0); PG8_BAR; PG8_MMA(1, 0, At, B0); PG8_MMA(1, 1, At, B1); PG8_BAR; PG8_SCHED;
        }
        if (wr == 0) PG8_BAR;
        E(acc, cur, wr, wc, fr, fq);
        if (!has_next) break;
#pragma unroll
        for (int a = 0; a < 2; ++a)
#pragma unroll
            for (int b = 0; b < 2; ++b)
#pragma unroll
                for (int m = 0; m < 4; ++m)
#pragma unroll
                    for (int n = 0; n < 2; ++n) acc[a][b][m][n] = (f32x4){0.f, 0.f, 0.f, 0.f};
        cur = nxt; cA = nA; cB = nB; ++ui; K = nK; hstep = nhstep;
#pragma unroll
        for (int i = 0; i < 2; ++i) { vA0[i] = nA0[i]; vA1[i] = nA1[i]; voffB[i] = nvoffB[i]; }
        if (wr == 1) PG8_BAR;
    }
    PG8_WAIT_V(0);
    PG8_BAR;
#undef PG8_SA
#undef PG8_SB
#undef PG8_STAGE
#undef PG8_LDA
#undef PG8_LDB
#undef PG8_MMA
#undef PG8_WAIT_V
#undef PG8_WAIT_L
#undef PG8_BAR
#undef PG8_SCHED
}

struct DenseOrder {
    const char* A; const char* Bt; int K, nM, nN, nwg, G, c, pn0;
    __device__ void init(const void* A_, const void* Bt_, int M, int N, int K_, int G_, int c_, int pn0_ = 0) { A = (const char*)A_; Bt = (const char*)Bt_; K = K_; nM = M / BM; nN = N / BM; nwg = nM * nN; G = G_; c = c_; pn0 = pn0_; }
    __device__ __forceinline__ bool next(int i, Unit& u) const {
        const long L = (long)i * G + c; if (L >= nwg) return false;
        int wgid = (int)L; { const int q = nwg / NXCD, r = nwg % NXCD, xcd = wgid % NXCD, off = wgid / NXCD; wgid = (xcd < r ? xcd * (q + 1) : r * (q + 1) + (xcd - r) * q) + off; }
        const int nig = WGM * nN, gid = wgid / nig, fm = gid * WGM, gsz = (nM - fm) < WGM ? (nM - fm) : WGM;
        u.pm = fm + ((wgid % nig) % gsz); u.pn = pn0 + (wgid % nig) / gsz; u.e = 0; u.nrows = BM; u.seg = 0;
        u.A = A + (size_t)u.pm * BM * K * 2; u.B = Bt + (size_t)u.pn * BM * K * 2; return true;
    }
    __device__ __forceinline__ unsigned a_row(const Unit&, int r, int K_) const { return (unsigned)(r * K_) * 2u; }
};
}

struct EpiInProj {
    static constexpr bool PERM = true;
    unsigned char* ws; const float2* RT;
    __device__ __forceinline__ void operator()(const f32x4 (&acc)[2][2][4][2], const pg8::Unit& u, int wr, int wc, int fr, int fq) const {
        const int seg = u.pn >> 1;
        bf16_t* dst = (bf16_t*)(ws + (seg == 0 ? WS_Q : seg == 1 ? WS_K : seg == 2 ? WS_V : seg == 3 ? WS_XR : WS_GG));
        const int row0 = u.pm * 256 + wr * 64 + fr, col0 = (u.pn & 1) * 256 + wc * 32 + 8 * fq;
        const bool rope = (seg <= 1) && ((wc & 1) == 0);
#pragma unroll
        for (int ai = 0; ai < 2; ++ai)
#pragma unroll
            for (int mh = 0; mh < 2; ++mh) {
                f32x4 cs[2][4];
                if (rope && fq < 2) {
#pragma unroll
                    for (int mi = 0; mi < 2; ++mi) { const int pos = (row0 + ai * 128 + (2 * mh + mi) * 16) & (SEQ - 1); const f32x4* cp = (const f32x4*)(RT + pos * 8);
                        cs[mi][0] = cp[0]; cs[mi][1] = cp[1]; cs[mi][2] = cp[2]; cs[mi][3] = cp[3]; }
                    asm volatile("" : "+v"(cs[0][0]), "+v"(cs[0][1]), "+v"(cs[0][2]), "+v"(cs[0][3]), "+v"(cs[1][0]), "+v"(cs[1][1]), "+v"(cs[1][2]), "+v"(cs[1][3]));
                }
#pragma unroll
                for (int mi = 0; mi < 2; ++mi) { const int m = 2 * mh + mi, row = row0 + ai * 128 + m * 16;
#pragma unroll
                    for (int bj = 0; bj < 2; ++bj) { f32x4 v0 = acc[ai][bj][m][0], v1 = acc[ai][bj][m][1];
                        if (rope) {
                            f32x4 p0, p1;
                            p0.x = __shfl_xor(v0.x, 16); p0.y = __shfl_xor(v0.y, 16); p0.z = __shfl_xor(v0.z, 16); p0.w = __shfl_xor(v0.w, 16);
                            p1.x = __shfl_xor(v1.x, 16); p1.y = __shfl_xor(v1.y, 16); p1.z = __shfl_xor(v1.z, 16); p1.w = __shfl_xor(v1.w, 16);
                            if (fq < 2) { const float sg = (fq == 0) ? -1.f : 1.f;
                                const f32x4 q0 = cs[mi][0], q1 = cs[mi][1], q2 = cs[mi][2], q3 = cs[mi][3];
                                v0.x = v0.x * q0.x + sg * p0.x * q0.y; v0.y = v0.y * q0.z + sg * p0.y * q0.w; v0.z = v0.z * q1.x + sg * p0.z * q1.y; v0.w = v0.w * q1.z + sg * p0.w * q1.w;
                                v1.x = v1.x * q2.x + sg * p1.x * q2.y; v1.y = v1.y * q2.z + sg * p1.y * q2.w; v1.z = v1.z * q3.x + sg * p1.z * q3.y; v1.w = v1.w * q3.z + sg * p1.w * q3.w; }
                        }
                        if (seg == 0) { v0 = v0 * QSCALE; v1 = v1 * QSCALE; }
                        if (seg == 4) { v0.x = gelu_tanh(v0.x); v0.y = gelu_tanh(v0.y); v0.z = gelu_tanh(v0.z); v0.w = gelu_tanh(v0.w); v1.x = gelu_tanh(v1.x); v1.y = gelu_tanh(v1.y); v1.z = gelu_tanh(v1.z); v1.w = gelu_tanh(v1.w); }
                        u32x4 w; w.x = pk2(v0.x, v0.y); w.y = pk2(v0.z, v0.w); w.z = pk2(v1.x, v1.y); w.w = pk2(v1.z, v1.w);
                        *(u32x4*)(dst + (size_t)row * 512 + col0 + bj * 128) = w; } }
            }
    }
};
__device__ __forceinline__ void phase1(const Args& a, LAS unsigned char* lds, int G, int c, int pn0, int ncols) {
    unsigned char* ws = a.ws;
    pg8::DenseOrder S; S.init(ws + WS_XN, ws + WS_WIN, MTOK, ncols, DM, G, c, pn0);
    EpiInProj E{ws, (const float2*)(ws + WS_RT)};
    pg8::gemm_phase(lds, DM, S, E);
}

namespace att {
constexpr int DQK = 64, DV = 128, QBLK = 32, KVBLK = 64, LD = 512;
constexpr float SCALE = 0.125f, THR = 8.f;
constexpr int SHM_V = KVBLK * DV * 2, SHM_K = KVBLK * DQK * 2, SHM_ATTN = 2 * SHM_V + 2 * SHM_K + NWAVES * 64 * 4;
#define KSWZ(row, colB) ((row) * 128 + ((colB) ^ ((((row) >> 1) & 7) << 4)))
#define SBAR() __builtin_amdgcn_sched_barrier(0)
__device__ __forceinline__ int crow(int r, int hi) { return (r & 3) + 8 * (r >> 2) + 4 * hi; }
__device__ __forceinline__ float max3f(float a, float b, float c) { float r; asm("v_max3_f32 %0, %1, %2, %3" : "=v"(r) : "v"(a), "v"(b), "v"(c)); return r; }
__device__ __forceinline__ unsigned cvtpk(float lo, float hi) { unsigned r; asm volatile("v_cvt_pk_bf16_f32 %0, %1, %2" : "=v"(r) : "v"(lo), "v"(hi)); return r; }

constexpr float THRL = 11.0f;
__device__ __forceinline__ float rowmax_a(const f32x16& p0) {
    float pmax = p0[0];
#pragma unroll
    for (int r = 1; r < 16; ++r) pmax = fmaxf(pmax, p0[r]);
    return pmax;
}
__device__ __forceinline__ float rowmax_b(const f32x16& p1, float pmax) {
#pragma unroll
    for (int r = 0; r < 16; ++r) pmax = fmaxf(pmax, p1[r]);
    auto rr = __builtin_amdgcn_permlane32_swap(__float_as_uint(pmax), __float_as_uint(pmax), false, false);
    return fmaxf(__uint_as_float(rr[0]), __uint_as_float(rr[1]));
}
template <bool FIRST> __device__ __forceinline__ void decide(float rm, f32x16& p0, f32x16& p1, float& mhat, f32x16& negm, float& alpha) {
    alpha = 1.f;
    if (FIRST || __builtin_expect(__any(rm > THRL), 0)) {
        const float dl = FIRST ? rm : fmaxf(rm, 0.f);
        mhat += dl;
#pragma unroll
        for (int r = 0; r < 16; ++r) { p0[r] -= dl; p1[r] -= dl; }
#pragma unroll
        for (int r = 0; r < 16; ++r) negm[r] = -mhat;
        alpha = __builtin_amdgcn_exp2f(-dl);
    }
}
template <int VAR> __device__ __forceinline__ void exp16(f32x16& p) {
#pragma unroll
    for (int r = 0; r < 16; ++r) p[r] = (VAR & 2) ? p[r] * 0.001f : __builtin_amdgcn_exp2f(p[r]);
}
template <int VAR> __device__ __forceinline__ float expsum16(f32x16& p) {
    exp16<VAR>(p);
    float ps = 0;
#pragma unroll
    for (int r = 0; r < 16; ++r) ps += p[r];
    return ps;
}
__device__ __forceinline__ float halves_sum(float ps) {
    auto rr = __builtin_amdgcn_permlane32_swap(__float_as_uint(ps), __float_as_uint(ps), false, false);
    return __uint_as_float(rr[0]) + __uint_as_float(rr[1]);
}
__device__ __forceinline__ void pack4(const f32x16& p0, const f32x16& p1, bf16x8& pa0, bf16x8& pa1, bf16x8& pa2, bf16x8& pa3) {
#define PK4(P, BASE, OUT) do { u32x4 w = {cvtpk(P[BASE + 0], P[BASE + 1]), cvtpk(P[BASE + 2], P[BASE + 3]), cvtpk(P[BASE + 4], P[BASE + 5]), cvtpk(P[BASE + 6], P[BASE + 7])}; OUT = *reinterpret_cast<bf16x8*>(&w); } while (0)
    PK4(p0, 0, pa0); PK4(p0, 8, pa1); PK4(p1, 0, pa2); PK4(p1, 8, pa3);
#undef PK4
}
typedef short v4i16_t __attribute__((ext_vector_type(4)));
__device__ __forceinline__ s16x4 vtr(const LAS char* p) { return __builtin_bit_cast(s16x4, __builtin_amdgcn_ds_read_tr16_b64_v4i16((LAS v4i16_t*)p)); }
__device__ __forceinline__ void glds16(const void* gsrc, unsigned lds_dst) { unsigned keep;
    asm volatile("s_mov_b32 %0, m0\n\ts_mov_b32 m0, %2\n\ts_nop 0\n\tglobal_load_lds_dwordx4 %1, off\n\ts_mov_b32 m0, %0" : "=&s"(keep) : "v"(gsrc), "s"(lds_dst) : "memory"); }
#define WAIT_BAR(N) asm volatile("s_waitcnt vmcnt(" #N ") lgkmcnt(0)\n\ts_barrier" ::: "memory")

constexpr int NKS = 4, NVS = 5, SHM_VR = NVS * SHM_V, SHM_KR = NKS * SHM_K, SHM_ATTN2 = SHM_VR + SHM_KR + NWAVES * 64 * 4;
template <int VAR> __device__ __forceinline__ void attn_pass(const bf16_t* __restrict__ Qb, const bf16_t* __restrict__ Kh, const bf16_t* __restrict__ Vh, int seq, char* lds,
                                          f32x16 (&o)[4], float (&rli)[16], bool prefetched, const bf16_t* nKh, const bf16_t* nVh, bf16x8 (&qr)[4], const bf16_t* nQb) {
    int tid_ = threadIdx.x; asm volatile("" : "+v"(tid_));
    const int tid = tid_, lane = tid & 63, r32 = lane & 31, hi = lane >> 5; const int wid = __builtin_amdgcn_readfirstlane(tid >> 6);
    char* V_lds = lds; char* K_lds = lds + SHM_VR;
    float* wsf = (float*)(lds + SHM_VR + SHM_KR) + wid * 64; float* li_l = wsf; float* al_l = wsf + 32;
    const unsigned ldsV = (unsigned)(uintptr_t)V_lds, ldsK = (unsigned)(uintptr_t)K_lds;
    float mhat = 0.f, l_reg = 0.f; f32x16 negm = f32x16{};
#pragma unroll
    for (int d = 0; d < 4; ++d) o[d] = f32x16{};
    if (!prefetched) {
        const bf16_t* Qw = Qb + (long)(wid * QBLK + r32) * LD + hi * 8;
#pragma unroll
        for (int d0 = 0; d0 < 4; ++d0) qr[d0] = *reinterpret_cast<const bf16x8*>(Qw + d0 * 16); }
    const bf16_t* ksrc = Kh + (long)lane * LD + wid * 8;
    const bf16_t* vsrc0 = Vh + (long)(16 * (wid & 3) + (lane >> 2)) * LD + (wid >> 2) * 32 + (lane & 3) * 8;
    const bf16_t* vsrc1 = vsrc0 + 64;
    const unsigned kdst = ldsK + wid * 1024, vdst0 = ldsV + wid * 1024, vdst1 = ldsV + (wid + 8) * 1024;
#define DMA(t, ko, vo) do { const long go_ = (long)(t) * KVBLK * LD; \
        glds16(ksrc + go_, (unsigned)__builtin_amdgcn_readfirstlane(kdst + (ko))); \
        glds16(vsrc0 + go_, (unsigned)__builtin_amdgcn_readfirstlane(vdst0 + (vo))); \
        glds16(vsrc1 + go_, (unsigned)__builtin_amdgcn_readfirstlane(vdst1 + (vo))); } while (0)
#define RESC(al) do { if (__any((al) < 1.f)) { if (hi == 0) al_l[r32] = (al); asm volatile("s_waitcnt lgkmcnt(0)" ::: "memory"); \
    _Pragma("unroll") for (int d = 0; d < 4; ++d) _Pragma("unroll") for (int r = 0; r < 16; ++r) o[d][r] *= al_l[crow(r, hi)]; } } while (0)
    f32x16 pA0, pA1, pB0, pB1; const int NT = seq / KVBLK;
    int kr_ = 0, kw_ = 3 * SHM_K, vr_ = 4 * SHM_V, vw_ = 3 * SHM_V;
#define ROT() do { kr_ = (kr_ == 3 * SHM_K) ? 0 : kr_ + SHM_K; kw_ = (kw_ == 3 * SHM_K) ? 0 : kw_ + SHM_K; vr_ = (vr_ == 4 * SHM_V) ? 0 : vr_ + SHM_V; vw_ = (vw_ == 4 * SHM_V) ? 0 : vw_ + SHM_V; } while (0)
    const LAS char* K3 = (const LAS char*)K_lds + hi * 1024 + r32 * 16;
    const LAS char* V3 = (const LAS char*)V_lds + ((lane >> 4) & 1) * 32 + (lane & 3) * 8 + (4 * hi + ((lane & 15) >> 2)) * 64;
    bf16x8 kf[4]; s16x4 vlo[8], vhi[8]; bf16x8 pa[4];
#define KRD(i) do { if (VAR & 64) kf[(i) & 3] = qr[(i) & 3]; else kf[(i) & 3] = *(const LAS bf16x8*)(kp_ + ((i) >> 1) * 2048 + ((i) & 1) * 512); } while (0)
#define VRD(i) do { if (VAR & 32) { vlo[(i) & 7] = (s16x4){qr[0][0], qr[1][1], qr[2][2], qr[3][3]}; vhi[(i) & 7] = (s16x4){qr[0][4], qr[1][5], qr[2][6], qr[3][7]}; } \
                    else { vlo[(i) & 7] = vtr(vp_ + ((i) & 3) * 4096 + ((i) >> 2) * 1024); vhi[(i) & 7] = vtr(vp_ + ((i) & 3) * 4096 + ((i) >> 2) * 1024 + 512); } } while (0)
#define VFR(s) (bf16x8){vlo[s][0], vlo[s][1], vlo[s][2], vlo[s][3], vhi[s][0], vhi[s][1], vhi[s][2], vhi[s][3]}
#define QKM(PC0, PC1, i) do { if (VAR & 16) { if (((i) >> 1) == 0) { if (((i) & 1) == 0) PC0 = negm; else PC1 = negm; } if (((i) & 1) == 0) PC0[(i)] += __builtin_bit_cast(float, (int)kf[(i) & 3][0]); else PC1[(i)] += __builtin_bit_cast(float, (int)kf[(i) & 3][1]); } \
        else if (((i) & 1) == 0) PC0 = __builtin_amdgcn_mfma_f32_32x32x16_bf16(kf[(i) & 3], qr[(i) >> 1], ((i) >> 1) == 0 ? negm : PC0, 0, 0, 0); \
        else PC1 = __builtin_amdgcn_mfma_f32_32x32x16_bf16(kf[(i) & 3], qr[(i) >> 1], ((i) >> 1) == 0 ? negm : PC1, 0, 0, 0); } while (0)
#define PVM(i) do { if (VAR & 8) o[(i) & 3][(i)] += __builtin_bit_cast(float, (int)(pa[(i) >> 2][0] + vlo[(i) & 7][0] + vhi[(i) & 7][1])); else o[(i) & 3] = __builtin_amdgcn_mfma_f32_32x32x16_bf16(pa[(i) >> 2], VFR((i) & 7), o[(i) & 3], 0, 0, 0); } while (0)
#define PKA(P, B) do { ca0_ = cvtpk(P[B + 0], P[B + 1]); ca1_ = cvtpk(P[B + 2], P[B + 3]); cb0_ = cvtpk(P[B + 4], P[B + 5]); cb1_ = cvtpk(P[B + 6], P[B + 7]); } while (0)
#define PKB(k) do { u32x4 w_ = {ca0_, ca1_, cb0_, cb1_}; pa[k] = __builtin_bit_cast(bf16x8, w_); } while (0)
#define MAX8(acc, P, B) if (!(VAR & 256)) { acc = max3f(acc, P[B], P[B + 1]); pmb_ = max3f(pmb_, P[B + 2], P[B + 3]); acc = max3f(acc, P[B + 4], P[B + 5]); pmb_ = max3f(pmb_, P[B + 6], P[B + 7]); }
#define EX4(P, B) do { P[B] = (VAR & 2) ? P[B] * 0.001f : __builtin_amdgcn_exp2f(P[B]); P[B + 1] = (VAR & 2) ? P[B + 1] * 0.001f : __builtin_amdgcn_exp2f(P[B + 1]); \
                       P[B + 2] = (VAR & 2) ? P[B + 2] * 0.001f : __builtin_amdgcn_exp2f(P[B + 2]); P[B + 3] = (VAR & 2) ? P[B + 3] * 0.001f : __builtin_amdgcn_exp2f(P[B + 3]); \
                       ps2_ += (f32x2){P[B], P[B + 1]}; ps2_ += (f32x2){P[B + 2], P[B + 3]}; } while (0)
#define ENDW(j) do { if (VAR & 2048) { asm volatile("s_waitcnt lgkmcnt(0)" ::: "memory"); } else if ((j) + 3 < NT) WAIT_BAR(6); else if ((j) + 2 < NT) WAIT_BAR(3); else WAIT_BAR(0); } while (0)
    if (!prefetched) { __syncthreads();
        DMA(0, 0, 0); DMA(1, SHM_K, SHM_V); DMA(2, 2 * SHM_K, 2 * SHM_V);
        WAIT_BAR(6); }
    else WAIT_BAR(0);
    { DMA(3, kw_, vw_); SBAR();
      const LAS char* kp_ = K3 + kr_;
      KRD(0); KRD(1); KRD(2); KRD(3);
      QKM(pA0, pA1, 0); KRD(4); QKM(pA0, pA1, 1); KRD(5); QKM(pA0, pA1, 2); KRD(6); QKM(pA0, pA1, 3); KRD(7);
      QKM(pA0, pA1, 4); QKM(pA0, pA1, 5); QKM(pA0, pA1, 6); QKM(pA0, pA1, 7);
      const float rm = rowmax_b(pA1, rowmax_a(pA0)); float al_; decide<true>(rm, pA0, pA1, mhat, negm, al_); float ps = expsum16<VAR>(pA0); ps += expsum16<VAR>(pA1); l_reg = halves_sum(ps); }
    ENDW(0); ROT();
#define STEP(PC0, PC1, PP0, PP1, j) do { \
        if (!(VAR & 4096)) { if ((j) + 3 < NT) DMA((j) + 3, kw_, vw_); } SBAR(); \
        const LAS char* kp_ = K3 + kr_; const LAS char* vp_ = V3 + vr_; \
        unsigned ca0_, ca1_, cb0_, cb1_; float pmx_, pmb_, al_; f32x2 ps2_ = (f32x2){0.f, 0.f}; \
        KRD(0); KRD(1); KRD(2); KRD(3); VRD(0); VRD(1); PKA(PP0, 0); PKB(0); PKA(PP0, 8); PKB(1); SBAR(); \
        QKM(PC0, PC1, 0); KRD(4); VRD(2); PKA(PP1, 0); SBAR(); \
        QKM(PC0, PC1, 1); KRD(5); VRD(3); PKB(2); SBAR(); \
        QKM(PC0, PC1, 2); KRD(6); VRD(4); PKA(PP1, 8); SBAR(); \
        QKM(PC0, PC1, 3); KRD(7); VRD(5); PKB(3); SBAR(); \
        QKM(PC0, PC1, 4); VRD(6); SBAR(); \
        QKM(PC0, PC1, 5); VRD(7); SBAR(); \
        QKM(PC0, PC1, 6); SBAR(); \
        QKM(PC0, PC1, 7); SBAR(); \
        PVM(0); VRD(8); pmx_ = PC0[0]; pmb_ = PC0[2]; MAX8(pmx_, PC0, 0); SBAR(); \
        PVM(1); VRD(9); MAX8(pmx_, PC0, 8); SBAR(); \
        PVM(2); VRD(10); MAX8(pmx_, PC1, 0); SBAR(); \
        PVM(3); VRD(11); MAX8(pmx_, PC1, 8); pmx_ = fmaxf(pmx_, pmb_); { auto rr_ = __builtin_amdgcn_permlane32_swap(__float_as_uint(pmx_), __float_as_uint(pmx_), false, false); pmx_ = fmaxf(__uint_as_float(rr_[0]), __uint_as_float(rr_[1])); } SBAR(); \
        PVM(4); VRD(12); decide<false>(pmx_, PC0, PC1, mhat, negm, al_); SBAR(); \
        PVM(5); VRD(13); EX4(PC0, 0); SBAR(); \
        PVM(6); VRD(14); EX4(PC0, 4); SBAR(); \
        PVM(7); VRD(15); EX4(PC0, 8); SBAR(); \
        PVM(8); EX4(PC0, 12); SBAR(); \
        PVM(9); EX4(PC1, 0); SBAR(); \
        PVM(10); EX4(PC1, 4); SBAR(); \
        PVM(11); EX4(PC1, 8); SBAR(); \
        PVM(12); EX4(PC1, 12); SBAR(); \
        PVM(13); l_reg = l_reg * al_ + halves_sum(ps2_.x + ps2_.y); SBAR(); \
        PVM(14); PVM(15); SBAR(); \
        ENDW(j); RESC(al_); ROT(); } while (0)
    for (int j = 1; j + 1 < NT; j += 2) {
        STEP(pB0, pB1, pA0, pA1, j);
        STEP(pA0, pA1, pB0, pB1, j + 1);
    }
    STEP(pB0, pB1, pA0, pA1, NT - 1);
    if (nKh) {
        const bf16_t* ksrcn = nKh + (long)lane * LD + wid * 8; const bf16_t* vsrcn = nVh + (long)(16 * (wid & 3) + (lane >> 2)) * LD + (wid >> 2) * 32 + (lane & 3) * 8;
#pragma unroll
        for (int t = 0; t < 3; ++t) { const long go_ = (long)t * KVBLK * LD;
            glds16(ksrcn + go_, (unsigned)__builtin_amdgcn_readfirstlane(kdst + t * SHM_K));
            glds16(vsrcn + go_, (unsigned)__builtin_amdgcn_readfirstlane(vdst0 + t * SHM_V));
            glds16(vsrcn + 64 + go_, (unsigned)__builtin_amdgcn_readfirstlane(vdst1 + t * SHM_V)); }
        const bf16_t* Qn = nQb + (long)(wid * QBLK + r32) * LD + hi * 8;
#pragma unroll
        for (int d0 = 0; d0 < 4; ++d0) qr[d0] = *reinterpret_cast<const bf16x8*>(Qn + d0 * 16); }
    { const LAS char* vp_ = V3 + vr_; unsigned ca0_, ca1_, cb0_, cb1_;
      PKA(pB0, 0); PKB(0); PKA(pB0, 8); PKB(1); PKA(pB1, 0); PKB(2); PKA(pB1, 8); PKB(3);
      VRD(0); VRD(1); VRD(2); VRD(3); VRD(4); VRD(5); VRD(6); VRD(7);
      PVM(0); VRD(8); PVM(1); VRD(9); PVM(2); VRD(10); PVM(3); VRD(11); PVM(4); VRD(12); PVM(5); VRD(13); PVM(6); VRD(14); PVM(7); VRD(15);
      PVM(8); PVM(9); PVM(10); PVM(11); PVM(12); PVM(13); PVM(14); PVM(15); }
    if (hi == 0) li_l[r32] = l_reg; asm volatile("s_waitcnt lgkmcnt(0)" ::: "memory");
#pragma unroll
    for (int r = 0; r < 16; ++r) rli[r] = __builtin_amdgcn_rcpf(li_l[crow(r, hi)]);
#undef DMA
#undef RESC
#undef ROT
#undef KRD
#undef VRD
#undef VFR
#undef QKM
#undef PVM
#undef PKA
#undef PKB
#undef MAX8
#undef EX4
#undef ENDW
#undef STEP
}
#undef WAIT_BAR
#undef KSWZ
#undef SBAR
}

template <int VAR> __device__ __forceinline__ void phase2_attn(const Args& a, char* lds, int nblk, int blk) {
    unsigned char* ws = a.ws;
    const bf16_t* Qb = (const bf16_t*)(ws + WS_Q); const bf16_t* Kb = (const bf16_t*)(ws + WS_K); const bf16_t* Vb = (const bf16_t*)(ws + WS_V);
    float* OS = (float*)(ws + WS_O0) + (size_t)blk * 32768;
    bf16_t* MIX = (bf16_t*)(ws + WS_MIX);
    const float lambda_init = 0.2f;
    float lam;
    { const int l0 = threadIdx.x & 63; const float d1 = wave_sum(a.in[3][l0] * a.in[4][l0]), d2 = wave_sum(a.in[5][l0] * a.in[6][l0]); lam = expf(d1) - expf(d2) + lambda_init; }
    const int seq = (VAR & 16384) ? SEQ / 2 : SEQ;
    bool pref = false; bf16x8 qreg[4];
    auto unit_of = [&](int i) -> int { if (nblk != 256) return blk + i * nblk; const int x = blk & 7, j = blk >> 3; return (i * 16 + 2 * x + (j >> 4)) * 16 + (j & 15); };
    const int nui = (nblk == 256) ? 2 : (NBATCH * 4 * 16 - 1 - blk + nblk) / nblk;
    for (int ui = 0; ui < nui; ++ui) {
        const int u = unit_of(ui);
        const int b = u >> 6, h = (u >> 4) & 3, qb = u & 15;
        const long row0 = (long)b * SEQ + qb * 256;
        const bf16_t* Kbh = Kb + (long)b * SEQ * 512 + h * 128; const bf16_t* Vbh = Vb + (long)b * SEQ * 512 + h * 128;
        const bool hasn = ui + 1 < nui; const int un = hasn ? unit_of(ui + 1) : 0;
        const bf16_t* Kn = hasn ? Kb + (long)(un >> 6) * SEQ * 512 + ((un >> 4) & 3) * 128 : nullptr; const bf16_t* Vn = hasn ? Vb + (long)(un >> 6) * SEQ * 512 + ((un >> 4) & 3) * 128 : nullptr;
        const bf16_t* Qn0 = hasn ? Qb + ((long)(un >> 6) * SEQ + (un & 15) * 256) * 512 + (((un >> 4) & 3) * 2) * 64 : nullptr;
        for (int m = 0; m < 2; ++m) {
            f32x16 o[4]; float rli[16];
            att::attn_pass<VAR>(Qb + row0 * 512 + (h * 2 + m) * 64, Kbh + m * 64, Vbh, seq, lds, o, rli, pref, m == 0 ? Kbh + 64 : Kn, m == 0 ? Vbh : Vn, qreg, m == 0 ? Qb + row0 * 512 + (h * 2 + 1) * 64 : Qn0);
            pref = (m == 0) || hasn;
            int tid_ = threadIdx.x; asm volatile("" : "+v"(tid_));
            const int wid = tid_ >> 6, r32 = tid_ & 31, hi = (tid_ >> 5) & 1;
            float* od = OS + (wid * 32) * 128 + r32;
            if (m == 0) {
#pragma unroll
                for (int r = 0; r < 16; ++r) { const int orow = att::crow(r, hi);
#pragma unroll
                    for (int d0 = 0; d0 < 4; ++d0) od[orow * 128 + d0 * 32] = o[d0][r] * rli[r]; }
            } else {
                float ss[16];
#pragma unroll
                for (int r = 0; r < 16; ++r) ss[r] = 0.f;
#pragma unroll
                for (int d0 = 0; d0 < 4; ++d0) {
#pragma unroll
                    for (int r = 0; r < 16; ++r) { const float v = od[att::crow(r, hi) * 128 + d0 * 32] - lam * (o[d0][r] * rli[r]); o[d0][r] = v; ss[r] = fmaf(v, v, ss[r]); }
                    asm volatile("" ::: "memory"); }
                float gs[4];
#pragma unroll
                for (int d0 = 0; d0 < 4; ++d0) gs[d0] = a.in[7][d0 * 32 + r32] * (1.0f - lambda_init);
                bf16_t* dst = MIX + (size_t)(row0 + wid * 32) * 1024 + h * 128 + r32;
#pragma unroll
                for (int r = 0; r < 16; ++r) { float s = ss[r];
                    s += __shfl_xor(s, 1); s += __shfl_xor(s, 2); s += __shfl_xor(s, 4); s += __shfl_xor(s, 8); s += __shfl_xor(s, 16);
                    const float rstd = __builtin_amdgcn_rsqf(s * (1.0f / 128.f) + EPS);
                    if (VAR == 0) {
#pragma unroll
                        for (int d0 = 0; d0 < 4; ++d0) dst[att::crow(r, hi) * 1024 + d0 * 32] = (bf16_t)pk2(o[d0][r] * rstd * gs[d0], 0.f); }
                    else if (rstd == 123.456f) dst[0] = 1; }
            }
        }
    }
}

constexpr int LRU_XS = 68;
constexpr int LRU_HS = 36;
__device__ __forceinline__ void phase2_lru(const Args& a, LAS unsigned char* lds, int nblk, int blk) {
    unsigned char* ws = a.ws;
    const bf16_t* XR = (const bf16_t*)(ws + WS_XR); const bf16_t* GG = (const bf16_t*)(ws + WS_GG);
    bf16_t* H1 = (bf16_t*)(ws + WS_HF); bf16_t* MIX = (bf16_t*)(ws + WS_MIX);
    LAS float* xcf = (LAS float*)lds;
    LAS unsigned* plm = (LAS unsigned*)(xcf + 2 * 2 * 64 * LRU_XS);
    LAS float* cmp = (LAS float*)(plm + 2 * 2 * 64 * LRU_HS);
    const int tid = threadIdx.x, lane = tid & 63, wave = __builtin_amdgcn_readfirstlane(tid >> 6);
    const int c16 = lane & 15, fq = lane >> 4;
    const int scp = tid & 31, sph = (tid >> 5) & 1, sdir = wave >> 2, sp0w = 16 * (wave & 3);
    const int dir = wave >> 2, cth = (wave >> 1) & 1, thalf = wave & 1;
    const int ic4 = tid & 7, ipos = tid >> 3, ihalf = ipos >> 5;
    for (int u = blk; u < NBATCH * 16; u += nblk) {
        const int b = u >> 4, kb = (u >> 1) & 7, chalf = u & 1;
        const bf16_t* XRb = XR + (size_t)b * SEQ * 512; const bf16_t* GGb = GG + (size_t)b * SEQ * 512; bf16_t* H1b = H1 + (size_t)b * SEQ * 512; bf16_t* MIXb = MIX + (size_t)b * SEQ * 1024;
        const int schg = kb * 64 + 2 * scp;
        f32x2 kw[4]; const f32x2 cb2 = (f32x2){a.in[9][schg], a.in[9][schg + 1]};
#pragma unroll
        for (int k = 0; k < 4; ++k) { const int kk = (sdir == 0) ? k : 3 - k; kw[k] = (f32x2){a.in[8][kk * 512 + schg], a.in[8][kk * 512 + schg + 1]}; }
        const int chl = chalf * 32 + cth * 16 + c16, chg = kb * 64 + chl;
        bf16x8 wrf[2], wif[2]; float brs, bis, kA2;
        { const float* wrp = a.in[10] + (size_t)(dir * 8 + kb) * 4096 + chl; const float* wip = a.in[12] + (size_t)(dir * 8 + kb) * 4096 + chl;
          constexpr float NL2E = -1.4426950408889634f;
          float wv[2][16];
#pragma unroll
          for (int ks = 0; ks < 2; ++ks)
#pragma unroll
              for (int j = 0; j < 8; ++j) { const int kk = 32 * ks + 8 * fq + j; wv[ks][j] = wrp[kk * 64]; wv[ks][8 + j] = wip[kk * 64]; }
          asm volatile("" : "+v"(wv[0][0]), "+v"(wv[0][1]), "+v"(wv[0][2]), "+v"(wv[0][3]), "+v"(wv[0][4]), "+v"(wv[0][5]), "+v"(wv[0][6]), "+v"(wv[0][7]),
                            "+v"(wv[0][8]), "+v"(wv[0][9]), "+v"(wv[0][10]), "+v"(wv[0][11]), "+v"(wv[0][12]), "+v"(wv[0][13]), "+v"(wv[0][14]), "+v"(wv[0][15]));
          asm volatile("" : "+v"(wv[1][0]), "+v"(wv[1][1]), "+v"(wv[1][2]), "+v"(wv[1][3]), "+v"(wv[1][4]), "+v"(wv[1][5]), "+v"(wv[1][6]), "+v"(wv[1][7]),
                            "+v"(wv[1][8]), "+v"(wv[1][9]), "+v"(wv[1][10]), "+v"(wv[1][11]), "+v"(wv[1][12]), "+v"(wv[1][13]), "+v"(wv[1][14]), "+v"(wv[1][15]));
#pragma unroll
          for (int ks = 0; ks < 2; ++ks) { u32x4 pr, pi;
              pr.x = pk2(wv[ks][0] * NL2E, wv[ks][1] * NL2E); pr.y = pk2(wv[ks][2] * NL2E, wv[ks][3] * NL2E); pr.z = pk2(wv[ks][4] * NL2E, wv[ks][5] * NL2E); pr.w = pk2(wv[ks][6] * NL2E, wv[ks][7] * NL2E);
              pi.x = pk2(wv[ks][8] * NL2E, wv[ks][9] * NL2E); pi.y = pk2(wv[ks][10] * NL2E, wv[ks][11] * NL2E); pi.z = pk2(wv[ks][12] * NL2E, wv[ks][13] * NL2E); pi.w = pk2(wv[ks][14] * NL2E, wv[ks][15] * NL2E);
              wrf[ks] = __builtin_bit_cast(bf16x8, pr); wif[ks] = __builtin_bit_cast(bf16x8, pi); }
          brs = a.in[11][dir * 512 + chg] * NL2E; bis = a.in[13][dir * 512 + chg] * NL2E;
          const float nl = -a.in[14][dir * 512 + chg];
          const float sp = (nl > 15.f) ? nl : log1pf(expf(nl));
          kA2 = -8.0f * sp * 1.4426950408889634f;
        }
        unsigned er0[11], er1[11];
        auto stage_ld = [&](int st, unsigned (&er)[11]) {
            const int t0 = (sdir == 0) ? 64 * st : 64 * (63 - st);
            if (sdir == 0) { const bf16_t* ub = XRb + kb * 64 + (long)(t0 + sp0w - 2) * 512; const int lo = sph * 4096 + 2 * scp;
#pragma unroll
                for (int i = 0; i < 11; ++i) er[i] = __builtin_nontemporal_load((const unsigned*)(ub + i * 512 + lo));
            } else { const bf16_t* ub = XRb + kb * 64 + (long)(t0 + 63 - sp0w + 1 - 8) * 512; const int lo = (1 - sph) * 4096 + 2 * scp;
#pragma unroll
                for (int i = 0; i < 11; ++i) er[i] = __builtin_nontemporal_load((const unsigned*)(ub - i * 512 + lo));
            }
        };
        auto stage_wr = [&](int st, const unsigned (&er)[11]) {
            const int stc = st < 64 ? st : 63;
            const int t0 = (sdir == 0) ? 64 * stc : 64 * (63 - stc);
            const int sgn = (sdir == 0) ? 1 : -1, tbase = (sdir == 0) ? (t0 + sp0w + 8 * sph - 2) : (t0 + 63 - sp0w - 8 * sph + 1);
            f32x2 e2[11];
            if (stc == 0 || stc == 63) {
#pragma unroll
                for (int i = 0; i < 11; ++i) { const int t = tbase + sgn * i; const bool in = (t >= 0 && t < SEQ);
                    e2[i].x = in ? __builtin_bit_cast(float, er[i] << 16) : 0.f; e2[i].y = in ? __builtin_bit_cast(float, er[i] & 0xffff0000u) : 0.f; }
            } else {
#pragma unroll
                for (int i = 0; i < 11; ++i) { e2[i].x = __builtin_bit_cast(float, er[i] << 16); e2[i].y = __builtin_bit_cast(float, er[i] & 0xffff0000u); }
            }
            LAS float* xd = xcf + ((st & 1) * 2 + sdir) * 64 * LRU_XS + (sp0w + 8 * sph) * LRU_XS + 2 * scp;
#pragma unroll
            for (int q = 0; q < 8; ++q) { const f32x2 y = cb2 + kw[0] * e2[q] + kw[1] * e2[q + 1] + kw[2] * e2[q + 2] + kw[3] * e2[q + 3];
                *(LAS f32x2*)(xd + q * LRU_XS) = y; }
        };
        const int ichg = kb * 64 + chalf * 32 + 4 * ic4;
        u32x2 hoth0[2], hoth1[2]; u32x2 ggv0[2], ggv1[2];
        f32x4 cry[2]; cry[0] = (f32x4){0.f, 0.f, 0.f, 0.f}; cry[1] = cry[0];
        auto io_ld = [&](int st, u32x2 (&hoth)[2], u32x2 (&ggv)[2]) {
#pragma unroll
            for (int d = 0; d < 2; ++d) { const int tok = (d == 0) ? 64 * st + ipos : 64 * (63 - st) + 63 - ipos;
                hoth[d] = *(const u32x2*)(H1b + (unsigned)(tok * 512 + ichg)); ggv[d] = *(const u32x2*)(GGb + (unsigned)(tok * 512 + ichg)); }
        };
        auto io_out = [&](int st, const u32x2 (&hoth)[2], const u32x2 (&ggv)[2]) {
#pragma unroll
            for (int d = 0; d < 2; ++d) { const int tok = (d == 0) ? 64 * st + ipos : 64 * (63 - st) + 63 - ipos;
                const u32x4 pl = *(const LAS u32x4*)(plm + ((st & 1) * 2 + d) * 64 * LRU_HS + ipos * LRU_HS + 4 * ic4);
                const LAS float* cp = cmp + (((st & 1) * 2 + d) * 2) * 64 + 8 * ic4;
                const f32x4 c0a = *(const LAS f32x4*)cp, c0b = *(const LAS f32x4*)(cp + 4), c1a = *(const LAS f32x4*)(cp + 64), c1b = *(const LAS f32x4*)(cp + 68);
                f32x4 cmid;
                cmid.x = fmaf(c0a.x, cry[d].x, c0a.y); cmid.y = fmaf(c0a.z, cry[d].y, c0a.w); cmid.z = fmaf(c0b.x, cry[d].z, c0b.y); cmid.w = fmaf(c0b.z, cry[d].w, c0b.w);
                const f32x4 cin = ihalf ? cmid : cry[d];
                cry[d].x = fmaf(c1a.x, cmid.x, c1a.y); cry[d].y = fmaf(c1a.z, cmid.y, c1a.w); cry[d].z = fmaf(c1b.x, cmid.z, c1b.y); cry[d].w = fmaf(c1b.z, cmid.w, c1b.w);
                f32x4 P, L;
                P.x = __builtin_bit_cast(float, pl.x << 16); L.x = __builtin_bit_cast(float, pl.x & 0xffff0000u); P.y = __builtin_bit_cast(float, pl.y << 16); L.y = __builtin_bit_cast(float, pl.y & 0xffff0000u);
                P.z = __builtin_bit_cast(float, pl.z << 16); L.z = __builtin_bit_cast(float, pl.z & 0xffff0000u); P.w = __builtin_bit_cast(float, pl.w << 16); L.w = __builtin_bit_cast(float, pl.w & 0xffff0000u);
                const f32x4 h = P * cin + L;
                if (st < 32) store_bf16x4(H1b + (unsigned)(tok * 512 + ichg), h);
                else { f32x4 g; g.x = __builtin_bit_cast(float, ggv[d].x << 16); g.y = __builtin_bit_cast(float, ggv[d].x & 0xffff0000u); g.z = __builtin_bit_cast(float, ggv[d].y << 16); g.w = __builtin_bit_cast(float, ggv[d].y & 0xffff0000u);
                    f32x4 ho; ho.x = __builtin_bit_cast(float, hoth[d].x << 16); ho.y = __builtin_bit_cast(float, hoth[d].x & 0xffff0000u); ho.z = __builtin_bit_cast(float, hoth[d].y << 16); ho.w = __builtin_bit_cast(float, hoth[d].y & 0xffff0000u);
                    store_bf16x4(MIXb + (unsigned)(tok * 1024 + 512 + ichg), (h + ho) * g); } }
        };
        auto body = [&](int s, bool second, unsigned (&er)[11], u32x2 (&hoth)[2], u32x2 (&ggv)[2]) {
            stage_wr(s + 1, er);
            stage_ld(s + 3 < 64 ? s + 3 : 63, er);
            if (s < 64) {
                const LAS float* xb = xcf + ((s & 1) * 2 + dir) * 64 * LRU_XS;
                LAS unsigned* pb = plm + ((s & 1) * 2 + dir) * 64 * LRU_HS + cth * 16 + c16;
                float TA1 = 1.f, TH1 = 0.f;
#pragma unroll
                for (int t2 = 0; t2 < 2; ++t2) { const int tt = 2 * thalf + t2;
                    f32x4 ra = (f32x4){0.f, 0.f, 0.f, 0.f}, ia = (f32x4){0.f, 0.f, 0.f, 0.f};
#pragma unroll
                    for (int ks = 0; ks < 2; ++ks) { const LAS f32x4* xp = (const LAS f32x4*)(xb + (16 * tt + c16) * LRU_XS + 32 * ks + 8 * fq);
                        const f32x4 x0 = xp[0], x1 = xp[1]; u32x4 pa; pa.x = pk2(x0.x, x0.y); pa.y = pk2(x0.z, x0.w); pa.z = pk2(x1.x, x1.y); pa.w = pk2(x1.z, x1.w);
                        const bf16x8 af = __builtin_bit_cast(bf16x8, pa);
                        ra = __builtin_amdgcn_mfma_f32_16x16x32_bf16(af, wrf[ks], ra, 0, 0, 0);
                        ia = __builtin_amdgcn_mfma_f32_16x16x32_bf16(af, wif[ks], ia, 0, 0, 0); }
                    float Ap[4], Hp[4];
#pragma unroll
                    for (int j = 0; j < 4; ++j) { const float xv = xb[(16 * tt + 4 * fq + j) * LRU_XS + chl];
                        const float r = __builtin_amdgcn_rcpf(1.0f + __builtin_amdgcn_exp2f(ra[j] + brs));
                        const float ig = __builtin_amdgcn_rcpf(1.0f + __builtin_amdgcn_exp2f(ia[j] + bis));
                        const float aa = __builtin_amdgcn_exp2f(kA2 * r);
                        const float uv = __builtin_amdgcn_sqrtf(fmaxf(1.0f - aa * aa, 0.f)) * (ig * xv);
                        if (j == 0) { Ap[0] = aa; Hp[0] = uv; } else { Ap[j] = aa * Ap[j - 1]; Hp[j] = fmaf(aa, Hp[j - 1], uv); } }
                    float Ag = Ap[3], Hg = Hp[3];
                    { const float A1 = __shfl_up(Ag, 16), Hs1 = __shfl_up(Hg, 16); if (fq >= 1) { Hg = fmaf(Ag, Hs1, Hg); Ag = Ag * A1; } }
                    { const float A2 = __shfl_up(Ag, 32), Hs2 = __shfl_up(Hg, 32); if (fq >= 2) { Hg = fmaf(Ag, Hs2, Hg); Ag = Ag * A2; } }
                    float EA = __shfl_up(Ag, 16), EH = __shfl_up(Hg, 16); if (fq == 0) { EA = 1.f; EH = 0.f; }
                    const float TA = __shfl(Ag, 48 + c16), TH = __shfl(Hg, 48 + c16);
#pragma unroll
                    for (int j = 0; j < 4; ++j) { const float Pt = Ap[j] * EA, Lt = fmaf(Ap[j], EH, Hp[j]);
                        const float Ph = Pt * TA1, Lh = fmaf(Pt, TH1, Lt);
                        pb[(16 * tt + 4 * fq + j) * LRU_HS] = pk2(Ph, Lh); }
                    if (t2 == 0) { TA1 = TA; TH1 = TH; }
                    else if (fq == 0) { LAS float* cw = cmp + ((((s & 1) * 2 + dir) * 2 + thalf) * 32 + cth * 16 + c16) * 2; cw[0] = TA * TA1; cw[1] = fmaf(TA, TH1, TH); }
                }
            }
            if (s >= 1) io_out(s - 1, hoth, ggv);
            if (second) io_ld(s + 1 < 64 ? s + 1 : 63, hoth, ggv);
            __syncthreads();
        };
        __syncthreads();
        stage_ld(0, er0); stage_wr(0, er0); stage_ld(1, er1); stage_ld(2, er0);
        __syncthreads();
        body(0, false, er1, hoth1, ggv1);
        for (int s = 1; s <= 31; s += 2) { body(s, false, er0, hoth0, ggv0); body(s + 1, false, er1, hoth1, ggv1); }
        io_ld(32, hoth0, ggv0); io_ld(33, hoth1, ggv1);
        for (int s = 33; s <= 63; s += 2) { body(s, true, er0, hoth0, ggv0); body(s + 1, true, er1, hoth1, ggv1); }
    }
}

struct EpiOutProj {
    static constexpr bool PERM = true;
    const float* x; bf16_t* X1;
    __device__ __forceinline__ void operator()(const f32x4 (&acc)[2][2][4][2], const pg8::Unit& u, int wr, int wc, int fr, int fq) const {
        const int row0 = u.pm * 256 + wr * 64 + fr, col0 = u.pn * 256 + wc * 32 + 8 * fq;
#pragma unroll
        for (int ai = 0; ai < 2; ++ai)
#pragma unroll
            for (int m = 0; m < 4; ++m) { const size_t rowoff = (size_t)(row0 + ai * 128 + m * 16) * DM + col0;
#pragma unroll
                for (int bj = 0; bj < 2; ++bj) { const size_t off = rowoff + bj * 128;
                    const f32x4 v0 = __builtin_nontemporal_load((const f32x4*)(x + off)) + acc[ai][bj][m][0], v1 = __builtin_nontemporal_load((const f32x4*)(x + off + 4)) + acc[ai][bj][m][1];
                    u32x4 w; w.x = pk2(v0.x, v0.y); w.y = pk2(v0.z, v0.w); w.z = pk2(v1.x, v1.y); w.w = pk2(v1.z, v1.w);
                    *(u32x4*)(X1 + off) = w; } }
    }
};
__device__ __forceinline__ void phase3(const Args& a, LAS unsigned char* lds, int nblk, int blk) {
    unsigned char* ws = a.ws;
    pg8::DenseOrder S; S.init(ws + WS_MIX, ws + WS_WOUT, MTOK, DM, DM, nblk, blk);
    EpiOutProj E{a.in[0], (bf16_t*)(ws + WS_X1)};
    pg8::gemm_phase(lds, DM, S, E);
}

#define WAIT_BAR(N) asm volatile("s_waitcnt vmcnt(" #N ") lgkmcnt(0)\n\ts_barrier" ::: "memory")
constexpr int P4_SLOT = 24 * 1024, P4_WL_OFF = 4 * P4_SLOT, P4_CNT_OFF = P4_WL_OFF + 8 * 16 * 52 * 4, P4_G2_OFF = P4_CNT_OFF + 512;
template <bool DUMMY> __device__ __forceinline__ void phase4(const Args& a, LAS unsigned char* lds, int nblk, int blk) {
    unsigned char* ws = a.ws;
    const bf16_t* X1 = (const bf16_t*)(ws + WS_X1); const float* g2 = a.in[16]; bf16_t* H2 = (bf16_t*)(ws + WS_XN);
    const bf16_t* WRH = (const bf16_t*)(ws + WS_WRH); const bf16_t* WRL = (const bf16_t*)(ws + WS_WRL);
    int* cnt = (int*)(ws + WS_CTL); int* LIST = (int*)(ws + WS_LIST); float* EW = (float*)(ws + WS_EW);
    const int tid = threadIdx.x, lane = tid & 63, wave = __builtin_amdgcn_readfirstlane(tid >> 6), r16 = lane & 15, kg = lane >> 4;
    LAS float* wl = (LAS float*)(lds + P4_WL_OFF) + wave * (16 * 52);
    LAS int* lcnt = (LAS int*)(lds + P4_CNT_OFF); LAS int* lbase = lcnt + 32;
    const unsigned ldsb = (unsigned)(uintptr_t)lds;
    const bf16_t* dsrc[3]; unsigned ddst[3];
#pragma unroll
    for (int i = 0; i < 3; ++i) { const int fb = 3 * wave + i, ksl = fb / 6, rem = fb - 6 * ksl, nt = rem >> 1, hl = rem & 1;
        dsrc[i] = (hl ? WRL : WRH) + (size_t)(16 * nt + r16) * DM + 32 * ksl + 8 * kg; ddst[i] = ldsb + fb * 1024; }
#define P4_DMA(c) do { _Pragma("unroll") for (int i_ = 0; i_ < 3; ++i_) att::glds16(dsrc[i_] + 128 * (c), (unsigned)__builtin_amdgcn_readfirstlane(ddst[i_] + ((c) & 3) * P4_SLOT)); } while (0)
    constexpr int NTILE = MTOK / 16;
    const int nit = (NTILE + nblk * 8 - 1) / (nblk * 8);
    for (int it = 0; it < nit; ++it) {
        const int t_ = (it * nblk + blk) * 8 + wave; const bool valid = t_ < NTILE; const int t = valid ? t_ : NTILE - 1;
        if (tid < NEXP) lcnt[tid] = 0;
        if (wave < 4) att::glds16(g2 + wave * 256 + lane * 4, (unsigned)__builtin_amdgcn_readfirstlane(ldsb + P4_G2_OFF + wave * 1024));
        P4_DMA(0); P4_DMA(1); P4_DMA(2); P4_DMA(3);
        const bf16_t* xp = X1 + (size_t)(t * 16 + r16) * DM + 8 * kg;
        u32x4 xv[32];
#pragma unroll
        for (int ks = 0; ks < 32; ++ks) xv[ks] = __builtin_nontemporal_load((const u32x4*)(xp + 32 * ks));
        f32x4 acc[3]; acc[0] = (f32x4){0.f, 0.f, 0.f, 0.f}; acc[1] = acc[0]; acc[2] = acc[0];
        float ss = 0.f;
#pragma unroll
        for (int c = 0; c < 8; ++c) {
            if (c == 0) WAIT_BAR(28); else if (c == 1) WAIT_BAR(24); else if (c == 2) WAIT_BAR(23); else if (c == 3) WAIT_BAR(22);
            else if (c == 4 || c == 5) WAIT_BAR(6); else if (c == 6) WAIT_BAR(3); else WAIT_BAR(0);
            if (c >= 1 && c + 3 < 8) P4_DMA(c + 3);
            const LAS unsigned char* bb = lds + (c & 3) * P4_SLOT + lane * 16;
#pragma unroll
            for (int kl = 0; kl < 4; ++kl) { const u32x4 xw = xv[4 * c + kl];
                const float f0 = __builtin_bit_cast(float, xw.x << 16), f1 = __builtin_bit_cast(float, xw.x & 0xffff0000u), f2 = __builtin_bit_cast(float, xw.y << 16), f3 = __builtin_bit_cast(float, xw.y & 0xffff0000u);
                const float f4 = __builtin_bit_cast(float, xw.z << 16), f5 = __builtin_bit_cast(float, xw.z & 0xffff0000u), f6 = __builtin_bit_cast(float, xw.w << 16), f7 = __builtin_bit_cast(float, xw.w & 0xffff0000u);
                ss += (f0 * f0 + f1 * f1) + (f2 * f2 + f3 * f3) + (f4 * f4 + f5 * f5) + (f6 * f6 + f7 * f7);
                const bf16x8 ah = __builtin_bit_cast(bf16x8, xw);
#pragma unroll
                for (int nt = 0; nt < 3; ++nt) {
                    const bf16x8 bh = *(const LAS bf16x8*)(bb + (kl * 6 + nt * 2 + 0) * 1024), bl = *(const LAS bf16x8*)(bb + (kl * 6 + nt * 2 + 1) * 1024);
                    acc[nt] = __builtin_amdgcn_mfma_f32_16x16x32_bf16(ah, bh, acc[nt], 0, 0, 0);
                    acc[nt] = __builtin_amdgcn_mfma_f32_16x16x32_bf16(ah, bl, acc[nt], 0, 0, 0); } }
        }
        ss += __shfl_xor(ss, 16); ss += __shfl_xor(ss, 32);
        const float rstd = 1.0f / sqrtf(ss * (1.0f / DM) + EPS);
#pragma unroll
        for (int nt = 0; nt < 3; ++nt)
#pragma unroll
            for (int j = 0; j < 4; ++j) wl[(4 * kg + j) * 52 + 16 * nt + r16] = acc[nt][j];
        if (kg == 0) wl[r16 * 52 + 48] = rstd;
        if (valid) { bf16_t* hp = H2 + (size_t)(t * 16 + r16) * DM + 8 * kg;
#pragma unroll
          for (int ks = 0; ks < 32; ++ks) { const LAS f32x4* gp4 = (const LAS f32x4*)(lds + P4_G2_OFF) + 2 * kg + 8 * ks; const f32x4 ga = gp4[0], gb = gp4[1]; u32x4 xw = xv[ks]; asm volatile("" : "+v"(xw));
              u32x4 w;
              w.x = pk2(__builtin_bit_cast(float, xw.x << 16) * rstd * ga.x, __builtin_bit_cast(float, xw.x & 0xffff0000u) * rstd * ga.y);
              w.y = pk2(__builtin_bit_cast(float, xw.y << 16) * rstd * ga.z, __builtin_bit_cast(float, xw.y & 0xffff0000u) * rstd * ga.w);
              w.z = pk2(__builtin_bit_cast(float, xw.z << 16) * rstd * gb.x, __builtin_bit_cast(float, xw.z & 0xffff0000u) * rstd * gb.y);
              w.w = pk2(__builtin_bit_cast(float, xw.w << 16) * rstd * gb.z, __builtin_bit_cast(float, xw.w & 0xffff0000u) * rstd * gb.w);
              *(u32x4*)(hp + 32 * ks) = w;
              if ((ks & 3) == 3) asm volatile("" ::: "memory"); } }
        asm volatile("s_waitcnt lgkmcnt(0)" ::: "memory");
        __builtin_amdgcn_wave_barrier();
        int ea = 0, eb = 0, ra = 0, rb = 0, rowg = 0; float w1 = 0.f, w2 = 0.f;
        const bool act = !DUMMY && valid && lane < 16;
        if (act) {
            const LAS float* tr = wl + lane * 52; const float rsd = tr[48];
            const float g0 = tr[0] * rsd, g1 = tr[1] * rsd, g2l = tr[2] * rsd, g3 = tr[3] * rsd;
            int gi = 0; float gm = g0;
            if (g1 > gm) { gm = g1; gi = 1; } if (g2l > gm) { gm = g2l; gi = 2; } if (g3 > gm) { gm = g3; gi = 3; }
            const float gp = 1.0f / (expf(g0 - gm) + expf(g1 - gm) + expf(g2l - gm) + expf(g3 - gm));
            const LAS float* ep = tr + 4 + gi * 8;
            int i1 = 0; float l1 = ep[0] * rsd;
            for (int j = 1; j < 8; ++j) { const float v = ep[j] * rsd; if (v > l1) { l1 = v; i1 = j; } }
            int i2 = -1; float l2 = -3.0e38f;
            for (int j = 0; j < 8; ++j) { const float v = ep[j] * rsd; if (j != i1 && v > l2) { l2 = v; i2 = j; } }
            const float e2 = expf(l2 - l1); w1 = gp / (1.0f + e2); w2 = gp * e2 / (1.0f + e2);
            rowg = t * 16 + lane; ea = gi * 8 + i1; eb = gi * 8 + i2;
            ra = __hip_atomic_fetch_add((int*)(lcnt + ea), 1, __ATOMIC_RELAXED, __HIP_MEMORY_SCOPE_WORKGROUP); rb = __hip_atomic_fetch_add((int*)(lcnt + eb), 1, __ATOMIC_RELAXED, __HIP_MEMORY_SCOPE_WORKGROUP);
        }
        __syncthreads();
        if (tid < NEXP) { const int n = lcnt[tid]; lbase[tid] = (n > 0) ? atomicAdd(&cnt[tid * 64], n) : 0; }
        __syncthreads();
        if (act) {
            LIST[(size_t)ea * MTOK + lbase[ea] + ra] = rowg * 2 + 0; EW[rowg * 2 + 0] = w1;
            LIST[(size_t)eb * MTOK + lbase[eb] + rb] = rowg * 2 + 1; EW[rowg * 2 + 1] = w2;
        }
        if (it + 1 < nit) __syncthreads();
    }
#undef P4_DMA
}

constexpr int MOE_TAB_OFF = 131072;
constexpr int MOE_MAXT = 320;
__device__ __forceinline__ int moe_build_table(const int* cnt, LAS int* tab) {
    __syncthreads();
    if (threadIdx.x < 64) {
        const int e = threadIdx.x, n = (e < NEXP) ? cnt[e * 64] : 0, mt = (n + 255) >> 8;
        int incl = mt;
#pragma unroll
        for (int d = 1; d < 64; d <<= 1) { const int o = __shfl_up(incl, d); if (e >= d) incl += o; }
        const int base = incl - mt;
        for (int m = 0; m < mt; ++m) { const int t = base + m; if (t < MOE_MAXT) { tab[3 * t] = e | (m << 8); tab[3 * t + 1] = (base + m) * 256; tab[3 * t + 2] = (n - m * 256) < 256 ? (n - m * 256) : 256; } }
        if (e == 63) tab[3 * MOE_MAXT] = incl < MOE_MAXT ? incl : MOE_MAXT; }
    __syncthreads();
    return tab[3 * MOE_MAXT];
}
struct MoeOrder1 {
    const char* H2; const char* W; const int* LIST; LAS const int* tab; int nunits, G, c;
    __device__ __forceinline__ bool next(int i, pg8::Unit& u) const {
        const int L = i * G + c; if (L >= nunits) return false;
        const int t = L >> 1; const int em = tab[3 * t]; u.e = em & 255; u.pm = em >> 8; u.pn = L & 1; u.seg = tab[3 * t + 1]; u.nrows = tab[3 * t + 2];
        u.A = H2; u.B = W + ((size_t)(u.e * 512 + u.pn * 256) * DM) * 2; return true;
    }
    __device__ __forceinline__ unsigned a_row(const pg8::Unit& u, int r, int K_) const { const int tok = (r < u.nrows) ? (LIST[(size_t)u.e * MTOK + u.pm * 256 + r] >> 1) : 0; return (unsigned)(tok * K_) * 2u; }
};
struct EpiMoe1 {
    static constexpr bool PERM = true;
    bf16_t* HID;
    __device__ __forceinline__ void operator()(const f32x4 (&acc)[2][2][4][2], const pg8::Unit& u, int wr, int wc, int fr, int fq) const {
        const int col0 = u.pn * 128 + wc * 32 + 8 * fq;
#pragma unroll
        for (int ai = 0; ai < 2; ++ai)
#pragma unroll
            for (int m = 0; m < 4; ++m) { const int r = ai * 128 + wr * 64 + m * 16 + fr;
                const f32x4 g0 = acc[ai][0][m][0], g1 = acc[ai][0][m][1], u0 = acc[ai][1][m][0], u1 = acc[ai][1][m][1];
                f32x4 h0, h1;
                h0.x = g0.x * sigmoidf_(g0.x) * u0.x; h0.y = g0.y * sigmoidf_(g0.y) * u0.y; h0.z = g0.z * sigmoidf_(g0.z) * u0.z; h0.w = g0.w * sigmoidf_(g0.w) * u0.w;
                h1.x = g1.x * sigmoidf_(g1.x) * u1.x; h1.y = g1.y * sigmoidf_(g1.y) * u1.y; h1.z = g1.z * sigmoidf_(g1.z) * u1.z; h1.w = g1.w * sigmoidf_(g1.w) * u1.w;
                u32x4 w; w.x = pk2(h0.x, h0.y); w.y = pk2(h0.z, h0.w); w.z = pk2(h1.x, h1.y); w.w = pk2(h1.z, h1.w);
                *(u32x4*)(HID + (size_t)(u.seg + r) * DEXP + col0) = w; }
    }
};
struct MoeOrder2 {
    const char* HID; const char* W; LAS const int* tab; int nunits, G, c;
    __device__ __forceinline__ bool next(int i, pg8::Unit& u) const {
        const int L = i * G + c; if (L >= nunits) return false;
        const int t = L >> 2; const int em = tab[3 * t]; u.e = em & 255; u.pm = em >> 8; u.pn = L & 3; u.seg = tab[3 * t + 1]; u.nrows = tab[3 * t + 2];
        u.A = HID + (size_t)u.seg * DEXP * 2; u.B = W + ((size_t)(u.e * DM + u.pn * 256) * DEXP) * 2; return true;
    }
    __device__ __forceinline__ unsigned a_row(const pg8::Unit&, int r, int K_) const { return (unsigned)(r * K_) * 2u; }
};
struct EpiMoe2 {
    static constexpr bool PERM = true;
    bf16_t* Y; const int* LIST;
    __device__ __forceinline__ void operator()(const f32x4 (&acc)[2][2][4][2], const pg8::Unit& u, int wr, int wc, int fr, int fq) const {
        const int col0 = u.pn * 256 + wc * 32 + 8 * fq;
        const int* lp = LIST + (size_t)u.e * MTOK + u.pm * 256;
        int dst[2][4];
#pragma unroll
        for (int ai = 0; ai < 2; ++ai)
#pragma unroll
            for (int m = 0; m < 4; ++m) { const int r = ai * 128 + wr * 64 + m * 16 + fr; dst[ai][m] = (r < u.nrows) ? lp[r] : -1; }
#pragma unroll
        for (int ai = 0; ai < 2; ++ai)
#pragma unroll
            for (int m = 0; m < 4; ++m) {
                if (dst[ai][m] >= 0) {
#pragma unroll
                    for (int bj = 0; bj < 2; ++bj) { const f32x4 v0 = acc[ai][bj][m][0], v1 = acc[ai][bj][m][1];
                        u32x4 w; w.x = pk2(v0.x, v0.y); w.y = pk2(v0.z, v0.w); w.z = pk2(v1.x, v1.y); w.w = pk2(v1.z, v1.w);
                        *(u32x4*)(Y + ((unsigned)dst[ai][m] * (unsigned)DM + (unsigned)(col0 + bj * 128))) = w; } } }
    }
};
constexpr int MOE_FLAG_OFF = 32768, MOE_FLAG_STRIDE = 16;
constexpr int MOE_TICKET_OFF = 31744;
constexpr int MOE_TKBUF_OFF = MOE_TAB_OFF + 3904;
struct MoeOrderM {
    const char* H2; const char* WGU; const char* HID; const char* WD; const int* LIST; LAS const int* tab; unsigned* flags; unsigned* ticket; volatile LAS unsigned* tkbuf; int n1, n2, G, c;
    mutable int L2n; mutable unsigned pfv, pfc; mutable unsigned tq;
    __device__ __forceinline__ bool next(int i, pg8::Unit& u) const {
        const int k = n1 / G, r1 = n1 - k * G, k1 = k + (c < r1 ? 1 : 0);
        if (i < k1) {
            const int L = i * G + c, t = L >> 1; const int em = tab[3 * t]; u.e = em & 255; u.pm = em >> 8; u.pn = L & 1; u.seg = tab[3 * t + 1]; u.nrows = tab[3 * t + 2];
            u.A = H2; u.B = WGU + ((size_t)(u.e * 512 + u.pn * 256) * DM) * 2; u.K = DM; u.typ = 0; u.tix = t;
        } else {
            const int L2 = L2n; if (L2 >= n2) return false;
            const int t = L2 >> 2; const int em = tab[3 * t]; u.e = em & 255; u.pm = em >> 8; u.pn = L2 & 3; u.seg = tab[3 * t + 1]; u.nrows = tab[3 * t + 2];
            u.A = HID + (size_t)u.seg * DEXP * 2; u.B = WD + ((size_t)(u.e * DM + u.pn * 256) * DEXP) * 2; u.K = DEXP; u.typ = 1; u.tix = t;
            pfc = pfv;
        }
        const int i1 = i + 1;
        if (i1 >= k1) {
            int L2x;
            if (i1 == k1) L2x = (r1 > 0) ? (c >= r1 ? c - r1 : (G - r1) + c) : c;
            else { volatile LAS unsigned* slot = tkbuf + (i1 & 1);
                if (threadIdx.x == 0) *slot = ((unsigned)i1 << 20) | (tq & 0xFFFFFu);
                unsigned v, sp = 0; do { v = *slot; } while ((v >> 20) != (unsigned)i1 && ++sp < (1u << 24));
                L2x = G + (int)(v & 0xFFFFFu); }
            L2n = L2x;
            pfv = (L2x < n2) ? __hip_atomic_load(flags + (L2x >> 2) * MOE_FLAG_STRIDE, __ATOMIC_RELAXED, __HIP_MEMORY_SCOPE_AGENT) : 0u;
        }
        if (i + 2 > k1 && threadIdx.x == 0) tq = __hip_atomic_fetch_add(ticket, 1u, __ATOMIC_RELAXED, __HIP_MEMORY_SCOPE_AGENT);
        return true;
    }
    __device__ __forceinline__ void wait_ready(const pg8::Unit& u) const {
        if (u.typ == 1 && pfc < 16u) { unsigned* f = flags + u.tix * MOE_FLAG_STRIDE; unsigned spins = 0;
            while (__hip_atomic_load(f, __ATOMIC_RELAXED, __HIP_MEMORY_SCOPE_AGENT) < 16u) { __builtin_amdgcn_s_sleep(8); if (++spins > (1u << 22)) break; }
            __builtin_amdgcn_fence(__ATOMIC_ACQUIRE, "agent"); }
    }
    __device__ __forceinline__ int row_of(const pg8::Unit& u, int r) const {
        if (u.typ == 0) { const int rr = (r < u.nrows) ? r : 0; return LIST[(size_t)u.e * MTOK + u.pm * 256 + rr] >> 1; }
        return r; }
    __device__ __forceinline__ unsigned a_row(const pg8::Unit& u, int r, int K_) const {
        if (u.typ == 0) { const int tok = (r < u.nrows) ? (LIST[(size_t)u.e * MTOK + u.pm * 256 + r] >> 1) : 0; return (unsigned)(tok * K_) * 2u; }
        return (unsigned)(r * K_) * 2u; }
};
__device__ __forceinline__ void st16_sc1(void* p, u32x4 v) { asm volatile("global_store_dwordx4 %0, %1, off sc1\n\ts_nop 1" :: "v"(p), "v"(v) : "memory"); }
struct EpiMoeM {
    static constexpr bool PERM = true;
    bf16_t* HID; bf16_t* Y; const int* LIST; unsigned* flags;
    __device__ __forceinline__ void operator()(const f32x4 (&acc)[2][2][4][2], const pg8::Unit& u, int wr, int wc, int fr, int fq) const {
        if (u.typ == 0) {
            const int col0 = u.pn * 128 + wc * 32 + 8 * fq;
#pragma unroll
            for (int ai = 0; ai < 2; ++ai)
#pragma unroll
                for (int m = 0; m < 4; ++m) { const int r = ai * 128 + wr * 64 + m * 16 + fr;
                    const f32x4 g0 = acc[ai][0][m][0], g1 = acc[ai][0][m][1], u0 = acc[ai][1][m][0], u1 = acc[ai][1][m][1];
                    f32x4 h0, h1;
                    h0.x = g0.x * sigmoidf_(g0.x) * u0.x; h0.y = g0.y * sigmoidf_(g0.y) * u0.y; h0.z = g0.z * sigmoidf_(g0.z) * u0.z; h0.w = g0.w * sigmoidf_(g0.w) * u0.w;
                    h1.x = g1.x * sigmoidf_(g1.x) * u1.x; h1.y = g1.y * sigmoidf_(g1.y) * u1.y; h1.z = g1.z * sigmoidf_(g1.z) * u1.z; h1.w = g1.w * sigmoidf_(g1.w) * u1.w;
                    u32x4 w; w.x = pk2(h0.x, h0.y); w.y = pk2(h0.z, h0.w); w.z = pk2(h1.x, h1.y); w.w = pk2(h1.z, h1.w);
                    st16_sc1(HID + (size_t)(u.seg + r) * DEXP + col0, w); }
            asm volatile("s_waitcnt vmcnt(0)" ::: "memory");
            if ((threadIdx.x & 63) == 0) __hip_atomic_fetch_add(flags + u.tix * MOE_FLAG_STRIDE, 1u, __ATOMIC_RELAXED, __HIP_MEMORY_SCOPE_AGENT);
        } else {
            const int col0 = u.pn * 256 + wc * 32 + 8 * fq;
            const int* lp = LIST + (size_t)u.e * MTOK + u.pm * 256;
            int dst[2][4];
#pragma unroll
            for (int ai = 0; ai < 2; ++ai)
#pragma unroll
                for (int m = 0; m < 4; ++m) { const int r = ai * 128 + wr * 64 + m * 16 + fr; dst[ai][m] = (r < u.nrows) ? lp[r] : -1; }
#pragma unroll
            for (int ai = 0; ai < 2; ++ai)
#pragma unroll
                for (int m = 0; m < 4; ++m) {
                    if (dst[ai][m] >= 0) {
#pragma unroll
                        for (int bj = 0; bj < 2; ++bj) { const f32x4 v0 = acc[ai][bj][m][0], v1 = acc[ai][bj][m][1];
                            u32x4 w; w.x = pk2(v0.x, v0.y); w.y = pk2(v0.z, v0.w); w.z = pk2(v1.x, v1.y); w.w = pk2(v1.z, v1.w);
                            *(u32x4*)(Y + ((unsigned)dst[ai][m] * (unsigned)DM + (unsigned)(col0 + bj * 128))) = w; } } }
        }
    }
};
__device__ __forceinline__ void phase56(const Args& a, LAS unsigned char* lds, int nblk, int blk) {
    unsigned char* ws = a.ws;
    LAS int* tab = (LAS int*)(lds + MOE_TAB_OFF);
    volatile LAS unsigned* tkbuf = (volatile LAS unsigned*)(lds + MOE_TKBUF_OFF);
    if (threadIdx.x < 2) tkbuf[threadIdx.x] = 0xFFFFFFFFu;
    const int nt = moe_build_table((const int*)(ws + WS_CTL), tab);
    const int vcu = (nblk % 8 == 0) ? (blk % 8) * (nblk / 8) + blk / 8 : blk;
    unsigned* flags = (unsigned*)(ws + WS_CTL + MOE_FLAG_OFF);
    MoeOrderM S{(const char*)(ws + WS_XN), (const char*)(ws + WS_WGU), (const char*)(ws + WS_HID), (const char*)(ws + WS_WD), (const int*)(ws + WS_LIST), tab, flags,
                (unsigned*)(ws + WS_CTL + MOE_TICKET_OFF), tkbuf, nt * 2, nt * 4, nblk, vcu, 0, 0u, 0u, 0u};
    EpiMoeM E{(bf16_t*)(ws + WS_HID), (bf16_t*)(ws + WS_Y), (const int*)(ws + WS_LIST), flags};
    pg8::gemm_phase_vk(lds, S, E);
}

template <bool DUMMY> __device__ __forceinline__ void phase7(const Args& a, int lane, int gw, int NGW) {
    unsigned char* ws = a.ws;
    float* out = a.out; const bf16_t* X1 = (const bf16_t*)(ws + WS_X1); const bf16_t* Y = (const bf16_t*)(ws + WS_Y); const float* EW = (const float*)(ws + WS_EW); const float* gf = a.in[22];
    f32x4 gv[4];
#pragma unroll
    for (int j = 0; j < 4; ++j) gv[j] = ((const f32x4*)gf)[lane + 64 * j];
    u32x2 xn[4]; u32x2 y0n[4], y1n[4]; float w0n, w1n;
    auto ld = [&](int m) {
        const u32x2* xr = (const u32x2*)(X1 + (size_t)m * DM) + lane;
        const u32x2* y0 = (const u32x2*)(Y + (size_t)(2 * m) * DM) + lane; const u32x2* y1 = (const u32x2*)(Y + (size_t)(2 * m + 1) * DM) + lane;
#pragma unroll
        for (int j = 0; j < 4; ++j) { xn[j] = __builtin_nontemporal_load(xr + 64 * j); y0n[j] = __builtin_nontemporal_load(y0 + 64 * j); y1n[j] = __builtin_nontemporal_load(y1 + 64 * j); }
        w0n = EW[2 * m]; w1n = EW[2 * m + 1];
    };
    if (gw < MTOK) ld(gw);
    for (int m = gw; m < MTOK; m += NGW) {
        f32x4 xv[4]; u32x2 a0[4], a1[4];
#pragma unroll
        for (int j = 0; j < 4; ++j) { xv[j].x = __builtin_bit_cast(float, xn[j].x << 16); xv[j].y = __builtin_bit_cast(float, xn[j].x & 0xffff0000u); xv[j].z = __builtin_bit_cast(float, xn[j].y << 16); xv[j].w = __builtin_bit_cast(float, xn[j].y & 0xffff0000u); a0[j] = y0n[j]; a1[j] = y1n[j]; }
        const float w0 = w0n, w1 = w1n;
        ld(m + NGW < MTOK ? m + NGW : m);
        f32x4 v[4]; float s = 0.f;
#pragma unroll
        for (int j = 0; j < 4; ++j) { f32x4 t;
            t.x = xv[j].x + w0 * __builtin_bit_cast(float, a0[j].x << 16) + w1 * __builtin_bit_cast(float, a1[j].x << 16);
            t.y = xv[j].y + w0 * __builtin_bit_cast(float, a0[j].x & 0xffff0000u) + w1 * __builtin_bit_cast(float, a1[j].x & 0xffff0000u);
            t.z = xv[j].z + w0 * __builtin_bit_cast(float, a0[j].y << 16) + w1 * __builtin_bit_cast(float, a1[j].y << 16);
            t.w = xv[j].w + w0 * __builtin_bit_cast(float, a0[j].y & 0xffff0000u) + w1 * __builtin_bit_cast(float, a1[j].y & 0xffff0000u);
            v[j] = t; s += (t.x * t.x + t.y * t.y) + (t.z * t.z + t.w * t.w); }
        s = wave_sum(s);
        const float rstd = 1.0f / sqrtf(s * (1.0f / DM) + EPS);
        f32x4* o = (f32x4*)(out + (size_t)m * DM) + lane;
#pragma unroll
        for (int j = 0; j < 4; ++j) { if (!DUMMY || rstd == 123.4567f) __builtin_nontemporal_store(v[j] * rstd * gv[j], o + 64 * j); }
    }
}

#define XB_TMO      128
#define XB_XCNT(j)  (256  + 64 * (j))
#define XB_XSUB(j)  (1280 + 64 * (j))
#define XB_XGEN(j)  (2304 + 64 * (j))
#define XB_TOP      3328
#define XB_TOPGEN   3392
#define XCD_BAR_WORDS 3456
#define XB_SPIN_CAP (1u << 22)
__device__ __forceinline__ unsigned xb_ld(unsigned* p)              { return __hip_atomic_load(p, __ATOMIC_RELAXED, __HIP_MEMORY_SCOPE_AGENT); }
__device__ __forceinline__ unsigned xb_add(unsigned* p, unsigned v) { return __hip_atomic_fetch_add(p, v, __ATOMIC_RELAXED, __HIP_MEMORY_SCOPE_AGENT); }
__device__ __forceinline__ unsigned xb_xcc_id() { return (unsigned)__builtin_amdgcn_s_getreg((3 << 11) | 20) & 0xFu; }
#define XB_SPIN(cond, bar) do { unsigned _sp = 0; while (cond) { \
    if ((++_sp & 255u) == 0u) { if (xb_ld(&(bar)[XB_TMO])) break; if (_sp > XB_SPIN_CAP) { atomicAdd(&(bar)[XB_TMO], 1u); break; } } } } while (0)
struct XcdBarrier { unsigned* bar; unsigned x; volatile LAS unsigned* st; };
__device__ __forceinline__ XcdBarrier xcd_barrier_post(unsigned* bar, volatile LAS unsigned* st) {
    XcdBarrier b; b.bar = bar; b.x = xb_xcc_id(); b.st = st;
    if (threadIdx.x == 0) (void)xb_add(&bar[XB_XCNT(b.x)], 1u);
    return b;
}
__device__ __forceinline__ void xcd_barrier_complete(unsigned* bar, unsigned x, unsigned& nloc, unsigned& nx) {
    const unsigned G = gridDim.x * gridDim.y * gridDim.z;
    unsigned sum, cnt, mine, sp = 0u;
    for (;;) {
        sum = 0u; cnt = 0u; mine = 0u;
#pragma unroll
        for (unsigned j = 0; j < 16; ++j) { const unsigned c = xb_ld(&bar[XB_XCNT(j)]); sum += c; cnt += (c > 0u) ? 1u : 0u; mine = (j == x) ? c : mine; }
        if (sum == G) break;
        __builtin_amdgcn_s_sleep(1);
        if ((++sp & 255u) == 0u) { if (xb_ld(&bar[XB_TMO])) break; if (sp > XB_SPIN_CAP) { atomicAdd(&bar[XB_TMO], 1u); break; } }
    }
    nloc = mine > 0u ? mine : 1u; (void)cnt;
    unsigned mask = 0u;
#pragma unroll
    for (unsigned j = 0; j < 16; ++j) mask |= (xb_ld(&bar[XB_XCNT(j)]) > 0u) ? (1u << j) : 0u;
    nx = mask;
}
__device__ __forceinline__ void xcd_barrier(const XcdBarrier& b) {
    asm volatile("s_waitcnt vmcnt(0)" ::: "memory");
    __syncthreads();
    if (threadIdx.x == 0) {
        unsigned* bar = b.bar;
        __builtin_amdgcn_s_waitcnt(0);
        asm volatile("buffer_inv sc1" ::: "memory");
        unsigned nloc = b.st[0], nx = b.st[1];
        if (nloc == 0u) { xcd_barrier_complete(bar, b.x, nloc, nx); b.st[0] = nloc; b.st[1] = nx; }
        const unsigned old = xb_add(&bar[XB_XSUB(b.x)], 1u);
        const unsigned gen = old / nloc;
        unsigned* xd = bar - 2048;
        if (old + 1u == (gen + 1u) * nloc) {
            __builtin_amdgcn_fence(__ATOMIC_RELEASE, "agent");
            asm volatile("s_waitcnt vmcnt(0)" ::: "memory");
            __hip_atomic_store(&xd[64 * b.x], gen + 1u, __ATOMIC_RELAXED, __HIP_MEMORY_SCOPE_AGENT);
        }
        unsigned sp = 0u;
        for (;;) { unsigned okm = 0u;
#pragma unroll
            for (unsigned j = 0; j < 16; ++j) okm |= (xb_ld(&xd[64 * j]) > gen) ? (1u << j) : 0u;
            if ((okm & nx) == nx) break;
            if ((++sp & 255u) == 0u) { if (xb_ld(&bar[XB_TMO])) break; if (sp > XB_SPIN_CAP) { atomicAdd(&bar[XB_TMO], 1u); break; } } }
        asm volatile("s_waitcnt vmcnt(0)" ::: "memory");
    }
    __syncthreads();
}

__device__ __forceinline__ void xcd_barrier_onesided(const XcdBarrier& b, bool waiter) {
    asm volatile("s_waitcnt vmcnt(0)" ::: "memory");
    __syncthreads();
    if (threadIdx.x == 0) {
        unsigned* bar = b.bar; unsigned* xd = bar - 2048;
        __builtin_amdgcn_s_waitcnt(0);
        if (waiter) asm volatile("buffer_inv sc1" ::: "memory");
        unsigned nloc = b.st[0], nx = b.st[1];
        if (nloc == 0u) { xcd_barrier_complete(bar, b.x, nloc, nx); b.st[0] = nloc; b.st[1] = nx; }
        const unsigned old = xb_add(&xd[1024 + 64 * b.x], 1u);
        if (old + 1u == nloc) {
            __builtin_amdgcn_fence(__ATOMIC_RELEASE, "agent");
            asm volatile("s_waitcnt vmcnt(0)" ::: "memory");
            __hip_atomic_store(&xd[1024 + 64 * b.x + 32], 1u, __ATOMIC_RELAXED, __HIP_MEMORY_SCOPE_AGENT);
        }
        if (waiter) { unsigned sp = 0u;
            for (;;) { unsigned okm = 0u;
#pragma unroll
                for (unsigned j = 0; j < 16; ++j) okm |= (xb_ld(&xd[1024 + 64 * j + 32]) != 0u) ? (1u << j) : 0u;
                if ((okm & nx) == nx) break;
                if ((++sp & 255u) == 0u) { if (xb_ld(&bar[XB_TMO])) break; if (sp > XB_SPIN_CAP) { atomicAdd(&bar[XB_TMO], 1u); break; } } } }
        asm volatile("s_waitcnt vmcnt(0)" ::: "memory");
    }
    __syncthreads();
}

template <int WOFF> __device__ __forceinline__ void xcd_split_arrive(const XcdBarrier& b) {
    asm volatile("s_waitcnt vmcnt(0)" ::: "memory");
    __syncthreads();
    if (threadIdx.x == 0) {
        unsigned* bar = b.bar; unsigned* xd = bar - 2048;
        __builtin_amdgcn_s_waitcnt(0);
        unsigned nloc = b.st[0], nx = b.st[1];
        if (nloc == 0u) { xcd_barrier_complete(bar, b.x, nloc, nx); b.st[0] = nloc; b.st[1] = nx; }
        const unsigned old = xb_add(&xd[1024 + 64 * b.x + WOFF], 1u);
        if (old + 1u == nloc) {
            __builtin_amdgcn_fence(__ATOMIC_RELEASE, "agent");
            asm volatile("s_waitcnt vmcnt(0)" ::: "memory");
            __hip_atomic_store(&xd[1024 + 64 * b.x + 32 + WOFF], 1u, __ATOMIC_RELAXED, __HIP_MEMORY_SCOPE_AGENT);
        }
    }
}
template <int WOFF> __device__ __forceinline__ void xcd_split_wait(const XcdBarrier& b) {
    if (threadIdx.x == 0) {
        unsigned* bar = b.bar; unsigned* xd = bar - 2048;
        const unsigned nx = b.st[1];
        asm volatile("buffer_inv sc1" ::: "memory");
        unsigned sp = 0u;
        for (;;) { unsigned okm = 0u;
#pragma unroll
            for (unsigned j = 0; j < 16; ++j) okm |= (xb_ld(&xd[1024 + 64 * j + 32 + WOFF]) != 0u) ? (1u << j) : 0u;
            if ((okm & nx) == nx) break;
            if ((++sp & 255u) == 0u) { if (xb_ld(&bar[XB_TMO])) break; if (sp > XB_SPIN_CAP) { atomicAdd(&bar[XB_TMO], 1u); break; } } }
        asm volatile("s_waitcnt vmcnt(0)" ::: "memory");
    }
    __syncthreads();
}

__device__ __forceinline__ void seam2_arrive(const XcdBarrier& b) {
    asm volatile("s_waitcnt vmcnt(0)" ::: "memory");
    __syncthreads();
    if (threadIdx.x == 0) {
        unsigned* xd = b.bar - 2048;
        __builtin_amdgcn_s_waitcnt(0);
        const unsigned ngx = xb_ld(&xd[1024 + 64 * b.x + 24]);
        const unsigned old = xb_add(&xd[1024 + 64 * b.x + 16], 1u);
        if (old + 1u == ngx) {
            __builtin_amdgcn_fence(__ATOMIC_RELEASE, "agent");
            asm volatile("s_waitcnt vmcnt(0)" ::: "memory");
            __hip_atomic_store(&xd[1024 + 64 * b.x + 48], 1u, __ATOMIC_RELAXED, __HIP_MEMORY_SCOPE_AGENT);
        }
    }
}
__device__ __forceinline__ void seam2_wait(const XcdBarrier& b) {
    if (threadIdx.x == 0) {
        unsigned* bar = b.bar; unsigned* xd = bar - 2048;
        asm volatile("buffer_inv sc1" ::: "memory");
        unsigned gm = 0u;
#pragma unroll
        for (unsigned j = 0; j < 16; ++j) gm |= (xb_ld(&xd[1024 + 64 * j + 24]) != 0u) ? (1u << j) : 0u;
        unsigned sp = 0u;
        for (;;) { unsigned okm = 0u;
#pragma unroll
            for (unsigned j = 0; j < 16; ++j) okm |= (xb_ld(&xd[1024 + 64 * j + 48]) != 0u) ? (1u << j) : 0u;
            if ((okm & gm) == gm) break;
            if ((++sp & 255u) == 0u) { if (xb_ld(&bar[XB_TMO])) break; if (sp > XB_SPIN_CAP) { atomicAdd(&bar[XB_TMO], 1u); break; } } }
        asm volatile("s_waitcnt vmcnt(0)" ::: "memory");
    }
    __syncthreads();
}

__global__ void __launch_bounds__(NTHREADS, 2) mega_fwd(Args args) {
    extern __shared__ __attribute__((aligned(16))) unsigned char lds[];
    const int tid = threadIdx.x, lane = tid & 63, wave = __builtin_amdgcn_readfirstlane(tid >> 6);
    const int nblk = gridDim.x, blk = blockIdx.x;
    const int gw = blk * NWAVES + wave, NGW = nblk * NWAVES;
    const int lo = args.ph_lo, hi = args.ph_hi;
#define IN(k) (lo <= (k) && (k) < hi)
#if MK_CG_SYNC
#define SEAM(k) do { if (IN(k) && IN((k) + 1)) { cg::this_grid().sync(); } } while (0)
#else
    volatile LAS unsigned* bst = (volatile LAS unsigned*)((LAS unsigned char*)lds + LDS_BYTES - 64);
    if (tid == 0) { bst[0] = 0u; bst[1] = 0u; }
    __syncthreads();
    const XcdBarrier gbar = xcd_barrier_post((unsigned*)(args.ws + WS_CTL) + 4096, bst);
    { const int nl_ = (nblk >= 256) ? 128 : nblk / 2;
      if (tid == 0 && blk < nblk - nl_) (void)xb_add((unsigned*)(args.ws + WS_CTL) + 2048 + 1024 + 64 * gbar.x + 24, 1u); }
#define SEAM(k) do { if (IN(k) && IN((k) + 1)) { xcd_barrier(gbar); } } while (0)
#endif
#if MK_CG_SYNC
    if (IN(0)) phase0<2>(args, (LAS unsigned char*)lds, tid, wave, lane, gw, NGW);
    SEAM(0);
#else
    if (IN(0) && IN(1)) {
        phase0<0>(args, (LAS unsigned char*)lds, tid, wave, lane, gw, NGW);
        xcd_split_arrive<8>(gbar);
        phase0<1>(args, (LAS unsigned char*)lds, tid, wave, lane, gw, NGW);
        xcd_split_wait<8>(gbar);
    } else if (IN(0)) phase0<2>(args, (LAS unsigned char*)lds, tid, wave, lane, gw, NGW);
#endif
    if (IN(1)) { phase1(args, (LAS unsigned char*)lds, nblk, blk, 6, 1024); if (PROBE_DUP == 1) phase1(args, (LAS unsigned char*)lds, nblk, blk, 6, 1024); }
#if MK_CG_SYNC
    SEAM(1);
#else
    if (IN(1) && IN(2)) { const int nl_ = (nblk >= 256) ? 128 : nblk / 2; xcd_barrier_onesided(gbar, blk >= nblk - nl_); }
#endif
    if (IN(2)) { const int nl = (nblk >= 256) ? 128 : nblk / 2, ng = nblk - nl;
        const bool probe_ = (hi != NPHASES);
#if MK_CG_SYNC
        if (blk < ng) { if (!(probe_ && PROBE_P2_MODE == 1)) phase1(args, (LAS unsigned char*)lds, ng, blk, 0, 1536);
            phase0_down(args, (LAS unsigned char*)lds, wave, lane, blk * NWAVES + wave, ng * NWAVES); }
        else { if (!(probe_ && PROBE_P2_MODE == 2)) phase2_lru(args, (LAS unsigned char*)lds, nl, blk - ng); } }
    SEAM(2);
#else
        const bool seam2 = IN(3);
        if (blk < ng) { if (!(probe_ && PROBE_P2_MODE == 1)) phase1(args, (LAS unsigned char*)lds, ng, blk, 0, 1536);
            if (seam2) seam2_arrive(gbar);
            phase0_down(args, (LAS unsigned char*)lds, wave, lane, blk * NWAVES + wave, ng * NWAVES); }
        else { if (!(probe_ && PROBE_P2_MODE == 2)) phase2_lru(args, (LAS unsigned char*)lds, nl, blk - ng); }
        if (seam2) seam2_wait(gbar); }
#endif
    if (IN(3)) { phase2_attn<0>(args, (char*)lds, nblk, blk); if (PROBE_DUP == 3) phase2_attn<0>(args, (char*)lds, nblk, blk); }
    SEAM(3);
    if (IN(4)) { phase3(args, (LAS unsigned char*)lds, nblk, blk); if (PROBE_DUP == 4) phase3(args, (LAS unsigned char*)lds, nblk, blk); }
    SEAM(4);
    if (IN(5)) { phase4<false>(args, (LAS unsigned char*)lds, nblk, blk); if (PROBE_DUP == 5) phase4<true>(args, (LAS unsigned char*)lds, nblk, blk); }
    SEAM(5);
    if (IN(6)) phase56(args, (LAS unsigned char*)lds, nblk, blk);
    SEAM(7);
    if (IN(8)) { int t8 = threadIdx.x; asm volatile("" : "+v"(t8));
        if (PROBE_DUP == 8) phase7<true>(args, t8 & 63, gw, NGW); phase7<false>(args, t8 & 63, gw, NGW); }
#undef IN
#undef SEAM
}

#if PROBE_ATT_VAR > 0
__global__ void __launch_bounds__(NTHREADS, 2) probe_attn(Args args) {
    extern __shared__ __attribute__((aligned(16))) unsigned char lds[];
    phase2_attn<PROBE_ATT_VAR>(args, (char*)lds, gridDim.x, blockIdx.x);
}
#endif
#if PROBE_VALU > 0
__global__ void __launch_bounds__(NTHREADS, 2) probe_valu(float* out, float seed) {
    float v[16];
#pragma unroll
    for (int i = 0; i < 16; ++i) v[i] = seed + (float)(threadIdx.x + i);
    f32x16 macc0 = f32x16{}, macc1 = f32x16{}; bf16x8 ma, mb;
#pragma unroll
    for (int i = 0; i < 8; ++i) { ma[i] = (short)(0x3F80 + threadIdx.x + i); mb[i] = (short)(0x3F00 + threadIdx.x * 3 + i); }
    for (int it = 0; it < 4096; ++it) {
#pragma unroll
        for (int i = 0; i < 16; ++i) {
#if PROBE_VALU == 1
            v[i] = fmaf(v[i], 1.0001f, 0.5f);
#elif PROBE_VALU == 2
            v[i] = __builtin_amdgcn_exp2f(v[i]);
#elif PROBE_VALU == 3
            v[i] = fmaxf(fmaxf(v[i], v[(i + 1) & 15]), seed);
#endif
        }
#if PROBE_VALU == 4 || PROBE_VALU == 5
        macc0 = __builtin_amdgcn_mfma_f32_32x32x16_bf16(ma, mb, macc0, 0, 0, 0);
#if PROBE_VALU == 4
        v[0] = fmaf(v[0], 1.0001f, 0.5f); v[1] = fmaf(v[1], 1.0001f, 0.5f); v[2] = fmaf(v[2], 1.0001f, 0.5f); v[3] = fmaf(v[3], 1.0001f, 0.5f); v[4] = fmaf(v[4], 1.0001f, 0.5f); v[5] = fmaf(v[5], 1.0001f, 0.5f);
#endif
        macc1 = __builtin_amdgcn_mfma_f32_32x32x16_bf16(ma, mb, macc1, 0, 0, 0);
#if PROBE_VALU == 4
        v[6] = fmaf(v[6], 1.0001f, 0.5f); v[7] = fmaf(v[7], 1.0001f, 0.5f); v[8] = fmaf(v[8], 1.0001f, 0.5f); v[9] = fmaf(v[9], 1.0001f, 0.5f); v[10] = fmaf(v[10], 1.0001f, 0.5f); v[11] = fmaf(v[11], 1.0001f, 0.5f);
#endif
#endif
        asm volatile("" : "+v"(v[0]), "+v"(v[1]), "+v"(v[2]), "+v"(v[3]), "+v"(v[4]), "+v"(v[5]), "+v"(v[6]), "+v"(v[7]));
    }
    float s = 0.f;
#pragma unroll
    for (int i = 0; i < 16; ++i) s += v[i] + macc0[i] + macc1[i];
    if (s == 123.456f) out[threadIdx.x] = s;
}
#endif
extern "C" void kernel_launch(void* const* d_in, const int* in_sizes, int n_in, void* d_out, int out_size, void* d_ws, size_t ws_size, hipStream_t stream) {
    static int grid = 0;
    if (grid == 0) {
        if (n_in != 23 || out_size != MTOK * DM || ws_size < WS_END) { fprintf(stderr, "kernel_launch: unexpected shapes (n_in %d out %d ws %zu)\n", n_in, out_size, ws_size); grid = -1; return; }
        int dev = 0, cus = 0, per_cu = 0;
        hipGetDevice(&dev);
        hipDeviceGetAttribute(&cus, hipDeviceAttributeMultiprocessorCount, dev);
        hipFuncSetAttribute((const void*)mega_fwd, hipFuncAttributeMaxDynamicSharedMemorySize, LDS_BYTES);
        hipOccupancyMaxActiveBlocksPerMultiprocessor(&per_cu, (const void*)mega_fwd, NTHREADS, LDS_BYTES);
        if (per_cu < 1) per_cu = 1;
        if (per_cu > 1) per_cu = 1;
        grid = cus * per_cu;
        (void)hipGetLastError();
    }
    if (grid < 0) return;
    (void)hipMemsetAsync((char*)d_ws + WS_CTL, 0, 65536, stream);
    Args a{};
    for (int i = 0; i < 23; ++i) a.in[i] = (const float*)d_in[i];
    a.out = (float*)d_out; a.ws = (unsigned char*)d_ws;
#if MK_N_LAUNCHES == 1
#if PROBE_VALU > 0
    hipLaunchKernelGGL(probe_valu, dim3(grid), dim3(NTHREADS), 0, stream, (float*)((char*)d_ws + WS_O0), 1.0f);
#endif
#if PROBE_PREFIX > 0
    { a.ph_lo = 0; a.ph_hi = PROBE_PREFIX; void* kargs0[] = {&a};
      (void)hipLaunchCooperativeKernel((const void*)mega_fwd, dim3(grid), dim3(NTHREADS), kargs0, LDS_BYTES, stream);
      (void)hipMemsetAsync((char*)d_ws + WS_CTL, 0, 65536, stream); }
#if PROBE_ATT_VAR > 0
    { (void)hipFuncSetAttribute((const void*)probe_attn, hipFuncAttributeMaxDynamicSharedMemorySize, LDS_BYTES); hipLaunchKernelGGL(probe_attn, dim3(grid), dim3(PROBE_ATT_THREADS), LDS_BYTES, stream, a); }
#endif
#endif
    a.ph_lo = 0; a.ph_hi = NPHASES;
    void* kargs[] = {&a};
    hipError_t e = hipLaunchCooperativeKernel((const void*)mega_fwd, dim3(grid), dim3(NTHREADS), kargs, LDS_BYTES, stream);
    if (e != hipSuccess) fprintf(stderr, "cooperative launch failed: %s (grid %d)\n", hipGetErrorString(e), grid);
#else
    for (int p = 0; p < NPHASES; ++p) {
        a.ph_lo = p; a.ph_hi = p + 1;
        hipLaunchKernelGGL(mega_fwd, dim3(grid), dim3(NTHREADS), LDS_BYTES, stream, a);
    }
#endif
}
```
